# Optimizing an MI355X kernel written in HIP

```python
import math
import jax, jax.numpy as jnp
from jax import lax
import numpy as np

D_MODEL = 1024
BATCH = 8
SEQ = 2048
DEPTH = 4

HEAD_DIM = 64
S5_WIDTH = D_MODEL // 4
S5_GROUP = 16
S5_GROUPS = S5_WIDTH // S5_GROUP
S5_STATE = 64
MOBA_WIDTH = 3 * D_MODEL // 8
MOBA_HEADS = MOBA_WIDTH // HEAD_DIM
GDN_WIDTH = 3 * D_MODEL // 8
GDN_HEADS = GDN_WIDTH // HEAD_DIM
MIX_WIDTH = S5_WIDTH + MOBA_WIDTH + GDN_WIDTH
IN_SIZES = (S5_WIDTH, MOBA_WIDTH, MOBA_WIDTH, MOBA_WIDTH,
            GDN_WIDTH, GDN_WIDTH, GDN_WIDTH, GDN_WIDTH, GDN_HEADS, GDN_HEADS)
IN_COLS = sum(IN_SIZES)

MOBA_BLOCK = 256
MOBA_TOPK = 3
MOBA_QBLOCK = 32
GDN_CHUNK = 64
CONV_WIDTH = 4

D_FF = 7 * D_MODEL // 2
N_EXPERTS = 8
TOP_K = 2
N_DENSE = (DEPTH + 1) // 2
N_MOE = DEPTH // 2

DEEPNORM_ALPHA = (2 * DEPTH) ** 0.25
DEEPNORM_BETA = (8 * DEPTH) ** -0.25
LN_EPS = 1e-5
RMS_EPS = 1e-6

kernel_name = "hymba_s5_moba_gdn_deepnorm_moe"

F32 = jnp.float32


def _split(h, sizes):
    idx = np.cumsum(np.array(sizes))[:-1].tolist()
    return jnp.split(h, idx, axis=-1)


def layer_norm(x, g, b):
    xf = x.astype(F32)
    mu = jnp.mean(xf, axis=-1, keepdims=True)
    var = jnp.mean(jnp.square(xf - mu), axis=-1, keepdims=True)
    return ((xf - mu) * lax.rsqrt(var + LN_EPS) * g.astype(F32) + b.astype(F32)).astype(x.dtype)


def l2norm(t):
    return t * lax.rsqrt(jnp.sum(jnp.square(t), axis=-1, keepdims=True) + RMS_EPS)


def s5_mixer(u, lam_re, lam_im, log_dt, b_re, b_im, c_re, c_im, d_skip, glu_w, glu_b):
    bsz, seqlen, _ = u.shape
    lam = lax.complex(lam_re.astype(F32), lam_im.astype(F32))
    step = jnp.exp(log_dt.astype(F32))[:, None]
    lam_bar = jnp.exp(lam * step)
    b_mat = lax.complex(b_re.astype(F32), b_im.astype(F32))
    b_bar = ((lam_bar - 1.0) / lam)[..., None] * b_mat
    ug = u.astype(F32).reshape(bsz, seqlen, S5_GROUPS, S5_GROUP)
    bu = jnp.einsum('blgp,gnp->blgn', ug.astype(jnp.complex64), b_bar)
    a = jnp.broadcast_to(lam_bar, bu.shape)

    def combine(e1, e2):
        a1, s1 = e1
        a2, s2 = e2
        return a1 * a2, a2 * s1 + s2

    _, states = lax.associative_scan(combine, (a, bu), axis=1)
    c_mat = lax.complex(c_re.astype(F32), c_im.astype(F32))
    y = jnp.einsum('gpn,blgn->blgp', c_mat, states).real + d_skip.astype(F32) * ug
    y = jax.nn.gelu(y.reshape(bsz, seqlen, S5_WIDTH))
    y = y * jax.nn.sigmoid(y @ glu_w.astype(F32) + glu_b.astype(F32))
    return y.astype(u.dtype)


def moba_mixer(q, k, v):
    bsz, seqlen, _ = q.shape
    n_blocks = -(-seqlen // MOBA_BLOCK)
    lpad = n_blocks * MOBA_BLOCK

    def heads(t):
        t = t.reshape(bsz, seqlen, MOBA_HEADS, HEAD_DIM).transpose(0, 2, 1, 3).astype(F32)
        return jnp.pad(t, ((0, 0), (0, 0), (0, lpad - seqlen), (0, 0)))

    qh = heads(q) * HEAD_DIM ** -0.5
    kh, vh = heads(k), heads(v)
    kb = kh.reshape(bsz, MOBA_HEADS, n_blocks, MOBA_BLOCK, HEAD_DIM)
    vb = vh.reshape(bsz, MOBA_HEADS, n_blocks, MOBA_BLOCK, HEAD_DIM)
    kmean = jnp.mean(kb, axis=3)

    gate = jnp.einsum('bhld,bhnd->bhln', qh, kmean)
    qblk = jnp.arange(lpad) // MOBA_BLOCK
    past = jnp.arange(n_blocks)[None, :] < qblk[:, None]
    gate = jnp.where(past, gate, -jnp.inf)
    n_sel = min(MOBA_TOPK, n_blocks)
    sel_score, sel_idx = lax.top_k(gate, n_sel)
    sel_valid = jnp.isfinite(sel_score)

    n_qb = lpad // MOBA_QBLOCK

    def by_qblock(t):
        t = t.reshape(bsz, MOBA_HEADS, n_qb, MOBA_QBLOCK, *t.shape[3:])
        return jnp.moveaxis(t, 2, 0)

    b_ix = jnp.arange(bsz)[:, None, None, None]
    h_ix = jnp.arange(MOBA_HEADS)[None, :, None, None]

    def attend(args):
        qc, idx, valid, i = args
        qpos = i * MOBA_QBLOCK + jnp.arange(MOBA_QBLOCK)
        own = (i * MOBA_QBLOCK) // MOBA_BLOCK
        k_own = lax.dynamic_index_in_dim(kb, own, axis=2, keepdims=False)
        v_own = lax.dynamic_index_in_dim(vb, own, axis=2, keepdims=False)
        kpos = own * MOBA_BLOCK + jnp.arange(MOBA_BLOCK)
        s_own = jnp.einsum('bhqd,bhkd->bhqk', qc, k_own)
        s_own = jnp.where(kpos[None, :] <= qpos[:, None], s_own, -jnp.inf)
        k_sel = kb[b_ix, h_ix, idx]
        v_sel = vb[b_ix, h_ix, idx]
        s_sel = jnp.einsum('bhqd,bhqnkd->bhqnk', qc, k_sel)
        s_sel = jnp.where(valid[..., None], s_sel, -jnp.inf)
        s_sel = s_sel.reshape(*s_sel.shape[:3], n_sel * MOBA_BLOCK)
        p = jax.nn.softmax(jnp.concatenate([s_own, s_sel], axis=-1), axis=-1)
        p_own = p[..., :MOBA_BLOCK]
        p_sel = p[..., MOBA_BLOCK:].reshape(*p.shape[:3], n_sel, MOBA_BLOCK)
        return (jnp.einsum('bhqk,bhkd->bhqd', p_own, v_own)
                + jnp.einsum('bhqnk,bhqnkd->bhqd', p_sel, v_sel))

    o = lax.map(attend, (by_qblock(qh), by_qblock(sel_idx), by_qblock(sel_valid), jnp.arange(n_qb)))
    o = jnp.moveaxis(o, 0, 2).reshape(bsz, MOBA_HEADS, lpad, HEAD_DIM)[:, :, :seqlen]
    return o.transpose(0, 2, 1, 3).reshape(bsz, seqlen, MOBA_WIDTH).astype(q.dtype)


def causal_conv(x, w):
    ch = x.shape[-1]
    return lax.conv_general_dilated(x, w[:, None, :].astype(x.dtype), window_strides=(1,),
                                    padding=[(CONV_WIDTH - 1, 0)],
                                    dimension_numbers=('NWC', 'WIO', 'NWC'),
                                    feature_group_count=ch)


def chunk_gated_delta(q, k, v, g, beta):
    bsz, nh, seqlen, dk = q.shape
    dv = v.shape[-1]
    n = seqlen // GDN_CHUNK
    C = GDN_CHUNK
    q = q.reshape(bsz, nh, n, C, dk)
    k = k.reshape(bsz, nh, n, C, dk)
    v = v.reshape(bsz, nh, n, C, dv)
    g = jnp.cumsum(g.reshape(bsz, nh, n, C), axis=-1)
    beta = beta.reshape(bsz, nh, n, C)
    kb = k * beta[..., None]
    vb = v * beta[..., None]
    tril_incl = jnp.tril(jnp.ones((C, C), dtype=bool))
    tril_strict = jnp.tril(jnp.ones((C, C), dtype=bool), -1)
    diff = jnp.where(tril_incl, g[..., :, None] - g[..., None, :], 0.0)
    decay = jnp.where(tril_incl, jnp.exp(diff), 0.0)
    lmat = jnp.where(tril_strict, jnp.einsum('bhncd,bhnsd->bhncs', kb, k) * decay, 0.0)
    eye = jnp.eye(C, dtype=F32)
    rhs = jnp.concatenate([vb, kb * jnp.exp(g)[..., None]], axis=-1)
    sol = lax.linalg.triangular_solve(eye + lmat, rhs, left_side=True, lower=True,
                                      unit_diagonal=True)
    u_val, w_k = sol[..., :dv], sol[..., dv:]
    attn = jnp.where(tril_incl, jnp.einsum('bhncd,bhnsd->bhncs', q, k) * decay, 0.0)

    def step(S, inp):
        qc, kc, uc, wc, gc, ac = inp
        v_new = uc - jnp.einsum('bhcd,bhde->bhce', wc, S)
        o = (jnp.einsum('bhcd,bhde->bhce', qc * jnp.exp(gc)[..., None], S)
             + jnp.einsum('bhcs,bhse->bhce', ac, v_new))
        g_last = gc[..., -1:]
        S = (S * jnp.exp(g_last)[..., None]
             + jnp.einsum('bhcd,bhce->bhde', kc * jnp.exp(g_last - gc)[..., None], v_new))
        return S, o

    xs = tuple(jnp.moveaxis(t, 2, 0) for t in (q, k, u_val, w_k, g, attn))
    S0 = jnp.zeros((bsz, nh, dk, dv), F32)
    _, o = lax.scan(step, S0, xs)
    return jnp.moveaxis(o, 0, 2).reshape(bsz, nh, seqlen, dv)


def gdn_mixer(q, k, v, z, a, b, conv_w, a_log, dt_bias, norm_w):
    bsz, seqlen, _ = q.shape
    qkv = jax.nn.silu(causal_conv(jnp.concatenate([q, k, v], axis=-1), conv_w).astype(F32))
    q, k, v = _split(qkv, (GDN_WIDTH, GDN_WIDTH, GDN_WIDTH))

    def heads(t):
        return t.reshape(bsz, seqlen, GDN_HEADS, HEAD_DIM).transpose(0, 2, 1, 3)

    qh = l2norm(heads(q)) * HEAD_DIM ** -0.5
    kh = l2norm(heads(k))
    vh = heads(v)
    beta = jax.nn.sigmoid(b.astype(F32)).transpose(0, 2, 1)
    g = (-jnp.exp(a_log.astype(F32))
         * jax.nn.softplus(a.astype(F32) + dt_bias.astype(F32))).transpose(0, 2, 1)
    o = chunk_gated_delta(qh, kh, vh, g, beta).transpose(0, 2, 1, 3)
    zh = z.astype(F32).reshape(bsz, seqlen, GDN_HEADS, HEAD_DIM)
    o = (o * lax.rsqrt(jnp.mean(jnp.square(o), axis=-1, keepdims=True) + RMS_EPS)
         * norm_w.astype(F32) * jax.nn.silu(zh))
    return o.reshape(bsz, seqlen, GDN_WIDTH).astype(q.dtype)


def swiglu(x, w_gate, w_up, w_down):
    return (jax.nn.silu(x @ w_gate) * (x @ w_up)) @ w_down


def moe_ffn(x, router_w, w_gate, w_up, w_down):
    logits = (x @ router_w).astype(F32)
    top_val, top_idx = lax.top_k(logits, TOP_K)
    gates = jax.nn.softmax(top_val, axis=-1)
    combine = jnp.sum(jax.nn.one_hot(top_idx, N_EXPERTS, dtype=F32) * gates[..., None], axis=-2)
    out = jnp.zeros(x.shape, F32)
    for e in range(N_EXPERTS):
        out = out + combine[..., e:e + 1] * swiglu(x, w_gate[e], w_up[e], w_down[e]).astype(F32)
    return out.astype(x.dtype)


def setup_inputs(seed: int = 0) -> dict:
    key = jax.random.key(seed)
    ks = jax.random.split(key, 32)
    nrm = jax.random.normal
    G, N, P = S5_GROUPS, S5_STATE, S5_GROUP
    x = nrm(ks[0], (BATCH, SEQ, D_MODEL), F32)
    w_in = nrm(ks[1], (DEPTH, D_MODEL, IN_COLS), F32) * D_MODEL ** -0.5
    w_out = nrm(ks[2], (DEPTH, MIX_WIDTH, D_MODEL), F32) * MIX_WIDTH ** -0.5 * DEEPNORM_BETA
    s5_lam_re = -0.5 + 0.01 * nrm(ks[3], (DEPTH, G, N), F32)
    s5_lam_im = (jnp.pi * jnp.arange(N, dtype=F32))[None, None, :] + 0.01 * nrm(ks[4], (DEPTH, G, N), F32)
    s5_log_dt = jax.random.uniform(ks[5], (DEPTH, G), F32, math.log(1e-3), math.log(1e-1))
    s5_b_re = nrm(ks[6], (DEPTH, G, N, P), F32) * (2 * P) ** -0.5
    s5_b_im = nrm(ks[7], (DEPTH, G, N, P), F32) * (2 * P) ** -0.5
    s5_c_re = nrm(ks[8], (DEPTH, G, P, N), F32) * (2 * N) ** -0.5
    s5_c_im = nrm(ks[9], (DEPTH, G, P, N), F32) * (2 * N) ** -0.5
    s5_d = nrm(ks[10], (DEPTH, G, P), F32)
    s5_glu_w = nrm(ks[11], (DEPTH, S5_WIDTH, S5_WIDTH), F32) * S5_WIDTH ** -0.5
    s5_glu_b = 0.01 * nrm(ks[12], (DEPTH, S5_WIDTH), F32)
    gdn_conv_w = nrm(ks[13], (DEPTH, CONV_WIDTH, 3 * GDN_WIDTH), F32) * CONV_WIDTH ** -0.5
    gdn_a_log = jnp.log(jax.random.uniform(ks[14], (DEPTH, GDN_HEADS), F32, 1.0, 16.0))
    dt0 = jnp.exp(jax.random.uniform(ks[15], (DEPTH, GDN_HEADS), F32, math.log(1e-3), math.log(1e-1)))
    gdn_dt_bias = dt0 + jnp.log(-jnp.expm1(-dt0))
    gdn_norm_w = 1.0 + 0.01 * nrm(ks[16], (DEPTH, HEAD_DIM), F32)
    ln1_g = 1.0 + 0.01 * nrm(ks[17], (DEPTH, D_MODEL), F32)
    ln1_b = 0.01 * nrm(ks[18], (DEPTH, D_MODEL), F32)
    ln2_g = 1.0 + 0.01 * nrm(ks[19], (DEPTH, D_MODEL), F32)
    ln2_b = 0.01 * nrm(ks[20], (DEPTH, D_MODEL), F32)
    ffn_w_gate = nrm(ks[21], (N_DENSE, D_MODEL, D_FF), F32) * D_MODEL ** -0.5
    ffn_w_up = nrm(ks[22], (N_DENSE, D_MODEL, D_FF), F32) * D_MODEL ** -0.5
    ffn_w_down = nrm(ks[23], (N_DENSE, D_FF, D_MODEL), F32) * D_FF ** -0.5 * DEEPNORM_BETA
    moe_router = nrm(ks[24], (N_MOE, D_MODEL, N_EXPERTS), F32) * D_MODEL ** -0.5
    moe_w_gate = nrm(ks[25], (N_MOE, N_EXPERTS, D_MODEL, D_FF), F32) * D_MODEL ** -0.5
    moe_w_up = nrm(ks[26], (N_MOE, N_EXPERTS, D_MODEL, D_FF), F32) * D_MODEL ** -0.5
    moe_w_down = nrm(ks[27], (N_MOE, N_EXPERTS, D_FF, D_MODEL), F32) * D_FF ** -0.5 * DEEPNORM_BETA
    return {"x": x, "w_in": w_in, "w_out": w_out,
            "s5_lam_re": s5_lam_re, "s5_lam_im": s5_lam_im, "s5_log_dt": s5_log_dt,
            "s5_b_re": s5_b_re, "s5_b_im": s5_b_im, "s5_c_re": s5_c_re, "s5_c_im": s5_c_im,
            "s5_d": s5_d, "s5_glu_w": s5_glu_w, "s5_glu_b": s5_glu_b,
            "gdn_conv_w": gdn_conv_w, "gdn_a_log": gdn_a_log, "gdn_dt_bias": gdn_dt_bias,
            "gdn_norm_w": gdn_norm_w,
            "ln1_g": ln1_g, "ln1_b": ln1_b, "ln2_g": ln2_g, "ln2_b": ln2_b,
            "ffn_w_gate": ffn_w_gate, "ffn_w_up": ffn_w_up, "ffn_w_down": ffn_w_down,
            "moe_router": moe_router, "moe_w_gate": moe_w_gate, "moe_w_up": moe_w_up,
            "moe_w_down": moe_w_down}


def reference(x, w_in, w_out, s5_lam_re, s5_lam_im, s5_log_dt, s5_b_re, s5_b_im, s5_c_re,
              s5_c_im, s5_d, s5_glu_w, s5_glu_b, gdn_conv_w, gdn_a_log, gdn_dt_bias, gdn_norm_w,
              ln1_g, ln1_b, ln2_g, ln2_b, ffn_w_gate, ffn_w_up, ffn_w_down,
              moe_router, moe_w_gate, moe_w_up, moe_w_down):
    for l in range(DEPTH):
        h = x @ w_in[l]
        s5_u, mq, mk, mv, gq, gk, gv, gz, ga, gb = _split(h, IN_SIZES)
        y_s5 = s5_mixer(s5_u, s5_lam_re[l], s5_lam_im[l], s5_log_dt[l], s5_b_re[l], s5_b_im[l],
                        s5_c_re[l], s5_c_im[l], s5_d[l], s5_glu_w[l], s5_glu_b[l])
        y_moba = moba_mixer(mq, mk, mv)
        y_gdn = gdn_mixer(gq, gk, gv, gz, ga, gb, gdn_conv_w[l], gdn_a_log[l], gdn_dt_bias[l],
                          gdn_norm_w[l])
        mix = jnp.concatenate([y_s5, y_moba, y_gdn], axis=-1) @ w_out[l]
        x = layer_norm(DEEPNORM_ALPHA * x + mix, ln1_g[l], ln1_b[l])
        if l % 2 == 0:
            f = swiglu(x, ffn_w_gate[l // 2], ffn_w_up[l // 2], ffn_w_down[l // 2])
        else:
            f = moe_ffn(x, moe_router[l // 2], moe_w_gate[l // 2], moe_w_up[l // 2], moe_w_down[l // 2])
        x = layer_norm(DEEPNORM_ALPHA * x + f, ln2_g[l], ln2_b[l])
    return x
```

```cpp
#include <hip/hip_runtime.h>
#include <cstdio>
#include <cstdint>

constexpr int BATCH = 8, SEQ = 2048, DM = 1024, DEPTH = 4, MTOK = BATCH * SEQ;
constexpr int INC = 2956, INP = 3072;
constexpr int C_S5 = 0, C_MQ = 256, C_MK = 640, C_MV = 1024, C_GQ = 1408, C_GK = 1792, C_GV = 2176, C_GZ = 2560, C_GA = 2944;
constexpr int DFF = 3584, NE = 8;
constexpr int S5G = 16, S5P = 16, S5N = 64;
constexpr int NH = 6, HD = 64;
constexpr float ALPHA = 1.681792830507429f;
constexpr float LN_EPS = 1e-5f, RMS_EPS = 1e-6f;
constexpr int MAXT = 136;

constexpr size_t MiB = 1u << 20;
constexpr size_t WS_CTL = 0;
constexpr size_t WS_WIN = 1 * MiB;
constexpr size_t WS_WOUT = 25 * MiB;
constexpr size_t WS_WGU = 33 * MiB;
constexpr size_t WS_WD = 285 * MiB;
constexpr size_t WS_XB = 411 * MiB;
constexpr size_t WS_X1 = 443 * MiB;
constexpr size_t WS_X1B = 507 * MiB;
constexpr size_t WS_Y = 539 * MiB;
constexpr size_t WS_R1 = 607 * MiB;
constexpr size_t R1_H = 0, R1_AUX = 96 * MiB, R1_MIX = 97 * MiB, R1_YS5 = 129 * MiB, R1_GQKV = 145 * MiB, R1_KMEAN = 217 * MiB;
constexpr size_t WS_MISC = 845 * MiB;
constexpr size_t MISC_TOKE = 0, MISC_TOKP = 128 * 1024, MISC_TOKW = 256 * 1024, MISC_ROWTOKV = 384 * 1024  , MISC_TILEE = 896 * 1024;
constexpr size_t WS_END = 847 * MiB;
constexpr int CW_CNT = 64;
constexpr int CW_NT = 128;

typedef unsigned short bf16_t;
typedef short bf16x8 __attribute__((ext_vector_type(8)));
typedef float f32x4 __attribute__((ext_vector_type(4)));
typedef unsigned u32x4 __attribute__((ext_vector_type(4)));
typedef unsigned u32x2 __attribute__((ext_vector_type(2)));
#define LAS __attribute__((address_space(3)))

__device__ __forceinline__ float bf2f(bf16_t v) { return __uint_as_float(((unsigned)v) << 16); }
__device__ __forceinline__ unsigned f2bf(float f) { unsigned u = __float_as_uint(f); return (u + 0x7fffu + ((u >> 16) & 1u)) >> 16; }
__device__ __forceinline__ unsigned pk2(float lo, float hi) { return f2bf(lo) | (f2bf(hi) << 16); }
__device__ __forceinline__ float wave_sum(float v) {
#pragma unroll
    for (int o = 1; o < 64; o <<= 1) v += __shfl_xor(v, o);
    return v;
}
__device__ __forceinline__ float sigmoidf_(float x) { return 1.f / (1.f + __expf(-x)); }
__device__ __forceinline__ float siluf_(float x) { return x / (1.f + __expf(-x)); }

namespace pg8 {
constexpr int BM = 256, BK = 64, HALF = 128, HTB = HALF * BK * 2, STAGE_BYTES = 8 * HTB, NXCD = 8, WGM = 8;
__host__ __device__ __forceinline__ int lds_byte(int r, int c) { const int st = (r >> 4) * 2 + (c >> 5), rr = r & 15, cc = c & 31, ob = rr * 64 + cc * 2; return st * 1024 + (ob ^ (((ob >> 9) & 1) << 5)); }
__host__ __device__ __forceinline__ void stage_rc(int b, int& R, int& C) { const int st = b / 1024, sb = b % 1024, swz = sb ^ (((sb >> 9) & 1) << 5); R = (st >> 1) * 16 + swz / 64; C = (st & 1) * 32 + (swz % 64) / 2; }
__host__ __device__ __forceinline__ int perm32(int rho) { const int n = rho >> 4, i = rho & 15; return 8 * (i >> 2) + 4 * n + (i & 3); }

struct Unit { int pm, pn, e; };
struct Gemm { const bf16_t* A; const bf16_t* Bt; int nM, nN, K; size_t bstride; const LAS int* tile_e; };

struct StaticOrder {
    int nM, nN, nwg, G, c; const LAS int* te;
    __device__ void init(int nM_, int nN_, int G_, int c_, const LAS int* te_) { nM = nM_; nN = nN_; nwg = nM * nN; G = G_; c = c_; te = te_; }
    __device__ bool next(int i, Unit& u) const {
        const long L = (long)i * G + c; if (L >= nwg) return false;
        int wgid = (int)L; { const int q = nwg / NXCD, r = nwg % NXCD, xcd = wgid % NXCD, off = wgid / NXCD; wgid = (xcd < r ? xcd * (q + 1) : r * (q + 1) + (xcd - r) * q) + off; }
        const int nig = WGM * nN, gid = wgid / nig, fm = gid * WGM, gsz = (nM - fm) < WGM ? (nM - fm) : WGM;
        u.pm = fm + ((wgid % nig) % gsz); u.pn = (wgid % nig) / gsz; u.e = te ? te[u.pm] : 0; return true;
    }
};

__device__ __forceinline__ unsigned cvt_pk_bf16(float lo, float hi) { unsigned r; asm volatile("v_cvt_pk_bf16_f32 %0, %1, %2" : "=v"(r) : "v"(lo), "v"(hi)); return r; }

struct EpiF32 {
    static constexpr bool PERM = false;
    float* C; int ldc; int pad;
    __device__ __forceinline__ void operator()(const f32x4 (&acc)[2][2][4][2], const Unit& u, int wr, int wc, int fr, int fq) const {
        const int row0 = u.pm * BM + wr * 64 + fr, col0 = u.pn * BM + wc * 32 + 4 * fq;
#pragma unroll
        for (int ai = 0; ai < 2; ++ai)
#pragma unroll
            for (int m = 0; m < 4; ++m) { float* rowp = C + (size_t)(row0 + ai * HALF + m * 16) * ldc + col0;
#pragma unroll
                for (int bj = 0; bj < 2; ++bj)
#pragma unroll
                    for (int n = 0; n < 2; ++n) *(f32x4*)(rowp + bj * HALF + n * 16) = acc[ai][bj][m][n]; }
    }
};
struct EpiBf16 {
    static constexpr bool PERM = true;
    bf16_t* O; float* aux; int ldc; int aux_pn;
    __device__ __forceinline__ void operator()(const f32x4 (&acc)[2][2][4][2], const Unit& u, int wr, int wc, int fr, int fq) const {
        const int row0 = u.pm * BM + wr * 64 + fr; const int col0 = u.pn * BM + wc * 32 + 8 * fq;
#pragma unroll
        for (int ai = 0; ai < 2; ++ai)
#pragma unroll
            for (int m = 0; m < 4; ++m) { bf16_t* rowp = O + (size_t)(row0 + ai * HALF + m * 16) * ldc + col0;
#pragma unroll
                for (int bj = 0; bj < 2; ++bj) { const f32x4 v0 = acc[ai][bj][m][0], v1 = acc[ai][bj][m][1];
                    u32x4 w; w.x = cvt_pk_bf16(v0[0], v0[1]); w.y = cvt_pk_bf16(v0[2], v0[3]); w.z = cvt_pk_bf16(v1[0], v1[1]); w.w = cvt_pk_bf16(v1[2], v1[3]);
                    *(u32x4*)(rowp + bj * HALF) = w; } }
        if (aux && u.pn == aux_pn && wc == 0 && fq < 2) {
#pragma unroll
            for (int ai = 0; ai < 2; ++ai)
#pragma unroll
                for (int m = 0; m < 4; ++m) { float* ap = aux + (size_t)(row0 + ai * HALF + m * 16) * 16 + 8 * fq;
                    *(f32x4*)(ap) = acc[ai][1][m][0]; *(f32x4*)(ap + 4) = acc[ai][1][m][1]; }
        }
    }
};
struct EpiSwiglu {
    static constexpr bool PERM = true;
    bf16_t* O; int ldc; int pad;
    __device__ __forceinline__ void operator()(const f32x4 (&acc)[2][2][4][2], const Unit& u, int wr, int wc, int fr, int fq) const {
        const int row0 = u.pm * BM + wr * 64 + fr; const int col0 = u.pn * HALF + wc * 32 + 8 * fq;
#pragma unroll
        for (int ai = 0; ai < 2; ++ai)
#pragma unroll
            for (int m = 0; m < 4; ++m) { bf16_t* rowp = O + (size_t)(row0 + ai * HALF + m * 16) * ldc + col0;
                float r[8];
#pragma unroll
                for (int n = 0; n < 2; ++n)
#pragma unroll
                    for (int j = 0; j < 4; ++j) { const float g = acc[ai][0][m][n][j], up = acc[ai][1][m][n][j];
                        r[n * 4 + j] = g * __builtin_amdgcn_rcpf(1.f + __builtin_amdgcn_exp2f(-1.4426950408889634f * g)) * up; }
                u32x4 w; w.x = cvt_pk_bf16(r[0], r[1]); w.y = cvt_pk_bf16(r[2], r[3]); w.z = cvt_pk_bf16(r[4], r[5]); w.w = cvt_pk_bf16(r[6], r[7]);
                *(u32x4*)(rowp) = w; }
    }
};

template <class Epi, bool ALIGN_EPI = true>
__device__ __forceinline__ void gemm_phase(LAS unsigned char* lds, const Gemm g, const StaticOrder& S, const Epi& E) {
    const int tid = threadIdx.x, wid = __builtin_amdgcn_readfirstlane(tid >> 6), lane = tid & 63, wr = wid >> 2, wc = wid & 3, fr = lane & 15, fq = lane >> 4;
    const int K = g.K, nt = K / BK;
    unsigned voffA[2], voffB[2];
#pragma unroll
    for (int i = 0; i < 2; ++i) { int R, C; stage_rc(tid * 16 + i * 8192, R, C); const int Rb = Epi::PERM ? ((R & ~31) + perm32(R & 31)) : R;
        voffA[i] = (unsigned)(R * K + C) * 2u; voffB[i] = (unsigned)(Rb * K + C) * 2u; }
    const size_t kstep = (size_t)(BK * 2);
    const size_t hstep = (size_t)HALF * K * 2;
    const size_t tstep = 2 * hstep;
    const unsigned ldsw = (unsigned)wid * 1024u;
    const int aoff = lds_byte(wr * 64 + fr, fq * 8), boff = lds_byte(wc * 32 + fr, fq * 8);
#define PG8_SA(b, h) (((b) * 2 + (h)) * HTB)
#define PG8_SB(b, h) ((4 + (b) * 2 + (h)) * HTB)
#define PG8_STAGE(bufoff, gbase, voff) do { _Pragma("unroll") for (int _i = 0; _i < 2; ++_i) \
        __builtin_amdgcn_global_load_lds((const unsigned*)((const char*)(gbase) + (voff)[_i]), (LAS unsigned*)(lds + (bufoff) + ldsw + _i * 8192), 16, 0, 0); } while (0)
#define PG8_LDA(dst, b, h) do { _Pragma("unroll") for (int m = 0; m < 4; ++m) _Pragma("unroll") for (int k = 0; k < 2; ++k) dst[m][k] = *(const LAS bf16x8*)(lds + PG8_SA(b, h) + aoff + m * 2048 + k * 1024); } while (0)
#define PG8_LDB(dst, b, h) do { _Pragma("unroll") for (int n = 0; n < 2; ++n) _Pragma("unroll") for (int k = 0; k < 2; ++k) dst[n][k] = *(const LAS bf16x8*)(lds + PG8_SB(b, h) + boff + n * 2048 + k * 1024); } while (0)
#define PG8_MMA(ai, bj, At, Bt) do { __builtin_amdgcn_s_setprio(1); _Pragma("unroll") for (int m = 0; m < 4; ++m) _Pragma("unroll") for (int n = 0; n < 2; ++n) _Pragma("unroll") for (int k = 0; k < 2; ++k) \
        acc[ai][bj][m][n] = __builtin_amdgcn_mfma_f32_16x16x32_bf16(Bt[n][k], At[m][k], acc[ai][bj][m][n], 0, 0, 0); __builtin_amdgcn_s_setprio(0); } while (0)
#define PG8_WAIT_V(n) asm volatile("s_waitcnt vmcnt(" #n ")" ::: "memory")
#define PG8_WAIT_L(n) asm volatile("s_waitcnt lgkmcnt(" #n ")" ::: "memory")
#define PG8_BAR __builtin_amdgcn_s_barrier()
#define PG8_SCHED __builtin_amdgcn_sched_barrier(0)
    Unit cur, nxt; int ui = 0;
    if (!S.next(0, cur)) return;
    f32x4 acc[2][2][4][2];
#pragma unroll
    for (int a = 0; a < 2; ++a)
#pragma unroll
        for (int b = 0; b < 2; ++b)
#pragma unroll
            for (int m = 0; m < 4; ++m)
#pragma unroll
                for (int n = 0; n < 2; ++n) acc[a][b][m][n] = (f32x4){0.f, 0.f, 0.f, 0.f};
    bf16x8 At[4][2], B0[2][2], B1[2][2];
    const char* cA = (const char*)g.A + (size_t)cur.pm * tstep; const char* cB = (const char*)(g.Bt + (size_t)cur.e * g.bstride) + (size_t)cur.pn * tstep;
    PG8_STAGE(PG8_SB(0, 0), cB, voffB); PG8_STAGE(PG8_SB(0, 1), cB + hstep, voffB); PG8_STAGE(PG8_SA(0, 0), cA, voffA); PG8_STAGE(PG8_SA(0, 1), cA + hstep, voffA);
    if (wr == 1) PG8_BAR;
    PG8_WAIT_V(2); PG8_BAR;
    PG8_STAGE(PG8_SB(1, 0), cB + kstep, voffB); PG8_STAGE(PG8_SA(1, 0), cA + kstep, voffA); PG8_STAGE(PG8_SB(1, 1), cB + hstep + kstep, voffB);
    PG8_WAIT_V(6); PG8_BAR;
    for (;;) {
        const bool has_next = S.next(ui + 1, nxt);
        const char* nA = has_next ? (const char*)g.A + (size_t)nxt.pm * tstep : cA; const char* nB = has_next ? (const char*)(g.Bt + (size_t)nxt.e * g.bstride) + (size_t)nxt.pn * tstep : cB;
        for (int t = 0; t < nt; t += 2) {
            const bool last = (t == nt - 2);
            const char* a1 = cA + (size_t)(t + 1) * kstep;
            const char* a2 = last ? nA : cA + (size_t)(t + 2) * kstep; const char* b2 = last ? nB : cB + (size_t)(t + 2) * kstep;
            const char* a3 = a2 + kstep; const char* b3 = b2 + kstep;
            PG8_LDB(B0, 0, 0); PG8_LDB(B1, 0, 1); PG8_SCHED; PG8_LDA(At, 0, 0); PG8_STAGE(PG8_SA(1, 1), a1 + hstep, voffA);
            PG8_WAIT_V(8); PG8_WAIT_L(0); PG8_BAR; PG8_MMA(0, 0, At, B0); PG8_MMA(0, 1, At, B1); PG8_BAR; PG8_SCHED;
            PG8_LDA(At, 0, 1); PG8_STAGE(PG8_SB(0, 0), b2, voffB); PG8_STAGE(PG8_SB(0, 1), b2 + hstep, voffB); PG8_STAGE(PG8_SA(0, 0), a2, voffA);
            PG8_WAIT_V(8); PG8_WAIT_L(0); PG8_BAR; PG8_MMA(1, 0, At, B0); PG8_MMA(1, 1, At, B1); PG8_BAR; PG8_SCHED;
            PG8_LDB(B0, 1, 0); PG8_LDB(B1, 1, 1); PG8_SCHED; PG8_LDA(At, 1, 0); PG8_STAGE(PG8_SA(0, 1), a2 + hstep, voffA);
            PG8_WAIT_V(8); PG8_WAIT_L(0); PG8_BAR; PG8_MMA(0, 0, At, B0); PG8_MMA(0, 1, At, B1); PG8_BAR; PG8_SCHED;
            PG8_LDA(At, 1, 1); PG8_STAGE(PG8_SB(1, 0), b3, voffB); PG8_STAGE(PG8_SB(1, 1), b3 + hstep, voffB); PG8_STAGE(PG8_SA(1, 0), a3, voffA);
            PG8_WAIT_V(8); PG8_WAIT_L(0); PG8_BAR; PG8_MMA(1, 0, At, B0); PG8_MMA(1, 1, At, B1); PG8_BAR; PG8_SCHED;
        }
        if constexpr (ALIGN_EPI) { if (wr == 0) PG8_BAR; }
        E(acc, cur, wr, wc, fr, fq);
        if (!has_next) break;
#pragma unroll
        for (int a = 0; a < 2; ++a)
#pragma unroll
            for (int b = 0; b < 2; ++b)
#pragma unroll
                for (int m = 0; m < 4; ++m)
#pragma unroll
                    for (int n = 0; n < 2; ++n) acc[a][b][m][n] = (f32x4){0.f, 0.f, 0.f, 0.f};
        cur = nxt; cA = nA; cB = nB; ++ui;
        if constexpr (ALIGN_EPI) { if (wr == 1) PG8_BAR; }
    }
    PG8_WAIT_V(0);
    if constexpr (!ALIGN_EPI) { if (wr == 0) PG8_BAR; }
    PG8_BAR;
#undef PG8_SA
#undef PG8_SB
#undef PG8_STAGE
#undef PG8_LDA
#undef PG8_LDB
#undef PG8_MMA
#undef PG8_WAIT_V
#undef PG8_WAIT_L
#undef PG8_BAR
#undef PG8_SCHED
}
}

constexpr int GEMM_LDS = 131072 + 1024;

struct GemmLaunch { const bf16_t* A; const bf16_t* Bt; int nM; int nN; int K; int pad; size_t bstride; const int* tile_e; const unsigned* nt_word; };

template <class Epi> __global__ void __launch_bounds__(512, 2) k_gemm(GemmLaunch L, Epi E) {
    extern __shared__ __attribute__((aligned(16))) unsigned char smem[];
    LAS unsigned char* lds = (LAS unsigned char*)smem;
    LAS int* te = (LAS int*)(lds + 131072);
    int nM = L.nM;
    if (L.nt_word) nM = (int)__builtin_amdgcn_readfirstlane(*(const volatile unsigned*)L.nt_word);
    if (L.tile_e) { if ((int)threadIdx.x < nM) te[threadIdx.x] = L.tile_e[threadIdx.x]; }
    __syncthreads();
    pg8::Gemm g{L.A, L.Bt, nM, L.nN, L.K, L.bstride, L.tile_e ? (const LAS int*)te : (const LAS int*)nullptr};
    pg8::StaticOrder S; S.init(nM, L.nN, (int)gridDim.x, (int)blockIdx.x, g.tile_e);
    pg8::gemm_phase<Epi, true>(lds, g, S, E);
}

__device__ __forceinline__ void prep_tile(const float* src, int K, int N, bf16_t* dst, int mode, int kt, int ntile, LAS float* scr) {
    const int t = threadIdx.x; const int k0 = kt * 64, n0 = ntile * 64;
#pragma unroll
    for (int j = 0; j < 2; ++j) { const int r = (t >> 4) + 32 * j, c4 = (t & 15) * 4; const int n = n0 + c4;
        f32x4 v = (f32x4){0.f, 0.f, 0.f, 0.f}; if (n < N) v = *(const f32x4*)(src + (size_t)(k0 + r) * N + n);
        scr[r * 65 + c4 + 0] = v[0]; scr[r * 65 + c4 + 1] = v[1]; scr[r * 65 + c4 + 2] = v[2]; scr[r * 65 + c4 + 3] = v[3]; }
    __syncthreads();
    { const int nl = t >> 3, kc = (t & 7) * 8; const int n = n0 + nl;
      int drow; if (mode == 0) drow = n; else if (mode == 1) drow = 256 * (n >> 7) + (n & 127); else drow = 256 * (n >> 7) + 128 + (n & 127);
      u32x4 o; o.x = pk2(scr[(kc + 0) * 65 + nl], scr[(kc + 1) * 65 + nl]); o.y = pk2(scr[(kc + 2) * 65 + nl], scr[(kc + 3) * 65 + nl]);
      o.z = pk2(scr[(kc + 4) * 65 + nl], scr[(kc + 5) * 65 + nl]); o.w = pk2(scr[(kc + 6) * 65 + nl], scr[(kc + 7) * 65 + nl]);
      *(u32x4*)(dst + (size_t)drow * K + k0 + kc) = o; }
    __syncthreads();
}
struct PrepArgs { const float *w_in, *w_out, *fg, *fu, *fd, *mg, *mu, *md; unsigned char* ws; };
__global__ void __launch_bounds__(512) k_prep(PrepArgs P) {
    __shared__ float scr[64 * 65];
    LAS float* s = (LAS float*)scr;
    constexpr int T_IN = 16 * 48, T_OUT = 16 * 16, T_GU = 16 * 56, T_D = 56 * 16;
    constexpr int N_IN = 4 * T_IN, N_OUT = 4 * T_OUT, N_G = 18 * T_GU, N_U = 18 * T_GU, N_D = 18 * T_D;
    constexpr int TOTAL = N_IN + N_OUT + N_G + N_U + N_D;
    for (int it = blockIdx.x; it < TOTAL; it += gridDim.x) {
        int r = it;
        if (r < N_IN) { const int l = r / T_IN, q = r % T_IN; prep_tile(P.w_in + (size_t)l * DM * INC, DM, INC, (bf16_t*)(P.ws + WS_WIN) + (size_t)l * INP * DM, 0, q / 48, q % 48, s); continue; } r -= N_IN;
        if (r < N_OUT) { const int l = r / T_OUT, q = r % T_OUT; prep_tile(P.w_out + (size_t)l * DM * DM, DM, DM, (bf16_t*)(P.ws + WS_WOUT) + (size_t)l * DM * DM, 0, q / 16, q % 16, s); continue; } r -= N_OUT;
        if (r < N_G + N_U) { const int up = r >= N_G; if (up) r -= N_G; const int sl = r / T_GU, q = r % T_GU;
            const float* src = sl < 2 ? (up ? P.fu : P.fg) + (size_t)sl * DM * DFF : (up ? P.mu : P.mg) + (size_t)(sl - 2) * DM * DFF;
            prep_tile(src, DM, DFF, (bf16_t*)(P.ws + WS_WGU) + (size_t)sl * 2 * DFF * DM, up ? 2 : 1, q / 56, q % 56, s); continue; } r -= N_G + N_U;
        { const int sl = r / T_D, q = r % T_D; const float* src = sl < 2 ? P.fd + (size_t)sl * DFF * DM : P.md + (size_t)(sl - 2) * DFF * DM;
          prep_tile(src, DFF, DM, (bf16_t*)(P.ws + WS_WD) + (size_t)sl * DM * DFF, 0, q / 16, q % 16, s); }
    }
}
__global__ void k_cast_x(const float* x, bf16_t* xb) {
    const size_t i = ((size_t)blockIdx.x * blockDim.x + threadIdx.x) * 4;
    if (i < (size_t)MTOK * DM) { const f32x4 v = *(const f32x4*)(x + i); u32x2 o; o.x = pk2(v[0], v[1]); o.y = pk2(v[2], v[3]); *(u32x2*)(xb + i) = o; }
}

__device__ __forceinline__ float gelu_tanh(float x) { const float u = 0.7978845608028654f * (x + 0.044715f * x * x * x); return 0.5f * x * (1.f + tanhf(u)); }
struct S5Args { const bf16_t* h; float* ys5; const float *lam_re, *lam_im, *log_dt, *b_re, *b_im, *c_re, *c_im, *dsk; };
__global__ void __launch_bounds__(64) k_s5scan(S5Args P) {
    const int b = blockIdx.x / S5G, g = blockIdx.x % S5G, n = threadIdx.x;
    const float lre = P.lam_re[g * S5N + n], lim = P.lam_im[g * S5N + n], dt = expf(P.log_dt[g]);
    const float a = lre * dt, bb = lim * dt;
    float sn, cs; sincosf(bb, &sn, &cs); const float er = expf(a); const float Lr = er * cs, Li = er * sn;
    const float sh = sinf(0.5f * bb); const float nr = expm1f(a) * cs - 2.f * sh * sh, ni = Li;
    const float den = lre * lre + lim * lim; const float fr = (nr * lre + ni * lim) / den, fi = (ni * lre - nr * lim) / den;
    float Br[S5P], Bi[S5P], Cr[S5P], Ci[S5P];
#pragma unroll
    for (int p = 0; p < S5P; ++p) { const float bre = P.b_re[(g * S5N + n) * S5P + p], bim = P.b_im[(g * S5N + n) * S5P + p];
        Br[p] = fr * bre - fi * bim; Bi[p] = fr * bim + fi * bre; Cr[p] = P.c_re[(g * S5P + p) * S5N + n]; Ci[p] = P.c_im[(g * S5P + p) * S5N + n]; }
    const float dsk = n < S5P ? P.dsk[g * S5P + n] : 0.f;
    float sr = 0.f, si = 0.f;
    for (int t = 0; t < SEQ; ++t) {
        const bf16_t* up = P.h + (size_t)(b * SEQ + t) * INP + C_S5 + g * S5P;
        const u32x4 w0 = *(const u32x4*)up, w1 = *(const u32x4*)(up + 8);
        float u[16];
#pragma unroll
        for (int j = 0; j < 4; ++j) { u[2 * j] = __uint_as_float(w0[j] << 16); u[2 * j + 1] = __uint_as_float(w0[j] & 0xffff0000u); u[8 + 2 * j] = __uint_as_float(w1[j] << 16); u[8 + 2 * j + 1] = __uint_as_float(w1[j] & 0xffff0000u); }
        float bur = 0.f, bui = 0.f;
#pragma unroll
        for (int p = 0; p < S5P; ++p) { bur += Br[p] * u[p]; bui += Bi[p] * u[p]; }
        const float nsr = Lr * sr - Li * si + bur, nsi = Lr * si + Li * sr + bui; sr = nsr; si = nsi;
        float yv = 0.f, uv = 0.f;
#pragma unroll
        for (int p = 0; p < S5P; ++p) { const float v = wave_sum(Cr[p] * sr - Ci[p] * si); if (n == p) { yv = v; uv = u[p]; } }
        if (n < S5P) P.ys5[(size_t)(b * SEQ + t) * 256 + g * S5P + n] = gelu_tanh(yv + dsk * uv);
    }
}
__global__ void __launch_bounds__(256) k_glu(const float* ys5, const float* W, const float* bias, bf16_t* mix) {
    __shared__ float yt[8][256];
    const int c = threadIdx.x; const int t0 = blockIdx.x * 8;
#pragma unroll
    for (int i = 0; i < 8; ++i) yt[i][c] = ys5[(size_t)(t0 + i) * 256 + c];
    __syncthreads();
    float acc[8];
#pragma unroll
    for (int i = 0; i < 8; ++i) acc[i] = bias[c];
    for (int k = 0; k < 256; ++k) { const float w = W[k * 256 + c];
#pragma unroll
        for (int i = 0; i < 8; ++i) acc[i] += yt[i][k] * w; }
#pragma unroll
    for (int i = 0; i < 8; ++i) mix[(size_t)(t0 + i) * DM + c] = (bf16_t)f2bf(yt[i][c] * sigmoidf_(acc[i]));
}

__global__ void __launch_bounds__(384) k_kmean(const bf16_t* h, float* kmean) {
    const int bb = blockIdx.x; const int c = threadIdx.x; float s = 0.f;
    const bf16_t* p = h + (size_t)bb * 256 * INP + C_MK + c;
    for (int r = 0; r < 256; ++r) s += bf2f(p[(size_t)r * INP]);
    kmean[bb * 384 + c] = s * (1.f / 256.f);
}
__global__ void __launch_bounds__(256) k_moba(const bf16_t* h, const float* kmean, bf16_t* mix) {
    const int wv = blockIdx.x * 4 + (threadIdx.x >> 6), lane = threadIdx.x & 63;
    const int hh = wv % NH, tok = wv / NH; const int b = tok / SEQ, q = tok % SEQ, qb = q >> 8;
    const float qv = bf2f(h[(size_t)tok * INP + C_MQ + hh * HD + lane]) * 0.125f;
    float gate[8];
#pragma unroll
    for (int j = 0; j < 8; ++j) { float gj = -INFINITY; if (j < qb) gj = wave_sum(qv * kmean[(b * 8 + j) * 384 + hh * HD + lane]); gate[j] = gj; }
    unsigned sel = 0;
#pragma unroll
    for (int j = 0; j < 8; ++j) { int rank = 0;
#pragma unroll
        for (int i = 0; i < 8; ++i) rank += (gate[i] > gate[j] || (gate[i] == gate[j] && i < j)) ? 1 : 0;
        if (j < qb && rank < 3) sel |= 1u << j; }
    sel |= 1u << qb;
    float qs[64];
#pragma unroll
    for (int d = 0; d < 64; ++d) qs[d] = __int_as_float(__builtin_amdgcn_readlane(__float_as_int(qv), d));
    float m = -1e30f, l = 0.f, o = 0.f;
    for (int j = 0; j <= qb; ++j) {
        if (!((sel >> j) & 1u)) continue;
        for (int tt = 0; tt < 4; ++tt) {
            const int k0 = j * 256 + tt * 64; if (k0 > q) break;
            const int key = k0 + lane;
            const bf16_t* kp = h + (size_t)(b * SEQ + key) * INP + C_MK + hh * HD;
            float s = 0.f;
#pragma unroll
            for (int c8 = 0; c8 < 8; ++c8) { const u32x4 w = *(const u32x4*)(kp + c8 * 8);
#pragma unroll
                for (int jj = 0; jj < 4; ++jj) { s += qs[c8 * 8 + 2 * jj] * __uint_as_float(w[jj] << 16); s += qs[c8 * 8 + 2 * jj + 1] * __uint_as_float(w[jj] & 0xffff0000u); } }
            if (key > q) s = -1e30f;
            float mx = s;
#pragma unroll
            for (int o2 = 1; o2 < 64; o2 <<= 1) mx = fmaxf(mx, __shfl_xor(mx, o2));
            const float mn = fmaxf(m, mx); const float sc = __expf(m - mn); const float p = (key > q) ? 0.f : __expf(s - mn);
            l = l * sc + wave_sum(p); o *= sc; m = mn;
            const bf16_t* vp = h + (size_t)(b * SEQ + k0) * INP + C_MV + hh * HD + lane;
#pragma unroll 16
            for (int kk = 0; kk < 64; ++kk) { const float pk = __int_as_float(__builtin_amdgcn_readlane(__float_as_int(p), kk)); o += pk * bf2f(vp[(size_t)kk * INP]); }
        }
    }
    mix[(size_t)tok * DM + 256 + hh * HD + lane] = (bf16_t)f2bf(o / l);
}

__global__ void __launch_bounds__(256) k_gdn_prep(const bf16_t* h, const float* conv_w, float* gqkv) {
    const int wv = blockIdx.x * 4 + (threadIdx.x >> 6), lane = threadIdx.x & 63;
    const int wh = wv % 18, tok = wv / 18; const int t = tok % SEQ; const int ch = wh * 64 + lane;
    float acc = 0.f;
#pragma unroll
    for (int j = 0; j < 4; ++j) { const int tt = t - 3 + j; if (tt >= 0) acc += conv_w[j * 1152 + ch] * bf2f(h[(size_t)(tok - 3 + j) * INP + C_GQ + ch]); }
    float v = siluf_(acc);
    if (wh < 12) { const float ss = wave_sum(v * v); v *= rsqrtf(ss + RMS_EPS); if (wh < 6) v *= 0.125f; }
    gqkv[(size_t)tok * 1152 + ch] = v;
}
struct GdnArgs { const float* gqkv; const float* aux; const bf16_t* h; bf16_t* mix; const float *a_log, *dt_bias, *norm_w; };
__global__ void __launch_bounds__(64) k_gdn_scan(GdnArgs P) {
    const int b = blockIdx.x / NH, hh = blockIdx.x % NH, e = threadIdx.x;
    const float Aneg = -expf(P.a_log[hh]), dtb = P.dt_bias[hh], nw = P.norm_w[e];
    float S[64];
#pragma unroll
    for (int d = 0; d < 64; ++d) S[d] = 0.f;
    for (int t = 0; t < SEQ; ++t) {
        const size_t tok = (size_t)b * SEQ + t;
        const float qd = P.gqkv[tok * 1152 + hh * 64 + e], kd = P.gqkv[tok * 1152 + 384 + hh * 64 + e], ve = P.gqkv[tok * 1152 + 768 + hh * 64 + e];
        const float av = P.aux[tok * 16 + hh] + dtb, bv = P.aux[tok * 16 + 6 + hh];
        const float sp = av > 20.f ? av : log1pf(expf(av)); const float alpha = expf(Aneg * sp), beta = sigmoidf_(bv);
        float kS = 0.f;
#pragma unroll
        for (int d = 0; d < 64; ++d) { const float kk = __int_as_float(__builtin_amdgcn_readlane(__float_as_int(kd), d)); S[d] *= alpha; kS += kk * S[d]; }
        const float vn = beta * (ve - kS);
        float o = 0.f;
#pragma unroll
        for (int d = 0; d < 64; ++d) { const float kk = __int_as_float(__builtin_amdgcn_readlane(__float_as_int(kd), d)); const float qq = __int_as_float(__builtin_amdgcn_readlane(__float_as_int(qd), d));
            S[d] += kk * vn; o += qq * S[d]; }
        const float ms = wave_sum(o * o) * (1.f / 64.f);
        const float z = bf2f(P.h[tok * INP + C_GZ + hh * 64 + e]);
        P.mix[tok * DM + 640 + hh * 64 + e] = (bf16_t)f2bf(o * rsqrtf(ms + RMS_EPS) * nw * siluf_(z));
    }
}

struct Ln1Args { const float* xin; const float* y; const float *g, *b; float* x1; bf16_t* x1b; const float* router; unsigned* ctl; int* tok_e; int* tok_p; float* tok_w; int* rowtok_v; int moe; int pad; };
__global__ void __launch_bounds__(256) k_ln1(Ln1Args P) {
    const int row = blockIdx.x * 4 + (threadIdx.x >> 6), lane = threadIdx.x & 63;
    const f32x4* xr = (const f32x4*)(P.xin + (size_t)row * DM) + lane; const f32x4* yr = (const f32x4*)(P.y + (size_t)row * DM) + lane;
    f32x4 v[4]; float s = 0.f;
#pragma unroll
    for (int j = 0; j < 4; ++j) { v[j] = xr[64 * j] * ALPHA + yr[64 * j]; s += (v[j][0] + v[j][1]) + (v[j][2] + v[j][3]); }
    const float mean = wave_sum(s) * (1.f / DM); float s2 = 0.f;
#pragma unroll
    for (int j = 0; j < 4; ++j) { v[j] = v[j] - mean; s2 += (v[j][0] * v[j][0] + v[j][1] * v[j][1]) + (v[j][2] * v[j][2] + v[j][3] * v[j][3]); }
    const float rstd = rsqrtf(wave_sum(s2) * (1.f / DM) + LN_EPS);
    float lg[8];
#pragma unroll
    for (int e = 0; e < 8; ++e) lg[e] = 0.f;
#pragma unroll
    for (int j = 0; j < 4; ++j) { const f32x4 gg = ((const f32x4*)P.g)[lane + 64 * j], bb = ((const f32x4*)P.b)[lane + 64 * j];
        v[j] = v[j] * rstd * gg + bb;
        ((f32x4*)(P.x1 + (size_t)row * DM))[lane + 64 * j] = v[j];
        u32x2 o; o.x = pk2(v[j][0], v[j][1]); o.y = pk2(v[j][2], v[j][3]); ((u32x2*)(P.x1b + (size_t)row * DM))[lane + 64 * j] = o;
        if (P.moe) {
#pragma unroll
            for (int c = 0; c < 4; ++c) { const f32x4* rp = (const f32x4*)(P.router + (size_t)(4 * (lane + 64 * j) + c) * 8); const f32x4 r0 = rp[0], r1 = rp[1];
                lg[0] += v[j][c] * r0[0]; lg[1] += v[j][c] * r0[1]; lg[2] += v[j][c] * r0[2]; lg[3] += v[j][c] * r0[3];
                lg[4] += v[j][c] * r1[0]; lg[5] += v[j][c] * r1[1]; lg[6] += v[j][c] * r1[2]; lg[7] += v[j][c] * r1[3]; } }
    }
    if (P.moe) {
#pragma unroll
        for (int e = 0; e < 8; ++e) lg[e] = wave_sum(lg[e]);
        int e1 = 0; float v1 = lg[0];
#pragma unroll
        for (int e = 1; e < 8; ++e) if (lg[e] > v1) { v1 = lg[e]; e1 = e; }
        int e2 = -1; float v2 = -INFINITY;
#pragma unroll
        for (int e = 0; e < 8; ++e) if (e != e1 && lg[e] > v2) { v2 = lg[e]; e2 = e; }
        const float w1 = 1.f / (1.f + __expf(v2 - v1)), w2 = 1.f - w1;
        if (lane == 0) {
            const int p1 = (int)atomicAdd(P.ctl + CW_CNT + e1, 1u), p2 = (int)atomicAdd(P.ctl + CW_CNT + e2, 1u);
            P.tok_e[row * 2] = e1; P.tok_e[row * 2 + 1] = e2; P.tok_p[row * 2] = p1; P.tok_p[row * 2 + 1] = p2; P.tok_w[row * 2] = w1; P.tok_w[row * 2 + 1] = w2;
            P.rowtok_v[e1 * MTOK + p1] = row; P.rowtok_v[e2 * MTOK + p2] = row;
        }
    }
}
__global__ void __launch_bounds__(256) k_permute(const bf16_t* x1b, bf16_t* xperm, unsigned* ctl, const int* rowtok_v, int* tile_e) {
    const int c = blockIdx.x * 4 + (threadIdx.x >> 6), lane = threadIdx.x & 63;
    int cnt[8], tb[9]; tb[0] = 0;
#pragma unroll
    for (int e = 0; e < 8; ++e) { cnt[e] = (int)ctl[CW_CNT + e]; tb[e + 1] = tb[e] + ((cnt[e] + 255) >> 8); }
    const int NT = tb[8];
    if (c == 0 && lane == 0) ctl[CW_NT] = (unsigned)NT;
    if (c >= NT * 256) return;
    const int tile = c >> 8; int e = 0, tbe = 0, cne = cnt[0];
#pragma unroll
    for (int i = 1; i < 8; ++i) if (tile >= tb[i]) { e = i; tbe = tb[i]; cne = cnt[i]; }
    if ((c & 255) == 0 && lane == 0) tile_e[tile] = e;
    const int pos = c - tbe * 256;
    u32x4 v0 = (u32x4){0u, 0u, 0u, 0u}, v1 = v0;
    if (pos < cne) { const int tok = rowtok_v[e * MTOK + pos]; const u32x4* s = (const u32x4*)(x1b + (size_t)tok * DM); v0 = s[lane]; v1 = s[lane + 64]; }
    u32x4* d = (u32x4*)(xperm + (size_t)c * DM); d[lane] = v0; d[lane + 64] = v1;
}
struct Ln2Args { const float* x1; const bf16_t* yp; const float *g, *b; float* xout; bf16_t* xb; const unsigned* ctl; const int* tok_e; const int* tok_p; const float* tok_w; int moe; int pad; };
__global__ void __launch_bounds__(256) k_ln2(Ln2Args P) {
    const int row = blockIdx.x * 4 + (threadIdx.x >> 6), lane = threadIdx.x & 63;
    int r1 = row, r2 = row; float w1 = 1.f, w2 = 0.f;
    if (P.moe) { int tb[9]; tb[0] = 0;
#pragma unroll
        for (int e = 0; e < 8; ++e) tb[e + 1] = tb[e] + (((int)P.ctl[CW_CNT + e] + 255) >> 8);
        const int e1 = P.tok_e[row * 2], e2 = P.tok_e[row * 2 + 1]; int b1 = 0, b2 = 0;
#pragma unroll
        for (int e = 0; e < 8; ++e) { if (e == e1) b1 = tb[e]; if (e == e2) b2 = tb[e]; }
        r1 = b1 * 256 + P.tok_p[row * 2]; r2 = b2 * 256 + P.tok_p[row * 2 + 1]; w1 = P.tok_w[row * 2]; w2 = P.tok_w[row * 2 + 1]; }
    const f32x4* xr = (const f32x4*)(P.x1 + (size_t)row * DM) + lane; const u32x2* y1 = (const u32x2*)(P.yp + (size_t)r1 * DM) + lane; const u32x2* y2 = (const u32x2*)(P.yp + (size_t)r2 * DM) + lane;
    f32x4 v[4]; float s = 0.f;
#pragma unroll
    for (int j = 0; j < 4; ++j) { const u32x2 a = y1[64 * j], c = y2[64 * j];
        f32x4 f; f[0] = w1 * __uint_as_float(a.x << 16) + w2 * __uint_as_float(c.x << 16); f[1] = w1 * __uint_as_float(a.x & 0xffff0000u) + w2 * __uint_as_float(c.x & 0xffff0000u);
        f[2] = w1 * __uint_as_float(a.y << 16) + w2 * __uint_as_float(c.y << 16); f[3] = w1 * __uint_as_float(a.y & 0xffff0000u) + w2 * __uint_as_float(c.y & 0xffff0000u);
        v[j] = xr[64 * j] * ALPHA + f; s += (v[j][0] + v[j][1]) + (v[j][2] + v[j][3]); }
    const float mean = wave_sum(s) * (1.f / DM); float s2 = 0.f;
#pragma unroll
    for (int j = 0; j < 4; ++j) { v[j] = v[j] - mean; s2 += (v[j][0] * v[j][0] + v[j][1] * v[j][1]) + (v[j][2] * v[j][2] + v[j][3] * v[j][3]); }
    const float rstd = rsqrtf(wave_sum(s2) * (1.f / DM) + LN_EPS);
#pragma unroll
    for (int j = 0; j < 4; ++j) { const f32x4 gg = ((const f32x4*)P.g)[lane + 64 * j], bb = ((const f32x4*)P.b)[lane + 64 * j];
        v[j] = v[j] * rstd * gg + bb;
        ((f32x4*)(P.xout + (size_t)row * DM))[lane + 64 * j] = v[j];
        u32x2 o; o.x = pk2(v[j][0], v[j][1]); o.y = pk2(v[j][2], v[j][3]); ((u32x2*)(P.xb + (size_t)row * DM))[lane + 64 * j] = o; }
}
__global__ void k_zero_cnt(unsigned* ctl) { if (threadIdx.x < 8) ctl[CW_CNT + threadIdx.x] = 0u; }

extern "C" void kernel_launch(void* const* d_in, const int* in_sizes, int n_in, void* d_out, int out_size, void* d_ws, size_t ws_size, hipStream_t stream) {
    static int ok = 0;
    if (ok == 0) {
        if (n_in != 28 || out_size != MTOK * DM || ws_size < WS_END) { fprintf(stderr, "kernel_launch: unexpected arguments (n_in %d out %d ws %zu)\n", n_in, out_size, ws_size); ok = -1; return; }
        (void)hipFuncSetAttribute((const void*)k_gemm<pg8::EpiF32>, hipFuncAttributeMaxDynamicSharedMemorySize, GEMM_LDS);
        (void)hipFuncSetAttribute((const void*)k_gemm<pg8::EpiBf16>, hipFuncAttributeMaxDynamicSharedMemorySize, GEMM_LDS);
        (void)hipFuncSetAttribute((const void*)k_gemm<pg8::EpiSwiglu>, hipFuncAttributeMaxDynamicSharedMemorySize, GEMM_LDS);
        ok = 1;
    }
    if (ok < 0) return;
    unsigned char* ws = (unsigned char*)d_ws;
    const float* const* in = (const float* const*)d_in;
    const float* x = in[0];
    unsigned* ctl = (unsigned*)(ws + WS_CTL);
    bf16_t* xb = (bf16_t*)(ws + WS_XB); float* X1 = (float*)(ws + WS_X1); bf16_t* x1b = (bf16_t*)(ws + WS_X1B);
    float* yf = (float*)(ws + WS_Y); bf16_t* ybf = (bf16_t*)(ws + WS_Y);
    bf16_t* hbuf = (bf16_t*)(ws + WS_R1 + R1_H); float* aux = (float*)(ws + WS_R1 + R1_AUX); bf16_t* mix = (bf16_t*)(ws + WS_R1 + R1_MIX);
    float* ys5 = (float*)(ws + WS_R1 + R1_YS5); float* gqkv = (float*)(ws + WS_R1 + R1_GQKV); float* kmean = (float*)(ws + WS_R1 + R1_KMEAN);
    bf16_t* Hbuf = (bf16_t*)(ws + WS_R1);
    int* tok_e = (int*)(ws + WS_MISC + MISC_TOKE); int* tok_p = (int*)(ws + WS_MISC + MISC_TOKP); float* tok_w = (float*)(ws + WS_MISC + MISC_TOKW);
    int* rowtok_v = (int*)(ws + WS_MISC + MISC_ROWTOKV); int* tile_e = (int*)(ws + WS_MISC + MISC_TILEE);
    float* X = (float*)d_out;

    (void)hipMemsetAsync(ws + WS_CTL, 0, 1 * MiB, stream);
    PrepArgs pa{in[1], in[2], in[21], in[22], in[23], in[25], in[26], in[27], ws};
    hipLaunchKernelGGL(k_prep, dim3(2048), dim3(512), 0, stream, pa);
    hipLaunchKernelGGL(k_cast_x, dim3(MTOK * DM / 4 / 256), dim3(256), 0, stream, x, xb);

    for (int l = 0; l < DEPTH; ++l) {
        const int moe = l & 1; const int slot0 = moe ? 2 + (l >> 1) * 8 : (l >> 1);
        { GemmLaunch L{xb, (const bf16_t*)(ws + WS_WIN) + (size_t)l * INP * DM, MTOK / 256, INP / 256, DM, 0, 0, nullptr, nullptr};
          pg8::EpiBf16 E{hbuf, aux, INP, 11};
          hipLaunchKernelGGL(k_gemm<pg8::EpiBf16>, dim3(256), dim3(512), GEMM_LDS, stream, L, E); }
        { S5Args a{hbuf, ys5, in[3] + l * S5G * S5N, in[4] + l * S5G * S5N, in[5] + l * S5G, in[6] + (size_t)l * S5G * S5N * S5P, in[7] + (size_t)l * S5G * S5N * S5P,
                   in[8] + (size_t)l * S5G * S5P * S5N, in[9] + (size_t)l * S5G * S5P * S5N, in[10] + l * S5G * S5P};
          hipLaunchKernelGGL(k_s5scan, dim3(BATCH * S5G), dim3(64), 0, stream, a);
          hipLaunchKernelGGL(k_glu, dim3(MTOK / 8), dim3(256), 0, stream, (const float*)ys5, in[11] + (size_t)l * 256 * 256, in[12] + l * 256, mix); }
        hipLaunchKernelGGL(k_kmean, dim3(BATCH * 8), dim3(384), 0, stream, (const bf16_t*)hbuf, kmean);
        hipLaunchKernelGGL(k_moba, dim3(MTOK * NH / 4), dim3(256), 0, stream, (const bf16_t*)hbuf, (const float*)kmean, mix);
        hipLaunchKernelGGL(k_gdn_prep, dim3(MTOK * 18 / 4), dim3(256), 0, stream, (const bf16_t*)hbuf, in[13] + (size_t)l * 4 * 1152, gqkv);
        { GdnArgs a{gqkv, aux, hbuf, mix, in[14] + l * NH, in[15] + l * NH, in[16] + l * HD};
          hipLaunchKernelGGL(k_gdn_scan, dim3(BATCH * NH), dim3(64), 0, stream, a); }
        { GemmLaunch L{mix, (const bf16_t*)(ws + WS_WOUT) + (size_t)l * DM * DM, MTOK / 256, DM / 256, DM, 0, 0, nullptr, nullptr};
          pg8::EpiF32 E{yf, DM, 0};
          hipLaunchKernelGGL(k_gemm<pg8::EpiF32>, dim3(256), dim3(512), GEMM_LDS, stream, L, E); }
        if (moe) hipLaunchKernelGGL(k_zero_cnt, dim3(1), dim3(64), 0, stream, ctl);
        { Ln1Args a{l == 0 ? x : (const float*)X, yf, in[17] + l * DM, in[18] + l * DM, X1, x1b, moe ? in[24] + (size_t)(l >> 1) * DM * NE : nullptr, ctl, tok_e, tok_p, tok_w, rowtok_v, moe, 0};
          hipLaunchKernelGGL(k_ln1, dim3(MTOK / 4), dim3(256), 0, stream, a); }
        const bf16_t* Aff = x1b;
        if (moe) { hipLaunchKernelGGL(k_permute, dim3(MAXT * 256 / 4), dim3(256), 0, stream, (const bf16_t*)x1b, ybf, ctl, (const int*)rowtok_v, tile_e); Aff = ybf; }
        { GemmLaunch L{Aff, (const bf16_t*)(ws + WS_WGU) + (size_t)slot0 * 2 * DFF * DM, MTOK / 256, 2 * DFF / 256, DM, 0, (size_t)2 * DFF * DM, moe ? tile_e : nullptr, moe ? ctl + CW_NT : nullptr};
          pg8::EpiSwiglu E{Hbuf, DFF, 0};
          hipLaunchKernelGGL(k_gemm<pg8::EpiSwiglu>, dim3(256), dim3(512), GEMM_LDS, stream, L, E); }
        { GemmLaunch L{Hbuf, (const bf16_t*)(ws + WS_WD) + (size_t)slot0 * DM * DFF, MTOK / 256, DM / 256, DFF, 0, (size_t)DM * DFF, moe ? tile_e : nullptr, moe ? ctl + CW_NT : nullptr};
          pg8::EpiBf16 E{ybf, nullptr, DM, -1};
          hipLaunchKernelGGL(k_gemm<pg8::EpiBf16>, dim3(256), dim3(512), GEMM_LDS, stream, L, E); }
        { Ln2Args a{X1, ybf, in[19] + l * DM, in[20] + l * DM, X, xb, ctl, tok_e, tok_p, tok_w, moe, 0};
          hipLaunchKernelGGL(k_ln2, dim3(MTOK / 4), dim3(256), 0, stream, a); }
    }
}
```

```cpp
#include <hip/hip_runtime.h>
#include <cstdio>
#include <cstdint>

constexpr int BATCH = 8, SEQ = 2048, DM = 1024, DEPTH = 4, MTOK = BATCH * SEQ;
constexpr int INC = 2956, INP = 3072;
constexpr int C_S5 = 0, C_MQ = 256, C_MK = 640, C_MV = 1024, C_GQ = 1408, C_GK = 1792, C_GV = 2176, C_GZ = 2560, C_GA = 2944;
constexpr int DFF = 3584, NE = 8;
constexpr int S5G = 16, S5P = 16, S5N = 64;
constexpr int NH = 6, HD = 64;
constexpr float ALPHA = 1.681792830507429f;
constexpr float LN_EPS = 1e-5f, RMS_EPS = 1e-6f;
constexpr int MAXT = 136;

constexpr size_t MiB = 1u << 20;
constexpr size_t WS_CTL = 0;
constexpr size_t WS_WIN = 1 * MiB;
constexpr size_t WS_WOUT = 25 * MiB;
constexpr size_t WS_WGU = 33 * MiB;
constexpr size_t WS_WD = 285 * MiB;
constexpr size_t WS_XB = 411 * MiB;
constexpr size_t WS_X1 = 443 * MiB;
constexpr size_t WS_X1B = 507 * MiB;
constexpr size_t WS_Y = 539 * MiB;
constexpr size_t WS_R1 = 607 * MiB;
constexpr size_t R1_H = 0, R1_AUX = 96 * MiB, R1_MIX = 97 * MiB, R1_YS5 = 129 * MiB, R1_GQKV = 145 * MiB, R1_KMEAN = 217 * MiB;
constexpr size_t WS_MISC = 845 * MiB;
constexpr size_t MISC_TOKE = 0, MISC_TOKP = 128 * 1024, MISC_TOKW = 256 * 1024, MISC_ROWTOKV = 384 * 1024  , MISC_TILEE = 896 * 1024;
constexpr size_t WS_END = 847 * MiB;
constexpr int CW_CNT = 64;
constexpr int CW_NT = 128;

typedef unsigned short bf16_t;
typedef short bf16x8 __attribute__((ext_vector_type(8)));
typedef float f32x4 __attribute__((ext_vector_type(4)));
typedef unsigned u32x4 __attribute__((ext_vector_type(4)));
typedef unsigned u32x2 __attribute__((ext_vector_type(2)));
#define LAS __attribute__((address_space(3)))

__device__ __forceinline__ float bf2f(bf16_t v) { return __uint_as_float(((unsigned)v) << 16); }
__device__ __forceinline__ unsigned f2bf(float f) { unsigned u = __float_as_uint(f); return (u + 0x7fffu + ((u >> 16) & 1u)) >> 16; }
__device__ __forceinline__ unsigned pk2(float lo, float hi) { return f2bf(lo) | (f2bf(hi) << 16); }
__device__ __forceinline__ float wave_sum(float v) {
#pragma unroll
    for (int o = 1; o < 64; o <<= 1) v += __shfl_xor(v, o);
    return v;
}
__device__ __forceinline__ int opaque(int v) { asm volatile("" : "+v"(v)); return v; }
__device__ __forceinline__ float sigmoidf_(float x) { return 1.f / (1.f + __expf(-x)); }
__device__ __forceinline__ float siluf_(float x) { return x / (1.f + __expf(-x)); }

namespace pg8 {
constexpr int BM = 256, BK = 64, HALF = 128, HTB = HALF * BK * 2, STAGE_BYTES = 8 * HTB, NXCD = 8, WGM = 8;
__host__ __device__ __forceinline__ int lds_byte(int r, int c) { const int st = (r >> 4) * 2 + (c >> 5), rr = r & 15, cc = c & 31, ob = rr * 64 + cc * 2; return st * 1024 + (ob ^ (((ob >> 9) & 1) << 5)); }
__host__ __device__ __forceinline__ void stage_rc(int b, int& R, int& C) { const int st = b / 1024, sb = b % 1024, swz = sb ^ (((sb >> 9) & 1) << 5); R = (st >> 1) * 16 + swz / 64; C = (st & 1) * 32 + (swz % 64) / 2; }
__host__ __device__ __forceinline__ int perm32(int rho) { const int n = rho >> 4, i = rho & 15; return 8 * (i >> 2) + 4 * n + (i & 3); }

struct Unit { int pm, pn, e; };
struct Gemm { const bf16_t* A; const bf16_t* Bt; int nM, nN, K; size_t bstride; const LAS int* tile_e; };

struct StaticOrder {
    int nM, nN, nwg, G, c; const LAS int* te;
    __device__ void init(int nM_, int nN_, int G_, int c_, const LAS int* te_) { nM = nM_; nN = nN_; nwg = nM * nN; G = G_; c = c_; te = te_; }
    __device__ bool next(int i, Unit& u) const {
        const long L = (long)i * G + c; if (L >= nwg) return false;
        int wgid = (int)L; { const int q = nwg / NXCD, r = nwg % NXCD, xcd = wgid % NXCD, off = wgid / NXCD; wgid = (xcd < r ? xcd * (q + 1) : r * (q + 1) + (xcd - r) * q) + off; }
        const int nig = WGM * nN, gid = wgid / nig, fm = gid * WGM, gsz = (nM - fm) < WGM ? (nM - fm) : WGM;
        u.pm = fm + ((wgid % nig) % gsz); u.pn = (wgid % nig) / gsz; u.e = te ? te[u.pm] : 0; return true;
    }
};

__device__ __forceinline__ unsigned cvt_pk_bf16(float lo, float hi) { unsigned r; asm volatile("v_cvt_pk_bf16_f32 %0, %1, %2" : "=v"(r) : "v"(lo), "v"(hi)); return r; }

struct EpiF32 {
    static constexpr bool PERM = false;
    float* C; int ldc; int pad;
    __device__ __forceinline__ void operator()(const f32x4 (&acc)[2][2][4][2], const Unit& u, int wr, int wc, int fr, int fq) const {
        const int row0 = u.pm * BM + wr * 64 + fr, col0 = u.pn * BM + wc * 32 + 4 * fq;
#pragma unroll
        for (int ai = 0; ai < 2; ++ai)
#pragma unroll
            for (int m = 0; m < 4; ++m) { float* rowp = C + (size_t)(row0 + ai * HALF + m * 16) * ldc + col0;
#pragma unroll
                for (int bj = 0; bj < 2; ++bj)
#pragma unroll
                    for (int n = 0; n < 2; ++n) *(f32x4*)(rowp + bj * HALF + n * 16) = acc[ai][bj][m][n]; }
    }
};
struct EpiBf16 {
    static constexpr bool PERM = true;
    bf16_t* O; float* aux; int ldc; int aux_pn;
    __device__ __forceinline__ void operator()(const f32x4 (&acc)[2][2][4][2], const Unit& u, int wr, int wc, int fr, int fq) const {
        const int row0 = u.pm * BM + wr * 64 + fr; const int col0 = u.pn * BM + wc * 32 + 8 * fq;
#pragma unroll
        for (int ai = 0; ai < 2; ++ai)
#pragma unroll
            for (int m = 0; m < 4; ++m) { bf16_t* rowp = O + (size_t)(row0 + ai * HALF + m * 16) * ldc + col0;
#pragma unroll
                for (int bj = 0; bj < 2; ++bj) { const f32x4 v0 = acc[ai][bj][m][0], v1 = acc[ai][bj][m][1];
                    u32x4 w; w.x = cvt_pk_bf16(v0[0], v0[1]); w.y = cvt_pk_bf16(v0[2], v0[3]); w.z = cvt_pk_bf16(v1[0], v1[1]); w.w = cvt_pk_bf16(v1[2], v1[3]);
                    *(u32x4*)(rowp + bj * HALF) = w; } }
        if (aux && u.pn == aux_pn && wc == 0 && fq < 2) {
#pragma unroll
            for (int ai = 0; ai < 2; ++ai)
#pragma unroll
                for (int m = 0; m < 4; ++m) { float* ap = aux + (size_t)(row0 + ai * HALF + m * 16) * 16 + 8 * fq;
                    *(f32x4*)(ap) = acc[ai][1][m][0]; *(f32x4*)(ap + 4) = acc[ai][1][m][1]; }
        }
    }
};
struct EpiSwiglu {
    static constexpr bool PERM = true;
    bf16_t* O; int ldc; int pad;
    __device__ __forceinline__ void operator()(const f32x4 (&acc)[2][2][4][2], const Unit& u, int wr, int wc, int fr, int fq) const {
        const int row0 = u.pm * BM + wr * 64 + fr; const int col0 = u.pn * HALF + wc * 32 + 8 * fq;
#pragma unroll
        for (int ai = 0; ai < 2; ++ai)
#pragma unroll
            for (int m = 0; m < 4; ++m) { bf16_t* rowp = O + (size_t)(row0 + ai * HALF + m * 16) * ldc + col0;
                float r[8];
#pragma unroll
                for (int n = 0; n < 2; ++n)
#pragma unroll
                    for (int j = 0; j < 4; ++j) { const float g = acc[ai][0][m][n][j], up = acc[ai][1][m][n][j];
                        r[n * 4 + j] = g * __builtin_amdgcn_rcpf(1.f + __builtin_amdgcn_exp2f(-1.4426950408889634f * g)) * up; }
                u32x4 w; w.x = cvt_pk_bf16(r[0], r[1]); w.y = cvt_pk_bf16(r[2], r[3]); w.z = cvt_pk_bf16(r[4], r[5]); w.w = cvt_pk_bf16(r[6], r[7]);
                *(u32x4*)(rowp) = w; }
    }
};

template <class Epi, bool ALIGN_EPI = true>
__device__ __forceinline__ void gemm_phase(LAS unsigned char* lds, const Gemm g, const StaticOrder& S, const Epi& E) {
    const int tid = opaque((int)threadIdx.x), wid = __builtin_amdgcn_readfirstlane(tid >> 6), lane = tid & 63, wr = wid >> 2, wc = wid & 3, fr = lane & 15, fq = lane >> 4;
    const int K = g.K, nt = K / BK;
    unsigned voffA[2], voffB[2];
#pragma unroll
    for (int i = 0; i < 2; ++i) { int R, C; stage_rc(tid * 16 + i * 8192, R, C); const int Rb = Epi::PERM ? ((R & ~31) + perm32(R & 31)) : R;
        voffA[i] = (unsigned)(R * K + C) * 2u; voffB[i] = (unsigned)(Rb * K + C) * 2u; }
    const size_t kstep = (size_t)(BK * 2);
    const size_t hstep = (size_t)HALF * K * 2;
    const size_t tstep = 2 * hstep;
    const unsigned ldsw = (unsigned)wid * 1024u;
    const int aoff = lds_byte(wr * 64 + fr, fq * 8), boff = lds_byte(wc * 32 + fr, fq * 8);
#define PG8_SA(b, h) (((b) * 2 + (h)) * HTB)
#define PG8_SB(b, h) ((4 + (b) * 2 + (h)) * HTB)
#define PG8_STAGE(bufoff, gbase, voff) do { _Pragma("unroll") for (int _i = 0; _i < 2; ++_i) \
        __builtin_amdgcn_global_load_lds((const unsigned*)((const char*)(gbase) + (voff)[_i]), (LAS unsigned*)(lds + (bufoff) + ldsw + _i * 8192), 16, 0, 0); } while (0)
#define PG8_LDA(dst, b, h) do { _Pragma("unroll") for (int m = 0; m < 4; ++m) _Pragma("unroll") for (int k = 0; k < 2; ++k) dst[m][k] = *(const LAS bf16x8*)(lds + PG8_SA(b, h) + aoff + m * 2048 + k * 1024); } while (0)
#define PG8_LDB(dst, b, h) do { _Pragma("unroll") for (int n = 0; n < 2; ++n) _Pragma("unroll") for (int k = 0; k < 2; ++k) dst[n][k] = *(const LAS bf16x8*)(lds + PG8_SB(b, h) + boff + n * 2048 + k * 1024); } while (0)
#define PG8_MMA(ai, bj, At, Bt) do { __builtin_amdgcn_s_setprio(1); _Pragma("unroll") for (int m = 0; m < 4; ++m) _Pragma("unroll") for (int n = 0; n < 2; ++n) _Pragma("unroll") for (int k = 0; k < 2; ++k) \
        acc[ai][bj][m][n] = __builtin_amdgcn_mfma_f32_16x16x32_bf16(Bt[n][k], At[m][k], acc[ai][bj][m][n], 0, 0, 0); __builtin_amdgcn_s_setprio(0); } while (0)
#define PG8_WAIT_V(n) asm volatile("s_waitcnt vmcnt(" #n ")" ::: "memory")
#define PG8_WAIT_L(n) asm volatile("s_waitcnt lgkmcnt(" #n ")" ::: "memory")
#define PG8_BAR __builtin_amdgcn_s_barrier()
#define PG8_SCHED __builtin_amdgcn_sched_barrier(0)
    Unit cur, nxt; int ui = 0;
    if (!S.next(0, cur)) return;
    f32x4 acc[2][2][4][2];
#pragma unroll
    for (int a = 0; a < 2; ++a)
#pragma unroll
        for (int b = 0; b < 2; ++b)
#pragma unroll
            for (int m = 0; m < 4; ++m)
#pragma unroll
                for (int n = 0; n < 2; ++n) acc[a][b][m][n] = (f32x4){0.f, 0.f, 0.f, 0.f};
    bf16x8 At[4][2], B0[2][2], B1[2][2];
    const char* cA = (const char*)g.A + (size_t)cur.pm * tstep; const char* cB = (const char*)(g.Bt + (size_t)cur.e * g.bstride) + (size_t)cur.pn * tstep;
    PG8_STAGE(PG8_SB(0, 0), cB, voffB); PG8_STAGE(PG8_SB(0, 1), cB + hstep, voffB); PG8_STAGE(PG8_SA(0, 0), cA, voffA); PG8_STAGE(PG8_SA(0, 1), cA + hstep, voffA);
    if (wr == 1) PG8_BAR;
    PG8_WAIT_V(2); PG8_BAR;
    PG8_STAGE(PG8_SB(1, 0), cB + kstep, voffB); PG8_STAGE(PG8_SA(1, 0), cA + kstep, voffA); PG8_STAGE(PG8_SB(1, 1), cB + hstep + kstep, voffB);
    PG8_WAIT_V(6); PG8_BAR;
    for (;;) {
        const bool has_next = S.next(ui + 1, nxt);
        const char* nA = has_next ? (const char*)g.A + (size_t)nxt.pm * tstep : cA; const char* nB = has_next ? (const char*)(g.Bt + (size_t)nxt.e * g.bstride) + (size_t)nxt.pn * tstep : cB;
        for (int t = 0; t < nt; t += 2) {
            const bool last = (t == nt - 2);
            const char* a1 = cA + (size_t)(t + 1) * kstep;
            const char* a2 = last ? nA : cA + (size_t)(t + 2) * kstep; const char* b2 = last ? nB : cB + (size_t)(t + 2) * kstep;
            const char* a3 = a2 + kstep; const char* b3 = b2 + kstep;
            PG8_LDB(B0, 0, 0); PG8_LDB(B1, 0, 1); PG8_SCHED; PG8_LDA(At, 0, 0); PG8_STAGE(PG8_SA(1, 1), a1 + hstep, voffA);
            PG8_WAIT_V(8); PG8_WAIT_L(0); PG8_BAR; PG8_MMA(0, 0, At, B0); PG8_MMA(0, 1, At, B1); PG8_BAR; PG8_SCHED;
            PG8_LDA(At, 0, 1); PG8_STAGE(PG8_SB(0, 0), b2, voffB); PG8_STAGE(PG8_SB(0, 1), b2 + hstep, voffB); PG8_STAGE(PG8_SA(0, 0), a2, voffA);
            PG8_WAIT_V(8); PG8_WAIT_L(0); PG8_BAR; PG8_MMA(1, 0, At, B0); PG8_MMA(1, 1, At, B1); PG8_BAR; PG8_SCHED;
            PG8_LDB(B0, 1, 0); PG8_LDB(B1, 1, 1); PG8_SCHED; PG8_LDA(At, 1, 0); PG8_STAGE(PG8_SA(0, 1), a2 + hstep, voffA);
            PG8_WAIT_V(8); PG8_WAIT_L(0); PG8_BAR; PG8_MMA(0, 0, At, B0); PG8_MMA(0, 1, At, B1); PG8_BAR; PG8_SCHED;
            PG8_LDA(At, 1, 1); PG8_STAGE(PG8_SB(1, 0), b3, voffB); PG8_STAGE(PG8_SB(1, 1), b3 + hstep, voffB); PG8_STAGE(PG8_SA(1, 0), a3, voffA);
            PG8_WAIT_V(8); PG8_WAIT_L(0); PG8_BAR; PG8_MMA(1, 0, At, B0); PG8_MMA(1, 1, At, B1); PG8_BAR; PG8_SCHED;
        }
        if constexpr (ALIGN_EPI) { if (wr == 0) PG8_BAR; }
        E(acc, cur, wr, wc, fr, fq);
        if (!has_next) break;
#pragma unroll
        for (int a = 0; a < 2; ++a)
#pragma unroll
            for (int b = 0; b < 2; ++b)
#pragma unroll
                for (int m = 0; m < 4; ++m)
#pragma unroll
                    for (int n = 0; n < 2; ++n) acc[a][b][m][n] = (f32x4){0.f, 0.f, 0.f, 0.f};
        cur = nxt; cA = nA; cB = nB; ++ui;
        if constexpr (ALIGN_EPI) { if (wr == 1) PG8_BAR; }
    }
    PG8_WAIT_V(0);
    if constexpr (!ALIGN_EPI) { if (wr == 0) PG8_BAR; }
    PG8_BAR;
#undef PG8_SA
#undef PG8_SB
#undef PG8_STAGE
#undef PG8_LDA
#undef PG8_LDB
#undef PG8_MMA
#undef PG8_WAIT_V
#undef PG8_WAIT_L
#undef PG8_BAR
#undef PG8_SCHED
}
}

constexpr int RING_BYTES = 131072;
constexpr int LDS_TE = RING_BYTES;
constexpr int LDS_MISC = RING_BYTES + 1024;
constexpr int LDS_BYTES = 147456;
constexpr int NWAVES = 8;

#define XB_TMO      128
#define XB_XCNT(j)  (256  + 64 * (j))
#define XB_XSUB(j)  (1280 + 64 * (j))
#define XB_XGEN(j)  (2304 + 64 * (j))
#define XB_TOP      3328
#define XB_TOPGEN   3392
#define XCD_BAR_WORDS 3456
#define XB_SPIN_CAP (1u << 18)
constexpr int CW_BAR = 4096;

__device__ __forceinline__ unsigned xb_ld(unsigned* p)              { return __hip_atomic_load(p, __ATOMIC_RELAXED, __HIP_MEMORY_SCOPE_AGENT); }
__device__ __forceinline__ unsigned xb_add(unsigned* p, unsigned v) { return __hip_atomic_fetch_add(p, v, __ATOMIC_RELAXED, __HIP_MEMORY_SCOPE_AGENT); }
__device__ __forceinline__ unsigned xb_xcc_id() { return (unsigned)__builtin_amdgcn_s_getreg((3 << 11) | 20) & 0xFu; }
#define XB_SPIN(cond, bar) do { unsigned _sp = 0; while (cond) { __builtin_amdgcn_s_sleep(1); \
    if ((++_sp & 255u) == 0u) { if (xb_ld(&(bar)[XB_TMO])) break; if (_sp > XB_SPIN_CAP) { atomicAdd(&(bar)[XB_TMO], 1u); break; } } } } while (0)
struct XcdBarrier { unsigned* bar; unsigned x; volatile LAS unsigned* st; };
__device__ __forceinline__ XcdBarrier xcd_barrier_post(unsigned* bar, volatile LAS unsigned* st) {
    XcdBarrier b; b.bar = bar; b.x = xb_xcc_id(); b.st = st;
    if (threadIdx.x == 0) (void)xb_add(&bar[XB_XCNT(b.x)], 1u);
    return b;
}
__device__ __forceinline__ void xcd_barrier_complete(unsigned* bar, unsigned x, unsigned& nloc, unsigned& nx) {
    const unsigned G = gridDim.x * gridDim.y * gridDim.z;
    unsigned sum, cnt, mine, sp = 0u;
    for (;;) {
        sum = 0u; cnt = 0u; mine = 0u;
#pragma unroll
        for (unsigned j = 0; j < 16; ++j) { const unsigned c = xb_ld(&bar[XB_XCNT(j)]); sum += c; cnt += (c > 0u) ? 1u : 0u; mine = (j == x) ? c : mine; }
        if (sum == G) break;
        __builtin_amdgcn_s_sleep(1);
        if ((++sp & 255u) == 0u) { if (xb_ld(&bar[XB_TMO])) break; if (sp > XB_SPIN_CAP) { atomicAdd(&bar[XB_TMO], 1u); break; } }
    }
    nloc = mine > 0u ? mine : 1u; nx = cnt > 0u ? cnt : 1u;
}
__device__ __forceinline__ void xcd_barrier(const XcdBarrier& b) {
    asm volatile("s_waitcnt vmcnt(0)" ::: "memory");
    __syncthreads();
    if (threadIdx.x == 0) {
        unsigned* bar = b.bar;
        const unsigned bx = xb_xcc_id();
        __builtin_amdgcn_s_waitcnt(0);
        unsigned nloc = b.st[0], nx = b.st[1];
        if (nloc == 0u) { xcd_barrier_complete(bar, bx, nloc, nx); b.st[0] = nloc; b.st[1] = nx; }
        const unsigned old = xb_add(&bar[XB_XSUB(bx)], 1u);
        const unsigned gen = old / nloc;
        if (old + 1u == (gen + 1u) * nloc) {
            __builtin_amdgcn_fence(__ATOMIC_RELEASE, "agent");
            asm volatile("s_waitcnt vmcnt(0)" ::: "memory");
            const unsigned og = xb_add(&bar[XB_TOP], 1u);
            const unsigned tg = og / nx;
            if (og + 1u == (tg + 1u) * nx) xb_add(&bar[XB_TOPGEN], 1u);
            else XB_SPIN(xb_ld(&bar[XB_TOPGEN]) == tg, bar);
            __builtin_amdgcn_fence(__ATOMIC_ACQUIRE, "agent");
            xb_add(&bar[XB_XGEN(bx)], 1u);
            asm volatile("s_waitcnt vmcnt(0)" ::: "memory");
        } else {
            XB_SPIN(xb_ld(&bar[XB_XGEN(bx)]) == gen, bar);
            __builtin_amdgcn_fence(__ATOMIC_ACQUIRE, "agent");
            asm volatile("s_waitcnt vmcnt(0)" ::: "memory");
        }
    }
    __syncthreads();
}

struct Params { const float* in[28]; float* out; unsigned char* ws; };

__device__ __forceinline__ void prep_tile(const float* src, int K, int N, bf16_t* dst, int mode, int kt, int ntile, LAS float* scr) {
    const int t = threadIdx.x; const int k0 = kt * 64, n0 = ntile * 64;
#pragma unroll
    for (int j = 0; j < 2; ++j) { const int r = (t >> 4) + 32 * j, c4 = (t & 15) * 4; const int n = n0 + c4;
        f32x4 v = (f32x4){0.f, 0.f, 0.f, 0.f}; if (n < N) v = *(const f32x4*)(src + (size_t)(k0 + r) * N + n);
        scr[r * 65 + c4 + 0] = v[0]; scr[r * 65 + c4 + 1] = v[1]; scr[r * 65 + c4 + 2] = v[2]; scr[r * 65 + c4 + 3] = v[3]; }
    __syncthreads();
    { const int nl = t >> 3, kc = (t & 7) * 8; const int n = n0 + nl;
      int drow; if (mode == 0) drow = n; else if (mode == 1) drow = 256 * (n >> 7) + (n & 127); else drow = 256 * (n >> 7) + 128 + (n & 127);
      u32x4 o; o.x = pk2(scr[(kc + 0) * 65 + nl], scr[(kc + 1) * 65 + nl]); o.y = pk2(scr[(kc + 2) * 65 + nl], scr[(kc + 3) * 65 + nl]);
      o.z = pk2(scr[(kc + 4) * 65 + nl], scr[(kc + 5) * 65 + nl]); o.w = pk2(scr[(kc + 6) * 65 + nl], scr[(kc + 7) * 65 + nl]);
      *(u32x4*)(dst + (size_t)drow * K + k0 + kc) = o; }
    __syncthreads();
}
__device__ __forceinline__ void phase_prep(const Params& P, LAS unsigned char* lds) {
    LAS float* s = (LAS float*)lds; unsigned char* ws = P.ws;
    constexpr int T_IN = 16 * 48, T_OUT = 16 * 16, T_GU = 16 * 56, T_D = 56 * 16;
    constexpr int N_IN = 4 * T_IN, N_OUT = 4 * T_OUT, N_G = 18 * T_GU, N_U = 18 * T_GU, N_D = 18 * T_D;
    constexpr int TOTAL = N_IN + N_OUT + N_G + N_U + N_D;
    for (int it = blockIdx.x; it < TOTAL; it += gridDim.x) {
        int r = it;
        if (r < N_IN) { const int l = r / T_IN, q = r % T_IN; prep_tile(P.in[1] + (size_t)l * DM * INC, DM, INC, (bf16_t*)(ws + WS_WIN) + (size_t)l * INP * DM, 0, q / 48, q % 48, s); continue; } r -= N_IN;
        if (r < N_OUT) { const int l = r / T_OUT, q = r % T_OUT; prep_tile(P.in[2] + (size_t)l * DM * DM, DM, DM, (bf16_t*)(ws + WS_WOUT) + (size_t)l * DM * DM, 0, q / 16, q % 16, s); continue; } r -= N_OUT;
        if (r < N_G + N_U) { const int up = r >= N_G; if (up) r -= N_G; const int sl = r / T_GU, q = r % T_GU;
            const float* src = sl < 2 ? (up ? P.in[22] : P.in[21]) + (size_t)sl * DM * DFF : (up ? P.in[26] : P.in[25]) + (size_t)(sl - 2) * DM * DFF;
            prep_tile(src, DM, DFF, (bf16_t*)(ws + WS_WGU) + (size_t)sl * 2 * DFF * DM, up ? 2 : 1, q / 56, q % 56, s); continue; } r -= N_G + N_U;
        { const int sl = r / T_D, q = r % T_D; const float* src = sl < 2 ? P.in[23] + (size_t)sl * DFF * DM : P.in[27] + (size_t)(sl - 2) * DFF * DM;
          prep_tile(src, DFF, DM, (bf16_t*)(ws + WS_WD) + (size_t)sl * DM * DFF, 0, q / 16, q % 16, s); }
    }
    const float* x = P.in[0]; bf16_t* xb = (bf16_t*)(ws + WS_XB);
    for (size_t i = ((size_t)blockIdx.x * 512 + threadIdx.x) * 4; i < (size_t)MTOK * DM; i += (size_t)gridDim.x * 512 * 4) {
        const f32x4 v = *(const f32x4*)(x + i); u32x2 o; o.x = pk2(v[0], v[1]); o.y = pk2(v[2], v[3]); *(u32x2*)(xb + i) = o; }
}

__device__ __forceinline__ float gelu_tanh(float x) { const float u = 0.7978845608028654f * (x + 0.044715f * x * x * x); return 0.5f * x * (1.f + tanhf(u)); }
__device__ __forceinline__ void s5scan_item(const Params& P, int l, int item, int n) {
    const bf16_t* h = (const bf16_t*)(P.ws + WS_R1 + R1_H); float* ys5 = (float*)(P.ws + WS_R1 + R1_YS5);
    const int b = item / S5G, g = item % S5G;
    const float* lam_re = P.in[3] + l * S5G * S5N; const float* lam_im = P.in[4] + l * S5G * S5N; const float* log_dt = P.in[5] + l * S5G;
    const float* b_re = P.in[6] + (size_t)l * S5G * S5N * S5P; const float* b_im = P.in[7] + (size_t)l * S5G * S5N * S5P;
    const float* c_re = P.in[8] + (size_t)l * S5G * S5P * S5N; const float* c_im = P.in[9] + (size_t)l * S5G * S5P * S5N; const float* dskp = P.in[10] + l * S5G * S5P;
    const float lre = lam_re[g * S5N + n], lim = lam_im[g * S5N + n], dt = expf(log_dt[g]);
    const float a = lre * dt, bb = lim * dt;
    float sn, cs; sincosf(bb, &sn, &cs); const float er = expf(a); const float Lr = er * cs, Li = er * sn;
    const float sh = sinf(0.5f * bb); const float nr = expm1f(a) * cs - 2.f * sh * sh, ni = Li;
    const float den = lre * lre + lim * lim; const float fr = (nr * lre + ni * lim) / den, fi = (ni * lre - nr * lim) / den;
    float Br[S5P], Bi[S5P], Cr[S5P], Ci[S5P];
#pragma unroll
    for (int p = 0; p < S5P; ++p) { const float bre = b_re[(g * S5N + n) * S5P + p], bim = b_im[(g * S5N + n) * S5P + p];
        Br[p] = fr * bre - fi * bim; Bi[p] = fr * bim + fi * bre; Cr[p] = c_re[(g * S5P + p) * S5N + n]; Ci[p] = c_im[(g * S5P + p) * S5N + n]; }
    const float dsk = n < S5P ? dskp[g * S5P + n] : 0.f;
    float sr = 0.f, si = 0.f;
    for (int t = 0; t < SEQ; ++t) {
        const bf16_t* up = h + (size_t)(b * SEQ + t) * INP + C_S5 + g * S5P;
        const u32x4 w0 = *(const u32x4*)up, w1 = *(const u32x4*)(up + 8);
        float u[16];
#pragma unroll
        for (int j = 0; j < 4; ++j) { u[2 * j] = __uint_as_float(w0[j] << 16); u[2 * j + 1] = __uint_as_float(w0[j] & 0xffff0000u); u[8 + 2 * j] = __uint_as_float(w1[j] << 16); u[8 + 2 * j + 1] = __uint_as_float(w1[j] & 0xffff0000u); }
        float bur = 0.f, bui = 0.f;
#pragma unroll
        for (int p = 0; p < S5P; ++p) { bur += Br[p] * u[p]; bui += Bi[p] * u[p]; }
        const float nsr = Lr * sr - Li * si + bur, nsi = Lr * si + Li * sr + bui; sr = nsr; si = nsi;
        float yv = 0.f, uv = 0.f;
#pragma unroll
        for (int p = 0; p < S5P; ++p) { const float v = wave_sum(Cr[p] * sr - Ci[p] * si); if (n == p) { yv = v; uv = u[p]; } }
        if (n < S5P) ys5[(size_t)(b * SEQ + t) * 256 + g * S5P + n] = gelu_tanh(yv + dsk * uv);
    }
}
__device__ __forceinline__ void glu_item(const Params& P, int l, int item, int lane) {
    const float* ys5 = (const float*)(P.ws + WS_R1 + R1_YS5); bf16_t* mix = (bf16_t*)(P.ws + WS_R1 + R1_MIX);
    const float* W = P.in[11] + (size_t)l * 256 * 256; const float* bias = P.in[12] + l * 256;
    const int t0 = (item >> 2) * 8, c = (item & 3) * 64 + lane;
    float acc[8];
#pragma unroll
    for (int i = 0; i < 8; ++i) acc[i] = bias[c];
    for (int k = 0; k < 256; k += 4) {
        const float w0 = W[(k + 0) * 256 + c], w1 = W[(k + 1) * 256 + c], w2 = W[(k + 2) * 256 + c], w3 = W[(k + 3) * 256 + c];
#pragma unroll
        for (int i = 0; i < 8; ++i) { const f32x4 y = *(const f32x4*)(ys5 + (size_t)(t0 + i) * 256 + k); acc[i] += y[0] * w0 + y[1] * w1 + y[2] * w2 + y[3] * w3; } }
#pragma unroll
    for (int i = 0; i < 8; ++i) mix[(size_t)(t0 + i) * DM + c] = (bf16_t)f2bf(ys5[(size_t)(t0 + i) * 256 + c] * sigmoidf_(acc[i]));
}

__device__ __forceinline__ void kmean_item(const Params& P, int item, int lane) {
    const bf16_t* h = (const bf16_t*)(P.ws + WS_R1 + R1_H); float* kmean = (float*)(P.ws + WS_R1 + R1_KMEAN);
    const int bb = item / 6, c = (item % 6) * 64 + lane; float s = 0.f;
    const bf16_t* p = h + (size_t)bb * 256 * INP + C_MK + c;
    for (int r = 0; r < 256; ++r) s += bf2f(p[(size_t)r * INP]);
    kmean[bb * 384 + c] = s * (1.f / 256.f);
}
__device__ __forceinline__ void moba_item(const Params& P, int wv, int lane) {
    const bf16_t* h = (const bf16_t*)(P.ws + WS_R1 + R1_H); const float* kmean = (const float*)(P.ws + WS_R1 + R1_KMEAN); bf16_t* mix = (bf16_t*)(P.ws + WS_R1 + R1_MIX);
    const int hh = wv % NH, tok = wv / NH; const int b = tok / SEQ, q = tok % SEQ, qb = q >> 8;
    const float qv = bf2f(h[(size_t)tok * INP + C_MQ + hh * HD + lane]) * 0.125f;
    float gate[8];
#pragma unroll
    for (int j = 0; j < 8; ++j) { float gj = -INFINITY; if (j < qb) gj = wave_sum(qv * kmean[(b * 8 + j) * 384 + hh * HD + lane]); gate[j] = gj; }
    unsigned sel = 0;
#pragma unroll
    for (int j = 0; j < 8; ++j) { int rank = 0;
#pragma unroll
        for (int i = 0; i < 8; ++i) rank += (gate[i] > gate[j] || (gate[i] == gate[j] && i < j)) ? 1 : 0;
        if (j < qb && rank < 3) sel |= 1u << j; }
    sel |= 1u << qb;
    float qs[64];
#pragma unroll
    for (int d = 0; d < 64; ++d) qs[d] = __int_as_float(__builtin_amdgcn_readlane(__float_as_int(qv), d));
    float m = -1e30f, lsum = 0.f, o = 0.f;
    for (int j = 0; j <= qb; ++j) {
        if (!((sel >> j) & 1u)) continue;
        for (int tt = 0; tt < 4; ++tt) {
            const int k0 = j * 256 + tt * 64; if (k0 > q) break;
            const int key = k0 + lane;
            const bf16_t* kp = h + (size_t)(b * SEQ + key) * INP + C_MK + hh * HD;
            float s = 0.f;
#pragma unroll
            for (int c8 = 0; c8 < 8; ++c8) { const u32x4 w = *(const u32x4*)(kp + c8 * 8);
#pragma unroll
                for (int jj = 0; jj < 4; ++jj) { s += qs[c8 * 8 + 2 * jj] * __uint_as_float(w[jj] << 16); s += qs[c8 * 8 + 2 * jj + 1] * __uint_as_float(w[jj] & 0xffff0000u); } }
            if (key > q) s = -1e30f;
            float mx = s;
#pragma unroll
            for (int o2 = 1; o2 < 64; o2 <<= 1) mx = fmaxf(mx, __shfl_xor(mx, o2));
            const float mn = fmaxf(m, mx); const float sc = __expf(m - mn); const float p = (key > q) ? 0.f : __expf(s - mn);
            lsum = lsum * sc + wave_sum(p); o *= sc; m = mn;
            const bf16_t* vp = h + (size_t)(b * SEQ + k0) * INP + C_MV + hh * HD + lane;
#pragma unroll 16
            for (int kk = 0; kk < 64; ++kk) { const float pk = __int_as_float(__builtin_amdgcn_readlane(__float_as_int(p), kk)); o += pk * bf2f(vp[(size_t)kk * INP]); }
        }
    }
    mix[(size_t)tok * DM + 256 + hh * HD + lane] = (bf16_t)f2bf(o / lsum);
}

__device__ __forceinline__ void gdn_prep_item(const Params& P, int l, int wv, int lane) {
    const bf16_t* h = (const bf16_t*)(P.ws + WS_R1 + R1_H); float* gqkv = (float*)(P.ws + WS_R1 + R1_GQKV); const float* conv_w = P.in[13] + (size_t)l * 4 * 1152;
    const int wh = wv % 18, tok = wv / 18; const int t = tok % SEQ; const int ch = wh * 64 + lane;
    float acc = 0.f;
#pragma unroll
    for (int j = 0; j < 4; ++j) { const int tt = t - 3 + j; if (tt >= 0) acc += conv_w[j * 1152 + ch] * bf2f(h[(size_t)(tok - 3 + j) * INP + C_GQ + ch]); }
    float v = siluf_(acc);
    if (wh < 12) { const float ss = wave_sum(v * v); v *= rsqrtf(ss + RMS_EPS); if (wh < 6) v *= 0.125f; }
    gqkv[(size_t)tok * 1152 + ch] = v;
}
__device__ __forceinline__ void gdn_scan_item(const Params& P, int l, int item, int e) {
    const float* gqkv = (const float*)(P.ws + WS_R1 + R1_GQKV); const float* aux = (const float*)(P.ws + WS_R1 + R1_AUX);
    const bf16_t* h = (const bf16_t*)(P.ws + WS_R1 + R1_H); bf16_t* mix = (bf16_t*)(P.ws + WS_R1 + R1_MIX);
    const int b = item / NH, hh = item % NH;
    const float Aneg = -expf(P.in[14][l * NH + hh]), dtb = P.in[15][l * NH + hh], nw = P.in[16][l * HD + e];
    float S[64];
#pragma unroll
    for (int d = 0; d < 64; ++d) S[d] = 0.f;
    for (int t = 0; t < SEQ; ++t) {
        const size_t tok = (size_t)b * SEQ + t;
        const float qd = gqkv[tok * 1152 + hh * 64 + e], kd = gqkv[tok * 1152 + 384 + hh * 64 + e], ve = gqkv[tok * 1152 + 768 + hh * 64 + e];
        const float av = aux[tok * 16 + hh] + dtb, bv = aux[tok * 16 + 6 + hh];
        const float sp = av > 20.f ? av : log1pf(expf(av)); const float alpha = expf(Aneg * sp), beta = sigmoidf_(bv);
        float kS = 0.f;
#pragma unroll
        for (int d = 0; d < 64; ++d) { const float kk = __int_as_float(__builtin_amdgcn_readlane(__float_as_int(kd), d)); S[d] *= alpha; kS += kk * S[d]; }
        const float vn = beta * (ve - kS);
        float o = 0.f;
#pragma unroll
        for (int d = 0; d < 64; ++d) { const float kk = __int_as_float(__builtin_amdgcn_readlane(__float_as_int(kd), d)); const float qq = __int_as_float(__builtin_amdgcn_readlane(__float_as_int(qd), d));
            S[d] += kk * vn; o += qq * S[d]; }
        const float ms = wave_sum(o * o) * (1.f / 64.f);
        const float z = bf2f(h[tok * INP + C_GZ + hh * 64 + e]);
        mix[tok * DM + 640 + hh * 64 + e] = (bf16_t)f2bf(o * rsqrtf(ms + RMS_EPS) * nw * siluf_(z));
    }
}

__device__ __forceinline__ void ln1_row(const Params& P, int l, int row, int lane) {
    unsigned char* ws = P.ws; const int moe = l & 1;
    const float* xin = l == 0 ? P.in[0] : (const float*)P.out; const float* y = (const float*)(ws + WS_Y);
    const float* g = P.in[17] + l * DM; const float* bvec = P.in[18] + l * DM;
    float* x1 = (float*)(ws + WS_X1); bf16_t* x1b = (bf16_t*)(ws + WS_X1B);
    const float* router = P.in[24] + (size_t)(l >> 1) * DM * NE;
    const f32x4* xr = (const f32x4*)(xin + (size_t)row * DM) + lane; const f32x4* yr = (const f32x4*)(y + (size_t)row * DM) + lane;
    f32x4 v[4]; float s = 0.f;
#pragma unroll
    for (int j = 0; j < 4; ++j) { v[j] = xr[64 * j] * ALPHA + yr[64 * j]; s += (v[j][0] + v[j][1]) + (v[j][2] + v[j][3]); }
    const float mean = wave_sum(s) * (1.f / DM); float s2 = 0.f;
#pragma unroll
    for (int j = 0; j < 4; ++j) { v[j] = v[j] - mean; s2 += (v[j][0] * v[j][0] + v[j][1] * v[j][1]) + (v[j][2] * v[j][2] + v[j][3] * v[j][3]); }
    const float rstd = rsqrtf(wave_sum(s2) * (1.f / DM) + LN_EPS);
    float lg[8];
#pragma unroll
    for (int e = 0; e < 8; ++e) lg[e] = 0.f;
#pragma unroll
    for (int j = 0; j < 4; ++j) { const f32x4 gg = ((const f32x4*)g)[lane + 64 * j], bb = ((const f32x4*)bvec)[lane + 64 * j];
        v[j] = v[j] * rstd * gg + bb;
        ((f32x4*)(x1 + (size_t)row * DM))[lane + 64 * j] = v[j];
        u32x2 o; o.x = pk2(v[j][0], v[j][1]); o.y = pk2(v[j][2], v[j][3]); ((u32x2*)(x1b + (size_t)row * DM))[lane + 64 * j] = o;
        if (moe) {
#pragma unroll
            for (int c = 0; c < 4; ++c) { const f32x4* rp = (const f32x4*)(router + (size_t)(4 * (lane + 64 * j) + c) * 8); const f32x4 r0 = rp[0], r1 = rp[1];
                lg[0] += v[j][c] * r0[0]; lg[1] += v[j][c] * r0[1]; lg[2] += v[j][c] * r0[2]; lg[3] += v[j][c] * r0[3];
                lg[4] += v[j][c] * r1[0]; lg[5] += v[j][c] * r1[1]; lg[6] += v[j][c] * r1[2]; lg[7] += v[j][c] * r1[3]; } }
    }
    if (moe) {
        unsigned* cntw = (unsigned*)(ws + WS_CTL) + CW_CNT + 16 * (l >> 1);
        int* tok_e = (int*)(ws + WS_MISC + MISC_TOKE); int* tok_p = (int*)(ws + WS_MISC + MISC_TOKP); float* tok_w = (float*)(ws + WS_MISC + MISC_TOKW); int* rowtok_v = (int*)(ws + WS_MISC + MISC_ROWTOKV);
#pragma unroll
        for (int e = 0; e < 8; ++e) lg[e] = wave_sum(lg[e]);
        int e1 = 0; float v1 = lg[0];
#pragma unroll
        for (int e = 1; e < 8; ++e) if (lg[e] > v1) { v1 = lg[e]; e1 = e; }
        int e2 = -1; float v2 = -INFINITY;
#pragma unroll
        for (int e = 0; e < 8; ++e) if (e != e1 && lg[e] > v2) { v2 = lg[e]; e2 = e; }
        const float w1 = 1.f / (1.f + __expf(v2 - v1)), w2 = 1.f - w1;
        if (lane == 0) {
            const int p1 = (int)atomicAdd(cntw + e1, 1u), p2 = (int)atomicAdd(cntw + e2, 1u);
            tok_e[row * 2] = e1; tok_e[row * 2 + 1] = e2; tok_p[row * 2] = p1; tok_p[row * 2 + 1] = p2; tok_w[row * 2] = w1; tok_w[row * 2 + 1] = w2;
            rowtok_v[e1 * MTOK + p1] = row; rowtok_v[e2 * MTOK + p2] = row;
        }
    }
}
__device__ __forceinline__ void permute_row(const Params& P, int l, int c, int lane) {
    unsigned char* ws = P.ws; unsigned* ctl = (unsigned*)(ws + WS_CTL); const unsigned* cntw = ctl + CW_CNT + 16 * (l >> 1);
    const bf16_t* x1b = (const bf16_t*)(ws + WS_X1B); bf16_t* xperm = (bf16_t*)(ws + WS_Y); const int* rowtok_v = (const int*)(ws + WS_MISC + MISC_ROWTOKV); int* tile_e = (int*)(ws + WS_MISC + MISC_TILEE);
    int cnt[8], tb[9]; tb[0] = 0;
#pragma unroll
    for (int e = 0; e < 8; ++e) { cnt[e] = (int)cntw[e]; tb[e + 1] = tb[e] + ((cnt[e] + 255) >> 8); }
    const int NT = tb[8];
    if (c == 0 && lane == 0) ctl[CW_NT] = (unsigned)NT;
    if (c >= NT * 256) return;
    const int tile = c >> 8; int e = 0, tbe = 0, cne = cnt[0];
#pragma unroll
    for (int i = 1; i < 8; ++i) if (tile >= tb[i]) { e = i; tbe = tb[i]; cne = cnt[i]; }
    if ((c & 255) == 0 && lane == 0) tile_e[tile] = e;
    const int pos = c - tbe * 256;
    u32x4 v0 = (u32x4){0u, 0u, 0u, 0u}, v1 = v0;
    if (pos < cne) { const int tok = rowtok_v[e * MTOK + pos]; const u32x4* s = (const u32x4*)(x1b + (size_t)tok * DM); v0 = s[lane]; v1 = s[lane + 64]; }
    u32x4* d = (u32x4*)(xperm + (size_t)c * DM); d[lane] = v0; d[lane + 64] = v1;
}
__device__ __forceinline__ void ln2_row(const Params& P, int l, int row, int lane) {
    unsigned char* ws = P.ws; const int moe = l & 1; const unsigned* cntw = (const unsigned*)(ws + WS_CTL) + CW_CNT + 16 * (l >> 1);
    const float* x1 = (const float*)(ws + WS_X1); const bf16_t* yp = (const bf16_t*)(ws + WS_Y); const float* g = P.in[19] + l * DM; const float* bvec = P.in[20] + l * DM;
    float* xout = P.out; bf16_t* xb = (bf16_t*)(ws + WS_XB);
    const int* tok_e = (const int*)(ws + WS_MISC + MISC_TOKE); const int* tok_p = (const int*)(ws + WS_MISC + MISC_TOKP); const float* tok_w = (const float*)(ws + WS_MISC + MISC_TOKW);
    int r1 = row, r2 = row; float w1 = 1.f, w2 = 0.f;
    if (moe) { int tb[9]; tb[0] = 0;
#pragma unroll
        for (int e = 0; e < 8; ++e) tb[e + 1] = tb[e] + (((int)cntw[e] + 255) >> 8);
        const int e1 = tok_e[row * 2], e2 = tok_e[row * 2 + 1]; int b1 = 0, b2 = 0;
#pragma unroll
        for (int e = 0; e < 8; ++e) { if (e == e1) b1 = tb[e]; if (e == e2) b2 = tb[e]; }
        r1 = b1 * 256 + tok_p[row * 2]; r2 = b2 * 256 + tok_p[row * 2 + 1]; w1 = tok_w[row * 2]; w2 = tok_w[row * 2 + 1]; }
    const f32x4* xr = (const f32x4*)(x1 + (size_t)row * DM) + lane; const u32x2* y1 = (const u32x2*)(yp + (size_t)r1 * DM) + lane; const u32x2* y2 = (const u32x2*)(yp + (size_t)r2 * DM) + lane;
    f32x4 v[4]; float s = 0.f;
#pragma unroll
    for (int j = 0; j < 4; ++j) { const u32x2 a = y1[64 * j], c = y2[64 * j];
        f32x4 f; f[0] = w1 * __uint_as_float(a.x << 16) + w2 * __uint_as_float(c.x << 16); f[1] = w1 * __uint_as_float(a.x & 0xffff0000u) + w2 * __uint_as_float(c.x & 0xffff0000u);
        f[2] = w1 * __uint_as_float(a.y << 16) + w2 * __uint_as_float(c.y << 16); f[3] = w1 * __uint_as_float(a.y & 0xffff0000u) + w2 * __uint_as_float(c.y & 0xffff0000u);
        v[j] = xr[64 * j] * ALPHA + f; s += (v[j][0] + v[j][1]) + (v[j][2] + v[j][3]); }
    const float mean = wave_sum(s) * (1.f / DM); float s2 = 0.f;
#pragma unroll
    for (int j = 0; j < 4; ++j) { v[j] = v[j] - mean; s2 += (v[j][0] * v[j][0] + v[j][1] * v[j][1]) + (v[j][2] * v[j][2] + v[j][3] * v[j][3]); }
    const float rstd = rsqrtf(wave_sum(s2) * (1.f / DM) + LN_EPS);
#pragma unroll
    for (int j = 0; j < 4; ++j) { const f32x4 gg = ((const f32x4*)g)[lane + 64 * j], bb = ((const f32x4*)bvec)[lane + 64 * j];
        v[j] = v[j] * rstd * gg + bb;
        ((f32x4*)(xout + (size_t)row * DM))[lane + 64 * j] = v[j];
        u32x2 o; o.x = pk2(v[j][0], v[j][1]); o.y = pk2(v[j][2], v[j][3]); ((u32x2*)(xb + (size_t)row * DM))[lane + 64 * j] = o; }
}

template <class Epi> __device__ __forceinline__ void run_gemm(LAS unsigned char* lds, const bf16_t* A, const bf16_t* Bt, int nM, int nN, int K, size_t bstride, const int* tile_e, const unsigned* nt_word, const Epi& E) {
    LAS int* te = (LAS int*)(lds + LDS_TE);
    if (nt_word) nM = (int)__builtin_amdgcn_readfirstlane(__hip_atomic_load(nt_word, __ATOMIC_RELAXED, __HIP_MEMORY_SCOPE_AGENT));
    if (tile_e) { const int t_ = opaque((int)threadIdx.x); if (t_ < nM) te[t_] = __hip_atomic_load(tile_e + t_, __ATOMIC_RELAXED, __HIP_MEMORY_SCOPE_AGENT); }
    __syncthreads();
    pg8::Gemm g{A, Bt, nM, nN, K, bstride, tile_e ? (const LAS int*)te : (const LAS int*)nullptr};
    pg8::StaticOrder S; S.init(nM, nN, (int)gridDim.x, (int)blockIdx.x, g.tile_e);
    pg8::gemm_phase<Epi, true>(lds, g, S, E);
}

__global__ void __launch_bounds__(512, 2) mega_fwd(Params P) {
    extern __shared__ __attribute__((aligned(16))) unsigned char smem[];
    LAS unsigned char* lds = (LAS unsigned char*)smem;
    volatile LAS unsigned* MISC = (volatile LAS unsigned*)(lds + LDS_MISC);
    const int tid = threadIdx.x, lane = tid & 63, wave = __builtin_amdgcn_readfirstlane(tid >> 6);
    const int G = gridDim.x, blk = blockIdx.x;
    unsigned char* ws = P.ws; unsigned* ctl = (unsigned*)(ws + WS_CTL);
    if (tid < 32) MISC[tid] = 0u;
    __syncthreads();
    XcdBarrier bar = xcd_barrier_post(ctl + CW_BAR, MISC + 8);
    const int gw = blk * NWAVES + wave, NGW = G * NWAVES;

    phase_prep(P, lds);
    xcd_barrier(bar);

    bf16_t* xb = (bf16_t*)(ws + WS_XB); bf16_t* x1b = (bf16_t*)(ws + WS_X1B); bf16_t* ybf = (bf16_t*)(ws + WS_Y); float* yf = (float*)(ws + WS_Y);
    bf16_t* hbuf = (bf16_t*)(ws + WS_R1 + R1_H); float* aux = (float*)(ws + WS_R1 + R1_AUX); bf16_t* mix = (bf16_t*)(ws + WS_R1 + R1_MIX); bf16_t* Hbuf = (bf16_t*)(ws + WS_R1);
    const int* tile_e = (const int*)(ws + WS_MISC + MISC_TILEE);

    for (int l = 0; l < DEPTH; ++l) {
        const int moe = l & 1; const int slot0 = moe ? 2 + (l >> 1) * 8 : (l >> 1);
        { pg8::EpiBf16 E{hbuf, aux, INP, 11};
          run_gemm(lds, xb, (const bf16_t*)(ws + WS_WIN) + (size_t)l * INP * DM, MTOK / 256, INP / 256, DM, 0, nullptr, nullptr, E); }
        xcd_barrier(bar);
        { const int ND = 128 < G ? 128 : G;
          if (wave == 0 && blk < ND) { for (int it = blk; it < BATCH * S5G; it += ND) s5scan_item(P, l, it, opaque(lane)); }
          else { const int widx = blk < ND ? blk * 7 + (wave - 1) : ND * 7 + (blk - ND) * 8 + wave, NW = ND * 7 + (G - ND) * 8;
                 for (int it = widx; it < MTOK * 18; it += NW) gdn_prep_item(P, l, it, opaque(lane));
                 for (int it = widx; it < BATCH * 8 * 6; it += NW) kmean_item(P, it, opaque(lane)); } }
        xcd_barrier(bar);
        { const int ND = 48 < G ? 48 : G;
          if (wave == 0 && blk < ND) { for (int it = blk; it < BATCH * NH; it += ND) gdn_scan_item(P, l, it, opaque(lane)); }
          else { const int widx = blk < ND ? blk * 7 + (wave - 1) : ND * 7 + (blk - ND) * 8 + wave, NW = ND * 7 + (G - ND) * 8;
                 for (int it = widx; it < (MTOK / 8) * 4; it += NW) glu_item(P, l, it, opaque(lane));
                 for (int it = widx; it < MTOK * NH; it += NW) moba_item(P, it, opaque(lane)); } }
        xcd_barrier(bar);
        { pg8::EpiF32 E{yf, DM, 0};
          run_gemm(lds, mix, (const bf16_t*)(ws + WS_WOUT) + (size_t)l * DM * DM, MTOK / 256, DM / 256, DM, 0, nullptr, nullptr, E); }
        xcd_barrier(bar);
        for (int r = gw; r < MTOK; r += NGW) ln1_row(P, l, r, opaque(lane));
        xcd_barrier(bar);
        if (moe) { for (int c = gw; c < MAXT * 256; c += NGW) permute_row(P, l, c, opaque(lane)); xcd_barrier(bar); }
        { pg8::EpiSwiglu E{Hbuf, DFF, 0};
          run_gemm(lds, moe ? (const bf16_t*)ybf : (const bf16_t*)x1b, (const bf16_t*)(ws + WS_WGU) + (size_t)slot0 * 2 * DFF * DM, MTOK / 256, 2 * DFF / 256, DM, (size_t)2 * DFF * DM,
                   moe ? tile_e : nullptr, moe ? ctl + CW_NT : nullptr, E); }
        xcd_barrier(bar);
        { pg8::EpiBf16 E{ybf, nullptr, DM, -1};
          run_gemm(lds, Hbuf, (const bf16_t*)(ws + WS_WD) + (size_t)slot0 * DM * DFF, MTOK / 256, DM / 256, DFF, (size_t)DM * DFF, moe ? tile_e : nullptr, moe ? ctl + CW_NT : nullptr, E); }
        xcd_barrier(bar);
        for (int r = gw; r < MTOK; r += NGW) ln2_row(P, l, r, opaque(lane));
        if (l + 1 < DEPTH) xcd_barrier(bar);
    }
}

extern "C" void kernel_launch(void* const* d_in, const int* in_sizes, int n_in, void* d_out, int out_size, void* d_ws, size_t ws_size, hipStream_t stream) {
    static int grid = 0;
    if (grid == 0) {
        if (n_in != 28 || out_size != MTOK * DM || ws_size < WS_END) { fprintf(stderr, "kernel_launch: unexpected arguments (n_in %d out %d ws %zu)\n", n_in, out_size, ws_size); grid = -1; return; }
        int dev = 0, cus = 0;
        if (hipGetDevice(&dev) != hipSuccess || hipDeviceGetAttribute(&cus, hipDeviceAttributeMultiprocessorCount, dev) != hipSuccess) { grid = -1; return; }
        if (hipFuncSetAttribute((const void*)mega_fwd, hipFuncAttributeMaxDynamicSharedMemorySize, LDS_BYTES) != hipSuccess) { fprintf(stderr, "kernel_launch: hipFuncSetAttribute failed\n"); grid = -1; return; }
        int per_cu = 0;
        if (hipOccupancyMaxActiveBlocksPerMultiprocessor(&per_cu, (const void*)mega_fwd, NWAVES * 64, LDS_BYTES) != hipSuccess || per_cu < 1) { fprintf(stderr, "kernel_launch: occupancy query says %d\n", per_cu); }
        (void)hipGetLastError();
        grid = cus;
    }
    if (grid < 0) return;
    (void)hipMemsetAsync((char*)d_ws + WS_CTL, 0, 1 * MiB, stream);
    Params p{};
    for (int i = 0; i < 28; ++i) p.in[i] = (const float*)d_in[i];
    p.out = (float*)d_out; p.ws = (unsigned char*)d_ws;
    hipLaunchKernelGGL(mega_fwd, dim3(grid), dim3(NWAVES * 64), LDS_BYTES, stream, p);
}
```

```cpp
#include <hip/hip_runtime.h>
#include <cstdio>
#include <cstdint>

constexpr int BATCH = 8, SEQ = 2048, DM = 1024, DEPTH = 4, MTOK = BATCH * SEQ;
constexpr int INC = 2956, INP = 3072;
constexpr int C_S5 = 0, C_MQ = 256, C_MK = 640, C_MV = 1024, C_GQ = 1408, C_GK = 1792, C_GV = 2176, C_GZ = 2560, C_GA = 2944;
constexpr int DFF = 3584, NE = 8;
constexpr int S5G = 16, S5P = 16, S5N = 64;
constexpr int NH = 6, HD = 64;
constexpr float ALPHA = 1.681792830507429f;
constexpr float LN_EPS = 1e-5f, RMS_EPS = 1e-6f;
constexpr int MAXT = 136;

constexpr size_t MiB = 1u << 20;
constexpr size_t WS_CTL = 0;
constexpr size_t WS_WIN = 1 * MiB;
constexpr size_t WS_WOUT = 25 * MiB;
constexpr size_t WS_WGU = 33 * MiB;
constexpr size_t WS_WD = 285 * MiB;
constexpr size_t WS_XB = 411 * MiB;
constexpr size_t WS_X1 = 443 * MiB;
constexpr size_t WS_X1B = 507 * MiB;
constexpr size_t WS_Y = 539 * MiB;
constexpr size_t WS_R1 = 607 * MiB;
constexpr size_t R1_H = 0, R1_AUX = 96 * MiB, R1_MIX = 97 * MiB, R1_YS5 = 129 * MiB, R1_GQKV = 145 * MiB, R1_KMEAN = 217 * MiB;
constexpr size_t WS_MISC = 845 * MiB;
constexpr size_t MISC_TOKE = 0, MISC_TOKP = 128 * 1024, MISC_TOKW = 256 * 1024, MISC_ROWTOKV = 384 * 1024  , MISC_TILEE = 896 * 1024;
constexpr size_t WS_END = 864 * MiB;
constexpr int CW_CNT = 64;
constexpr int CW_NT = 128;
constexpr int CW_Q = 192;

typedef unsigned short bf16_t;
typedef short bf16x8 __attribute__((ext_vector_type(8)));
typedef float f32x4 __attribute__((ext_vector_type(4)));
typedef unsigned u32x4 __attribute__((ext_vector_type(4)));
typedef unsigned u32x2 __attribute__((ext_vector_type(2)));
#define LAS __attribute__((address_space(3)))

__device__ __forceinline__ float bf2f(bf16_t v) { return __uint_as_float(((unsigned)v) << 16); }
__device__ __forceinline__ unsigned f2bf(float f) { unsigned u = __float_as_uint(f); return (u + 0x7fffu + ((u >> 16) & 1u)) >> 16; }
__device__ __forceinline__ unsigned pk2(float lo, float hi) { return f2bf(lo) | (f2bf(hi) << 16); }
__device__ __forceinline__ float wave_sum(float v) {
#pragma unroll
    for (int o = 1; o < 64; o <<= 1) v += __shfl_xor(v, o);
    return v;
}
__device__ __forceinline__ int opaque(int v) { asm volatile("" : "+v"(v)); return v; }
__device__ __forceinline__ float sigmoidf_(float x) { return 1.f / (1.f + __expf(-x)); }
__device__ __forceinline__ float siluf_(float x) { return x / (1.f + __expf(-x)); }

namespace pg8 {
constexpr int BM = 256, BK = 64, HALF = 128, HTB = HALF * BK * 2, STAGE_BYTES = 8 * HTB, NXCD = 8, WGM = 8;
__host__ __device__ __forceinline__ int lds_byte(int r, int c) { const int st = (r >> 4) * 2 + (c >> 5), rr = r & 15, cc = c & 31, ob = rr * 64 + cc * 2; return st * 1024 + (ob ^ (((ob >> 9) & 1) << 5)); }
__host__ __device__ __forceinline__ void stage_rc(int b, int& R, int& C) { const int st = b / 1024, sb = b % 1024, swz = sb ^ (((sb >> 9) & 1) << 5); R = (st >> 1) * 16 + swz / 64; C = (st & 1) * 32 + (swz % 64) / 2; }
__host__ __device__ __forceinline__ int perm32(int rho) { const int n = rho >> 4, i = rho & 15; return 8 * (i >> 2) + 4 * n + (i & 3); }

struct Unit { int pm, pn, e; };
struct Gemm { const bf16_t* A; const bf16_t* Bt; int nM, nN, K; size_t bstride; const LAS int* tile_e; };

struct StaticOrder {
    int nM, nN, nwg, G, c; const LAS int* te;
    __device__ void init(int nM_, int nN_, int G_, int c_, const LAS int* te_) { nM = nM_; nN = nN_; nwg = nM * nN; G = G_; c = c_; te = te_; }
    __device__ bool next(int i, Unit& u) const {
        const long L = (long)i * G + c; if (L >= nwg) return false;
        int wgid = (int)L; { const int q = nwg / NXCD, r = nwg % NXCD, xcd = wgid % NXCD, off = wgid / NXCD; wgid = (xcd < r ? xcd * (q + 1) : r * (q + 1) + (xcd - r) * q) + off; }
        const int nig = WGM * nN, gid = wgid / nig, fm = gid * WGM, gsz = (nM - fm) < WGM ? (nM - fm) : WGM;
        u.pm = fm + ((wgid % nig) % gsz); u.pn = (wgid % nig) / gsz; u.e = te ? te[u.pm] : 0; return true;
    }
};

__device__ __forceinline__ unsigned cvt_pk_bf16(float lo, float hi) { unsigned r; asm volatile("v_cvt_pk_bf16_f32 %0, %1, %2" : "=v"(r) : "v"(lo), "v"(hi)); return r; }

struct EpiF32 {
    static constexpr bool PERM = false;
    float* C; int ldc; int pad;
    __device__ __forceinline__ void operator()(const f32x4 (&acc)[2][2][4][2], const Unit& u, int wr, int wc, int fr, int fq) const {
        const int row0 = u.pm * BM + wr * 64 + fr, col0 = u.pn * BM + wc * 32 + 4 * fq;
#pragma unroll
        for (int ai = 0; ai < 2; ++ai)
#pragma unroll
            for (int m = 0; m < 4; ++m) { float* rowp = C + (size_t)(row0 + ai * HALF + m * 16) * ldc + col0;
#pragma unroll
                for (int bj = 0; bj < 2; ++bj)
#pragma unroll
                    for (int n = 0; n < 2; ++n) *(f32x4*)(rowp + bj * HALF + n * 16) = acc[ai][bj][m][n]; }
    }
};
struct EpiBf16 {
    static constexpr bool PERM = true;
    bf16_t* O; float* aux; int ldc; int aux_pn;
    __device__ __forceinline__ void operator()(const f32x4 (&acc)[2][2][4][2], const Unit& u, int wr, int wc, int fr, int fq) const {
        const int row0 = u.pm * BM + wr * 64 + fr; const int col0 = u.pn * BM + wc * 32 + 8 * fq;
#pragma unroll
        for (int ai = 0; ai < 2; ++ai)
#pragma unroll
            for (int m = 0; m < 4; ++m) { bf16_t* rowp = O + (size_t)(row0 + ai * HALF + m * 16) * ldc + col0;
#pragma unroll
                for (int bj = 0; bj < 2; ++bj) { const f32x4 v0 = acc[ai][bj][m][0], v1 = acc[ai][bj][m][1];
                    u32x4 w; w.x = cvt_pk_bf16(v0[0], v0[1]); w.y = cvt_pk_bf16(v0[2], v0[3]); w.z = cvt_pk_bf16(v1[0], v1[1]); w.w = cvt_pk_bf16(v1[2], v1[3]);
                    *(u32x4*)(rowp + bj * HALF) = w; } }
        if (aux && u.pn == aux_pn && wc == 0 && fq < 2) {
#pragma unroll
            for (int ai = 0; ai < 2; ++ai)
#pragma unroll
                for (int m = 0; m < 4; ++m) { float* ap = aux + (size_t)(row0 + ai * HALF + m * 16) * 16 + 8 * fq;
                    *(f32x4*)(ap) = acc[ai][1][m][0]; *(f32x4*)(ap + 4) = acc[ai][1][m][1]; }
        }
    }
};
struct EpiSwiglu {
    static constexpr bool PERM = true;
    bf16_t* O; int ldc; int pad;
    __device__ __forceinline__ void operator()(const f32x4 (&acc)[2][2][4][2], const Unit& u, int wr, int wc, int fr, int fq) const {
        const int row0 = u.pm * BM + wr * 64 + fr; const int col0 = u.pn * HALF + wc * 32 + 8 * fq;
#pragma unroll
        for (int ai = 0; ai < 2; ++ai)
#pragma unroll
            for (int m = 0; m < 4; ++m) { bf16_t* rowp = O + (size_t)(row0 + ai * HALF + m * 16) * ldc + col0;
                float r[8];
#pragma unroll
                for (int n = 0; n < 2; ++n)
#pragma unroll
                    for (int j = 0; j < 4; ++j) { const float g = acc[ai][0][m][n][j], up = acc[ai][1][m][n][j];
                        r[n * 4 + j] = g * __builtin_amdgcn_rcpf(1.f + __builtin_amdgcn_exp2f(-1.4426950408889634f * g)) * up; }
                u32x4 w; w.x = cvt_pk_bf16(r[0], r[1]); w.y = cvt_pk_bf16(r[2], r[3]); w.z = cvt_pk_bf16(r[4], r[5]); w.w = cvt_pk_bf16(r[6], r[7]);
                *(u32x4*)(rowp) = w; }
    }
};

template <class Epi, bool ALIGN_EPI = true>
__device__ __forceinline__ void gemm_phase(LAS unsigned char* lds, const Gemm g, const StaticOrder& S, const Epi& E) {
    const int tid = opaque((int)threadIdx.x), wid = __builtin_amdgcn_readfirstlane(tid >> 6), lane = tid & 63, wr = wid >> 2, wc = wid & 3, fr = lane & 15, fq = lane >> 4;
    const int K = g.K, nt = K / BK;
    unsigned voffA[2], voffB[2];
#pragma unroll
    for (int i = 0; i < 2; ++i) { int R, C; stage_rc(tid * 16 + i * 8192, R, C); const int Rb = Epi::PERM ? ((R & ~31) + perm32(R & 31)) : R;
        voffA[i] = (unsigned)(R * K + C) * 2u; voffB[i] = (unsigned)(Rb * K + C) * 2u; }
    const size_t kstep = (size_t)(BK * 2);
    const size_t hstep = (size_t)HALF * K * 2;
    const size_t tstep = 2 * hstep;
    const unsigned ldsw = (unsigned)wid * 1024u;
    const int aoff = lds_byte(wr * 64 + fr, fq * 8), boff = lds_byte(wc * 32 + fr, fq * 8);
#define PG8_SA(b, h) (((b) * 2 + (h)) * HTB)
#define PG8_SB(b, h) ((4 + (b) * 2 + (h)) * HTB)
#define PG8_STAGE(bufoff, gbase, voff) do { _Pragma("unroll") for (int _i = 0; _i < 2; ++_i) \
        __builtin_amdgcn_global_load_lds((const unsigned*)((const char*)(gbase) + (voff)[_i]), (LAS unsigned*)(lds + (bufoff) + ldsw + _i * 8192), 16, 0, 0); } while (0)
#define PG8_LDA(dst, b, h) do { _Pragma("unroll") for (int m = 0; m < 4; ++m) _Pragma("unroll") for (int k = 0; k < 2; ++k) dst[m][k] = *(const LAS bf16x8*)(lds + PG8_SA(b, h) + aoff + m * 2048 + k * 1024); } while (0)
#define PG8_LDB(dst, b, h) do { _Pragma("unroll") for (int n = 0; n < 2; ++n) _Pragma("unroll") for (int k = 0; k < 2; ++k) dst[n][k] = *(const LAS bf16x8*)(lds + PG8_SB(b, h) + boff + n * 2048 + k * 1024); } while (0)
#define PG8_MMA(ai, bj, At, Bt) do { __builtin_amdgcn_s_setprio(1); _Pragma("unroll") for (int m = 0; m < 4; ++m) _Pragma("unroll") for (int n = 0; n < 2; ++n) _Pragma("unroll") for (int k = 0; k < 2; ++k) \
        acc[ai][bj][m][n] = __builtin_amdgcn_mfma_f32_16x16x32_bf16(Bt[n][k], At[m][k], acc[ai][bj][m][n], 0, 0, 0); __builtin_amdgcn_s_setprio(0); } while (0)
#define PG8_WAIT_V(n) asm volatile("s_waitcnt vmcnt(" #n ")" ::: "memory")
#define PG8_WAIT_L(n) asm volatile("s_waitcnt lgkmcnt(" #n ")" ::: "memory")
#define PG8_BAR __builtin_amdgcn_s_barrier()
#define PG8_SCHED __builtin_amdgcn_sched_barrier(0)
    Unit cur, nxt; int ui = 0;
    if (!S.next(0, cur)) return;
    f32x4 acc[2][2][4][2];
#pragma unroll
    for (int a = 0; a < 2; ++a)
#pragma unroll
        for (int b = 0; b < 2; ++b)
#pragma unroll
            for (int m = 0; m < 4; ++m)
#pragma unroll
                for (int n = 0; n < 2; ++n) acc[a][b][m][n] = (f32x4){0.f, 0.f, 0.f, 0.f};
    bf16x8 At[4][2], B0[2][2], B1[2][2];
    const char* cA = (const char*)g.A + (size_t)cur.pm * tstep; const char* cB = (const char*)(g.Bt + (size_t)cur.e * g.bstride) + (size_t)cur.pn * tstep;
    PG8_STAGE(PG8_SB(0, 0), cB, voffB); PG8_STAGE(PG8_SB(0, 1), cB + hstep, voffB); PG8_STAGE(PG8_SA(0, 0), cA, voffA); PG8_STAGE(PG8_SA(0, 1), cA + hstep, voffA);
    if (wr == 1) PG8_BAR;
    PG8_WAIT_V(2); PG8_BAR;
    PG8_STAGE(PG8_SB(1, 0), cB + kstep, voffB); PG8_STAGE(PG8_SA(1, 0), cA + kstep, voffA); PG8_STAGE(PG8_SB(1, 1), cB + hstep + kstep, voffB);
    PG8_WAIT_V(6); PG8_BAR;
    for (;;) {
        const bool has_next = S.next(ui + 1, nxt);
        const char* nA = has_next ? (const char*)g.A + (size_t)nxt.pm * tstep : cA; const char* nB = has_next ? (const char*)(g.Bt + (size_t)nxt.e * g.bstride) + (size_t)nxt.pn * tstep : cB;
        for (int t = 0; t < nt; t += 2) {
            const bool last = (t == nt - 2);
            const char* a1 = cA + (size_t)(t + 1) * kstep;
            const char* a2 = last ? nA : cA + (size_t)(t + 2) * kstep; const char* b2 = last ? nB : cB + (size_t)(t + 2) * kstep;
            const char* a3 = a2 + kstep; const char* b3 = b2 + kstep;
            PG8_LDB(B0, 0, 0); PG8_LDB(B1, 0, 1); PG8_SCHED; PG8_LDA(At, 0, 0); PG8_STAGE(PG8_SA(1, 1), a1 + hstep, voffA);
            PG8_WAIT_V(8); PG8_WAIT_L(0); PG8_BAR; PG8_MMA(0, 0, At, B0); PG8_MMA(0, 1, At, B1); PG8_BAR; PG8_SCHED;
            PG8_LDA(At, 0, 1); PG8_STAGE(PG8_SB(0, 0), b2, voffB); PG8_STAGE(PG8_SB(0, 1), b2 + hstep, voffB); PG8_STAGE(PG8_SA(0, 0), a2, voffA);
            PG8_WAIT_V(8); PG8_WAIT_L(0); PG8_BAR; PG8_MMA(1, 0, At, B0); PG8_MMA(1, 1, At, B1); PG8_BAR; PG8_SCHED;
            PG8_LDB(B0, 1, 0); PG8_LDB(B1, 1, 1); PG8_SCHED; PG8_LDA(At, 1, 0); PG8_STAGE(PG8_SA(0, 1), a2 + hstep, voffA);
            PG8_WAIT_V(8); PG8_WAIT_L(0); PG8_BAR; PG8_MMA(0, 0, At, B0); PG8_MMA(0, 1, At, B1); PG8_BAR; PG8_SCHED;
            PG8_LDA(At, 1, 1); PG8_STAGE(PG8_SB(1, 0), b3, voffB); PG8_STAGE(PG8_SB(1, 1), b3 + hstep, voffB); PG8_STAGE(PG8_SA(1, 0), a3, voffA);
            PG8_WAIT_V(8); PG8_WAIT_L(0); PG8_BAR; PG8_MMA(1, 0, At, B0); PG8_MMA(1, 1, At, B1); PG8_BAR; PG8_SCHED;
        }
        if constexpr (ALIGN_EPI) { if (wr == 0) PG8_BAR; }
        E(acc, cur, wr, wc, fr, fq);
        if (!has_next) break;
#pragma unroll
        for (int a = 0; a < 2; ++a)
#pragma unroll
            for (int b = 0; b < 2; ++b)
#pragma unroll
                for (int m = 0; m < 4; ++m)
#pragma unroll
                    for (int n = 0; n < 2; ++n) acc[a][b][m][n] = (f32x4){0.f, 0.f, 0.f, 0.f};
        cur = nxt; cA = nA; cB = nB; ++ui;
        if constexpr (ALIGN_EPI) { if (wr == 1) PG8_BAR; }
    }
    PG8_WAIT_V(0);
    if constexpr (!ALIGN_EPI) { if (wr == 0) PG8_BAR; }
    PG8_BAR;
#undef PG8_SA
#undef PG8_SB
#undef PG8_STAGE
#undef PG8_LDA
#undef PG8_LDB
#undef PG8_MMA
#undef PG8_WAIT_V
#undef PG8_WAIT_L
#undef PG8_BAR
#undef PG8_SCHED
}
}

constexpr int RING_BYTES = 131072;
constexpr int LDS_TE = RING_BYTES;
constexpr int LDS_MISC = RING_BYTES + 1024;
constexpr int LDS_BYTES = 147456;
constexpr int NWAVES = 8;

#define XB_TMO      128
#define XB_XCNT(j)  (256  + 64 * (j))
#define XB_XSUB(j)  (1280 + 64 * (j))
#define XB_XGEN(j)  (2304 + 64 * (j))
#define XB_TOP      3328
#define XB_TOPGEN   3392
#define XCD_BAR_WORDS 3456
#define XB_SPIN_CAP (1u << 18)
constexpr int CW_BAR = 4096;

__device__ __forceinline__ unsigned xb_ld(unsigned* p)              { return __hip_atomic_load(p, __ATOMIC_RELAXED, __HIP_MEMORY_SCOPE_AGENT); }
__device__ __forceinline__ unsigned xb_add(unsigned* p, unsigned v) { return __hip_atomic_fetch_add(p, v, __ATOMIC_RELAXED, __HIP_MEMORY_SCOPE_AGENT); }
__device__ __forceinline__ unsigned xb_xcc_id() { return (unsigned)__builtin_amdgcn_s_getreg((3 << 11) | 20) & 0xFu; }
#define XB_SPIN(cond, bar) do { unsigned _sp = 0; while (cond) { __builtin_amdgcn_s_sleep(1); \
    if ((++_sp & 255u) == 0u) { if (xb_ld(&(bar)[XB_TMO])) break; if (_sp > XB_SPIN_CAP) { atomicAdd(&(bar)[XB_TMO], 1u); break; } } } } while (0)
struct XcdBarrier { unsigned* bar; unsigned x; volatile LAS unsigned* st; };
__device__ __forceinline__ XcdBarrier xcd_barrier_post(unsigned* bar, volatile LAS unsigned* st) {
    XcdBarrier b; b.bar = bar; b.x = xb_xcc_id(); b.st = st;
    if (threadIdx.x == 0) (void)xb_add(&bar[XB_XCNT(b.x)], 1u);
    return b;
}
__device__ __forceinline__ void xcd_barrier_complete(unsigned* bar, unsigned x, unsigned& nloc, unsigned& nx) {
    const unsigned G = gridDim.x * gridDim.y * gridDim.z;
    unsigned sum, cnt, mine, sp = 0u;
    for (;;) {
        sum = 0u; cnt = 0u; mine = 0u;
#pragma unroll
        for (unsigned j = 0; j < 16; ++j) { const unsigned c = xb_ld(&bar[XB_XCNT(j)]); sum += c; cnt += (c > 0u) ? 1u : 0u; mine = (j == x) ? c : mine; }
        if (sum == G) break;
        __builtin_amdgcn_s_sleep(1);
        if ((++sp & 255u) == 0u) { if (xb_ld(&bar[XB_TMO])) break; if (sp > XB_SPIN_CAP) { atomicAdd(&bar[XB_TMO], 1u); break; } }
    }
    nloc = mine > 0u ? mine : 1u; nx = cnt > 0u ? cnt : 1u;
}
__device__ __forceinline__ void xcd_barrier(const XcdBarrier& b) {
    asm volatile("s_waitcnt vmcnt(0)" ::: "memory");
    __syncthreads();
    if (threadIdx.x == 0) {
        unsigned* bar = b.bar;
        const unsigned bx = xb_xcc_id();
        __builtin_amdgcn_s_waitcnt(0);
        unsigned nloc = b.st[0], nx = b.st[1];
        if (nloc == 0u) { xcd_barrier_complete(bar, bx, nloc, nx); b.st[0] = nloc; b.st[1] = nx; }
        const unsigned old = xb_add(&bar[XB_XSUB(bx)], 1u);
        const unsigned gen = old / nloc;
        if (old + 1u == (gen + 1u) * nloc) {
            __builtin_amdgcn_fence(__ATOMIC_RELEASE, "agent");
            asm volatile("s_waitcnt vmcnt(0)" ::: "memory");
            const unsigned og = xb_add(&bar[XB_TOP], 1u);
            const unsigned tg = og / nx;
            if (og + 1u == (tg + 1u) * nx) xb_add(&bar[XB_TOPGEN], 1u);
            else XB_SPIN(xb_ld(&bar[XB_TOPGEN]) == tg, bar);
            __builtin_amdgcn_fence(__ATOMIC_ACQUIRE, "agent");
            xb_add(&bar[XB_XGEN(bx)], 1u);
            asm volatile("s_waitcnt vmcnt(0)" ::: "memory");
        } else {
            XB_SPIN(xb_ld(&bar[XB_XGEN(bx)]) == gen, bar);
            __builtin_amdgcn_fence(__ATOMIC_ACQUIRE, "agent");
            asm volatile("s_waitcnt vmcnt(0)" ::: "memory");
        }
    }
    __syncthreads();
}

struct Params { const float* in[28]; float* out; unsigned char* ws; };

__device__ __forceinline__ void prep_tile(const float* src, int K, int N, bf16_t* dst, int mode, int kt, int ntile, LAS float* scr) {
    const int t = threadIdx.x; const int k0 = kt * 64, n0 = ntile * 64;
#pragma unroll
    for (int j = 0; j < 2; ++j) { const int r = (t >> 4) + 32 * j, c4 = (t & 15) * 4; const int n = n0 + c4;
        f32x4 v = (f32x4){0.f, 0.f, 0.f, 0.f}; if (n < N) v = *(const f32x4*)(src + (size_t)(k0 + r) * N + n);
        scr[r * 65 + c4 + 0] = v[0]; scr[r * 65 + c4 + 1] = v[1]; scr[r * 65 + c4 + 2] = v[2]; scr[r * 65 + c4 + 3] = v[3]; }
    __syncthreads();
    { const int nl = t >> 3, kc = (t & 7) * 8; const int n = n0 + nl;
      int drow; if (mode == 0) drow = n; else if (mode == 1) drow = 256 * (n >> 7) + (n & 127); else drow = 256 * (n >> 7) + 128 + (n & 127);
      u32x4 o; o.x = pk2(scr[(kc + 0) * 65 + nl], scr[(kc + 1) * 65 + nl]); o.y = pk2(scr[(kc + 2) * 65 + nl], scr[(kc + 3) * 65 + nl]);
      o.z = pk2(scr[(kc + 4) * 65 + nl], scr[(kc + 5) * 65 + nl]); o.w = pk2(scr[(kc + 6) * 65 + nl], scr[(kc + 7) * 65 + nl]);
      *(u32x4*)(dst + (size_t)drow * K + k0 + kc) = o; }
    __syncthreads();
}
__device__ __forceinline__ void phase_prep(const Params& P, LAS unsigned char* lds) {
    LAS float* s = (LAS float*)lds; unsigned char* ws = P.ws;
    constexpr int T_IN = 16 * 48, T_OUT = 16 * 16, T_GU = 16 * 56, T_D = 56 * 16;
    constexpr int N_IN = 4 * T_IN, N_OUT = 4 * T_OUT, N_G = 18 * T_GU, N_U = 18 * T_GU, N_D = 18 * T_D;
    constexpr int TOTAL = N_IN + N_OUT + N_G + N_U + N_D;
    for (int it = blockIdx.x; it < TOTAL; it += gridDim.x) {
        int r = it;
        if (r < N_IN) { const int l = r / T_IN, q = r % T_IN; prep_tile(P.in[1] + (size_t)l * DM * INC, DM, INC, (bf16_t*)(ws + WS_WIN) + (size_t)l * INP * DM, 0, q / 48, q % 48, s); continue; } r -= N_IN;
        if (r < N_OUT) { const int l = r / T_OUT, q = r % T_OUT; prep_tile(P.in[2] + (size_t)l * DM * DM, DM, DM, (bf16_t*)(ws + WS_WOUT) + (size_t)l * DM * DM, 0, q / 16, q % 16, s); continue; } r -= N_OUT;
        if (r < N_G + N_U) { const int up = r >= N_G; if (up) r -= N_G; const int sl = r / T_GU, q = r % T_GU;
            const float* src = sl < 2 ? (up ? P.in[22] : P.in[21]) + (size_t)sl * DM * DFF : (up ? P.in[26] : P.in[25]) + (size_t)(sl - 2) * DM * DFF;
            prep_tile(src, DM, DFF, (bf16_t*)(ws + WS_WGU) + (size_t)sl * 2 * DFF * DM, up ? 2 : 1, q / 56, q % 56, s); continue; } r -= N_G + N_U;
        { const int sl = r / T_D, q = r % T_D; const float* src = sl < 2 ? P.in[23] + (size_t)sl * DFF * DM : P.in[27] + (size_t)(sl - 2) * DFF * DM;
          prep_tile(src, DFF, DM, (bf16_t*)(ws + WS_WD) + (size_t)sl * DM * DFF, 0, q / 16, q % 16, s); }
    }
    const float* x = P.in[0]; bf16_t* xb = (bf16_t*)(ws + WS_XB);
    for (size_t i = ((size_t)blockIdx.x * 512 + threadIdx.x) * 4; i < (size_t)MTOK * DM; i += (size_t)gridDim.x * 512 * 4) {
        const f32x4 v = *(const f32x4*)(x + i); u32x2 o; o.x = pk2(v[0], v[1]); o.y = pk2(v[2], v[3]); *(u32x2*)(xb + i) = o; }
}

__device__ __forceinline__ float gelu_tanh(float x) { const float u = 0.7978845608028654f * (x + 0.044715f * x * x * x); return 0.5f * x * (1.f + tanhf(u)); }
__device__ __forceinline__ void s5scan_item(const Params& P, int l, int item, int n) {
    const bf16_t* h = (const bf16_t*)(P.ws + WS_R1 + R1_H); float* ys5 = (float*)(P.ws + WS_R1 + R1_YS5);
    const int b = item / S5G, g = item % S5G;
    const float* lam_re = P.in[3] + l * S5G * S5N; const float* lam_im = P.in[4] + l * S5G * S5N; const float* log_dt = P.in[5] + l * S5G;
    const float* b_re = P.in[6] + (size_t)l * S5G * S5N * S5P; const float* b_im = P.in[7] + (size_t)l * S5G * S5N * S5P;
    const float* c_re = P.in[8] + (size_t)l * S5G * S5P * S5N; const float* c_im = P.in[9] + (size_t)l * S5G * S5P * S5N; const float* dskp = P.in[10] + l * S5G * S5P;
    const float lre = lam_re[g * S5N + n], lim = lam_im[g * S5N + n], dt = expf(log_dt[g]);
    const float a = lre * dt, bb = lim * dt;
    float sn, cs; sincosf(bb, &sn, &cs); const float er = expf(a); const float Lr = er * cs, Li = er * sn;
    const float sh = sinf(0.5f * bb); const float nr = expm1f(a) * cs - 2.f * sh * sh, ni = Li;
    const float den = lre * lre + lim * lim; const float fr = (nr * lre + ni * lim) / den, fi = (ni * lre - nr * lim) / den;
    float Br[S5P], Bi[S5P], Cr[S5P], Ci[S5P];
#pragma unroll
    for (int p = 0; p < S5P; ++p) { const float bre = b_re[(g * S5N + n) * S5P + p], bim = b_im[(g * S5N + n) * S5P + p];
        Br[p] = fr * bre - fi * bim; Bi[p] = fr * bim + fi * bre; Cr[p] = c_re[(g * S5P + p) * S5N + n]; Ci[p] = c_im[(g * S5P + p) * S5N + n]; }
    const float dsk = n < S5P ? dskp[g * S5P + n] : 0.f;
    float sr = 0.f, si = 0.f;
    for (int t = 0; t < SEQ; ++t) {
        const bf16_t* up = h + (size_t)(b * SEQ + t) * INP + C_S5 + g * S5P;
        const u32x4 w0 = *(const u32x4*)up, w1 = *(const u32x4*)(up + 8);
        float u[16];
#pragma unroll
        for (int j = 0; j < 4; ++j) { u[2 * j] = __uint_as_float(w0[j] << 16); u[2 * j + 1] = __uint_as_float(w0[j] & 0xffff0000u); u[8 + 2 * j] = __uint_as_float(w1[j] << 16); u[8 + 2 * j + 1] = __uint_as_float(w1[j] & 0xffff0000u); }
        float bur = 0.f, bui = 0.f;
#pragma unroll
        for (int p = 0; p < S5P; ++p) { bur += Br[p] * u[p]; bui += Bi[p] * u[p]; }
        const float nsr = Lr * sr - Li * si + bur, nsi = Lr * si + Li * sr + bui; sr = nsr; si = nsi;
        float yv = 0.f, uv = 0.f;
#pragma unroll
        for (int p = 0; p < S5P; ++p) { const float v = wave_sum(Cr[p] * sr - Ci[p] * si); if (n == p) { yv = v; uv = u[p]; } }
        if (n < S5P) ys5[(size_t)(b * SEQ + t) * 256 + g * S5P + n] = gelu_tanh(yv + dsk * uv);
    }
}
__device__ __forceinline__ void glu_item(const Params& P, int l, int item, int lane) {
    const float* ys5 = (const float*)(P.ws + WS_R1 + R1_YS5); bf16_t* mix = (bf16_t*)(P.ws + WS_R1 + R1_MIX);
    const float* W = P.in[11] + (size_t)l * 256 * 256; const float* bias = P.in[12] + l * 256;
    const int t0 = (item >> 2) * 8, c = (item & 3) * 64 + lane;
    float acc[8];
#pragma unroll
    for (int i = 0; i < 8; ++i) acc[i] = bias[c];
    for (int k = 0; k < 256; k += 4) {
        const float w0 = W[(k + 0) * 256 + c], w1 = W[(k + 1) * 256 + c], w2 = W[(k + 2) * 256 + c], w3 = W[(k + 3) * 256 + c];
#pragma unroll
        for (int i = 0; i < 8; ++i) { const f32x4 y = *(const f32x4*)(ys5 + (size_t)(t0 + i) * 256 + k); acc[i] += y[0] * w0 + y[1] * w1 + y[2] * w2 + y[3] * w3; } }
#pragma unroll
    for (int i = 0; i < 8; ++i) mix[(size_t)(t0 + i) * DM + c] = (bf16_t)f2bf(ys5[(size_t)(t0 + i) * 256 + c] * sigmoidf_(acc[i]));
}

__device__ __forceinline__ void kmean_item(const Params& P, int item, int lane) {
    const bf16_t* h = (const bf16_t*)(P.ws + WS_R1 + R1_H); float* kmean = (float*)(P.ws + WS_R1 + R1_KMEAN);
    const int bb = item / 6, c = (item % 6) * 64 + lane; float s = 0.f;
    const bf16_t* p = h + (size_t)bb * 256 * INP + C_MK + c;
    for (int r = 0; r < 256; ++r) s += bf2f(p[(size_t)r * INP]);
    kmean[bb * 384 + c] = s * (1.f / 256.f);
}
__device__ __forceinline__ void moba_item(const Params& P, int wv, int lane) {
    const bf16_t* h = (const bf16_t*)(P.ws + WS_R1 + R1_H); const float* kmean = (const float*)(P.ws + WS_R1 + R1_KMEAN); bf16_t* mix = (bf16_t*)(P.ws + WS_R1 + R1_MIX);
    const int hh = wv % NH, tok = wv / NH; const int b = tok / SEQ, q = tok % SEQ, qb = q >> 8;
    const float qv = bf2f(h[(size_t)tok * INP + C_MQ + hh * HD + lane]) * 0.125f;
    float gate[8];
#pragma unroll
    for (int j = 0; j < 8; ++j) { float gj = -INFINITY; if (j < qb) gj = wave_sum(qv * kmean[(b * 8 + j) * 384 + hh * HD + lane]); gate[j] = gj; }
    unsigned sel = 0;
#pragma unroll
    for (int j = 0; j < 8; ++j) { int rank = 0;
#pragma unroll
        for (int i = 0; i < 8; ++i) rank += (gate[i] > gate[j] || (gate[i] == gate[j] && i < j)) ? 1 : 0;
        if (j < qb && rank < 3) sel |= 1u << j; }
    sel |= 1u << qb;
    float qs[64];
#pragma unroll
    for (int d = 0; d < 64; ++d) qs[d] = __int_as_float(__builtin_amdgcn_readlane(__float_as_int(qv), d));
    float m = -1e30f, lsum = 0.f, o = 0.f;
    for (int j = 0; j <= qb; ++j) {
        if (!((sel >> j) & 1u)) continue;
        for (int tt = 0; tt < 4; ++tt) {
            const int k0 = j * 256 + tt * 64; if (k0 > q) break;
            const int key = k0 + lane;
            const bf16_t* kp = h + (size_t)(b * SEQ + key) * INP + C_MK + hh * HD;
            float s = 0.f;
#pragma unroll
            for (int c8 = 0; c8 < 8; ++c8) { const u32x4 w = *(const u32x4*)(kp + c8 * 8);
#pragma unroll
                for (int jj = 0; jj < 4; ++jj) { s += qs[c8 * 8 + 2 * jj] * __uint_as_float(w[jj] << 16); s += qs[c8 * 8 + 2 * jj + 1] * __uint_as_float(w[jj] & 0xffff0000u); } }
            if (key > q) s = -1e30f;
            float mx = s;
#pragma unroll
            for (int o2 = 1; o2 < 64; o2 <<= 1) mx = fmaxf(mx, __shfl_xor(mx, o2));
            const float mn = fmaxf(m, mx); const float sc = __expf(m - mn); const float p = (key > q) ? 0.f : __expf(s - mn);
            lsum = lsum * sc + wave_sum(p); o *= sc; m = mn;
            const bf16_t* vp = h + (size_t)(b * SEQ + k0) * INP + C_MV + hh * HD + lane;
#pragma unroll 16
            for (int kk = 0; kk < 64; ++kk) { const float pk = __int_as_float(__builtin_amdgcn_readlane(__float_as_int(p), kk)); o += pk * bf2f(vp[(size_t)kk * INP]); }
        }
    }
    mix[(size_t)tok * DM + 256 + hh * HD + lane] = (bf16_t)f2bf(o / lsum);
}

__device__ __forceinline__ void gdn_prep_item(const Params& P, int l, int wv, int lane) {
    const bf16_t* h = (const bf16_t*)(P.ws + WS_R1 + R1_H); float* gqkv = (float*)(P.ws + WS_R1 + R1_GQKV); const float* conv_w = P.in[13] + (size_t)l * 4 * 1152;
    const int wh = wv % 18, tok = wv / 18; const int t = tok % SEQ; const int ch = wh * 64 + lane;
    float acc = 0.f;
#pragma unroll
    for (int j = 0; j < 4; ++j) { const int tt = t - 3 + j; if (tt >= 0) acc += conv_w[j * 1152 + ch] * bf2f(h[(size_t)(tok - 3 + j) * INP + C_GQ + ch]); }
    float v = siluf_(acc);
    if (wh < 12) { const float ss = wave_sum(v * v); v *= rsqrtf(ss + RMS_EPS); if (wh < 6) v *= 0.125f; }
    gqkv[(size_t)tok * 1152 + ch] = v;
}
__device__ __forceinline__ void gdn_scan_item(const Params& P, int l, int item, int e) {
    const float* gqkv = (const float*)(P.ws + WS_R1 + R1_GQKV); const float* aux = (const float*)(P.ws + WS_R1 + R1_AUX);
    const bf16_t* h = (const bf16_t*)(P.ws + WS_R1 + R1_H); bf16_t* mix = (bf16_t*)(P.ws + WS_R1 + R1_MIX);
    const int b = item / NH, hh = item % NH;
    const float Aneg = -expf(P.in[14][l * NH + hh]), dtb = P.in[15][l * NH + hh], nw = P.in[16][l * HD + e];
    float S[64];
#pragma unroll
    for (int d = 0; d < 64; ++d) S[d] = 0.f;
    for (int t = 0; t < SEQ; ++t) {
        const size_t tok = (size_t)b * SEQ + t;
        const float qd = gqkv[tok * 1152 + hh * 64 + e], kd = gqkv[tok * 1152 + 384 + hh * 64 + e], ve = gqkv[tok * 1152 + 768 + hh * 64 + e];
        const float av = aux[tok * 16 + hh] + dtb, bv = aux[tok * 16 + 6 + hh];
        const float sp = av > 20.f ? av : log1pf(expf(av)); const float alpha = expf(Aneg * sp), beta = sigmoidf_(bv);
        float kS = 0.f;
#pragma unroll
        for (int d = 0; d < 64; ++d) { const float kk = __int_as_float(__builtin_amdgcn_readlane(__float_as_int(kd), d)); S[d] *= alpha; kS += kk * S[d]; }
        const float vn = beta * (ve - kS);
        float o = 0.f;
#pragma unroll
        for (int d = 0; d < 64; ++d) { const float kk = __int_as_float(__builtin_amdgcn_readlane(__float_as_int(kd), d)); const float qq = __int_as_float(__builtin_amdgcn_readlane(__float_as_int(qd), d));
            S[d] += kk * vn; o += qq * S[d]; }
        const float ms = wave_sum(o * o) * (1.f / 64.f);
        const float z = bf2f(h[tok * INP + C_GZ + hh * 64 + e]);
        mix[tok * DM + 640 + hh * 64 + e] = (bf16_t)f2bf(o * rsqrtf(ms + RMS_EPS) * nw * siluf_(z));
    }
}

constexpr size_t WS_S5W1 = 847 * MiB, WS_S5W23 = 851 * MiB, WS_S5LAM = 863 * MiB;
__device__ __forceinline__ void s5prep_item(const Params& P, int item, LAS unsigned char* lds) {
    const int tid = opaque((int)threadIdx.x); const int l = item >> 4, g = item & 15;
    LAS float* lamp = (LAS float*)lds;
    LAS float* bbar = lamp + 17 * 64 * 2;
    LAS float* Cc = bbar + 64 * 16 * 2;
    LAS float* Km = Cc + 16 * 64 * 2;
    const float* lam_re = P.in[3] + l * S5G * S5N; const float* lam_im = P.in[4] + l * S5G * S5N; const float* log_dt = P.in[5] + l * S5G;
    const float* b_re = P.in[6] + (size_t)l * S5G * S5N * S5P; const float* b_im = P.in[7] + (size_t)l * S5G * S5N * S5P;
    const float* c_re = P.in[8] + (size_t)l * S5G * S5P * S5N; const float* c_im = P.in[9] + (size_t)l * S5G * S5P * S5N; const float* dskp = P.in[10] + l * S5G * S5P + g * S5P;
    if (tid < 64) { const int n = tid;
        const float lre = lam_re[g * S5N + n], lim = lam_im[g * S5N + n], dt = expf(log_dt[g]); const float a = lre * dt, bb = lim * dt;
        for (int k = 0; k <= 16; ++k) { float sn, cs; sincosf((float)k * bb, &sn, &cs); const float er = expf((float)k * a); lamp[(k * 64 + n) * 2] = er * cs; lamp[(k * 64 + n) * 2 + 1] = er * sn; }
        float sn, cs; sincosf(bb, &sn, &cs); const float sh = sinf(0.5f * bb); const float nr = expm1f(a) * cs - 2.f * sh * sh, ni = expf(a) * sn;
        const float den = lre * lre + lim * lim; const float fr = (nr * lre + ni * lim) / den, fi = (ni * lre - nr * lim) / den;
        for (int p = 0; p < S5P; ++p) { const float bre = b_re[(g * S5N + n) * S5P + p], bim = b_im[(g * S5N + n) * S5P + p]; bbar[(n * 16 + p) * 2] = fr * bre - fi * bim; bbar[(n * 16 + p) * 2 + 1] = fr * bim + fi * bre; }
    }
    for (int e = tid; e < 1024; e += 512) { const int p = e >> 6, n = e & 63; Cc[e * 2] = c_re[(g * S5P + p) * S5N + n]; Cc[e * 2 + 1] = c_im[(g * S5P + p) * S5N + n]; }
    __syncthreads();
    if (tid < 64) { float* lam16 = (float*)(P.ws + WS_S5LAM) + (size_t)item * 128; lam16[tid * 2] = lamp[(16 * 64 + tid) * 2]; lam16[tid * 2 + 1] = lamp[(16 * 64 + tid) * 2 + 1]; }
    for (int e = tid; e < 4096; e += 512) { const int d = e >> 8, pp = (e >> 4) & 15, q = e & 15; float s = 0.f;
        for (int n = 0; n < 64; ++n) { const float cr = Cc[(pp * 64 + n) * 2], ci = Cc[(pp * 64 + n) * 2 + 1], lr = lamp[(d * 64 + n) * 2], li = lamp[(d * 64 + n) * 2 + 1];
            const float zr = cr * lr - ci * li, zi = cr * li + ci * lr; s += zr * bbar[(n * 16 + q) * 2] - zi * bbar[(n * 16 + q) * 2 + 1]; }
        Km[e] = s; }
    __syncthreads();
    bf16_t* W1 = (bf16_t*)(P.ws + WS_S5W1 + (size_t)item * 65536);
    for (int e = tid; e < 256 * 128; e += 512) { const int k = e >> 7, col = e & 127; const int t = k >> 4, p = k & 15, n = col >> 1, ri = col & 1;
        const float lr = lamp[((15 - t) * 64 + n) * 2], li = lamp[((15 - t) * 64 + n) * 2 + 1], br = bbar[(n * 16 + p) * 2], bi = bbar[(n * 16 + p) * 2 + 1];
        const float val = ri ? (lr * bi + li * br) : (lr * br - li * bi);
        W1[(((k >> 5) * 8 + (col >> 4)) * 64 + (col & 15) + 16 * ((k & 31) >> 3)) * 8 + (k & 7)] = (bf16_t)f2bf(val); }
    bf16_t* W23 = (bf16_t*)(P.ws + WS_S5W23 + (size_t)item * 196608);
    for (int e = tid; e < 384 * 256; e += 512) { const int k = e >> 8, col = e & 255; const int tp = col >> 4, pp = col & 15; float val;
        if (k < 256) { const int tau = k >> 4, q = k & 15; val = tp >= tau ? Km[((tp - tau) * 16 + pp) * 16 + q] : 0.f; if (tau == tp && q == pp) val += dskp[pp]; }
        else { const int comp = k - 256, n = comp >> 1, ri = comp & 1; const float cr = Cc[(pp * 64 + n) * 2], ci = Cc[(pp * 64 + n) * 2 + 1], lr = lamp[((tp + 1) * 64 + n) * 2], li = lamp[((tp + 1) * 64 + n) * 2 + 1];
            val = ri ? -(cr * li + ci * lr) : (cr * lr - ci * li); }
        W23[(((k >> 5) * 16 + (col >> 4)) * 64 + (col & 15) + 16 * ((k & 31) >> 3)) * 8 + (k & 7)] = (bf16_t)f2bf(val); }
    __syncthreads();
}
__device__ __forceinline__ float gelu_tanh_fast(float x) { const float u2 = 1.5957691216057308f * (x + 0.044715f * x * x * x); return x / (1.f + __expf(-u2)); }
__device__ __forceinline__ void s5_unit(const Params& P, int l, int unit, LAS unsigned char* lds) {
    const int tid = opaque((int)threadIdx.x), lane = tid & 63, wave = __builtin_amdgcn_readfirstlane(tid >> 6), q = lane >> 4, n_i = lane & 15;
    const int b = unit >> 4, g = unit & 15, item = l * 16 + g;
    const bf16_t* h = (const bf16_t*)(P.ws + WS_R1 + R1_H); bf16_t* ys5 = (bf16_t*)(P.ws + WS_R1 + R1_YS5);
    const bf16x8* W1f = (const bf16x8*)(P.ws + WS_S5W1 + (size_t)item * 65536); const bf16x8* W23f = (const bf16x8*)(P.ws + WS_S5W23 + (size_t)item * 196608);
    LAS unsigned char* RA = lds; LAS unsigned char* RB = lds + 65536; LAS unsigned char* RS = lds + 98304;
#pragma unroll
    for (int ks = 0; ks < 8; ++ks) { const int tok = (16 * wave + n_i) * 16 + 2 * ks + (q >> 1);
        __builtin_amdgcn_global_load_lds((const unsigned*)(h + ((size_t)(b * SEQ + tok) * INP + C_S5 + g * 16 + 8 * (q & 1))), (LAS unsigned*)(RA + (wave * 8 + ks) * 1024), 16, 0, 0); }
    asm volatile("s_waitcnt vmcnt(0)" ::: "memory"); __syncthreads();
    f32x4 acc[8];
#pragma unroll
    for (int m = 0; m < 8; ++m) acc[m] = (f32x4){0.f, 0.f, 0.f, 0.f};
#pragma unroll
    for (int ks = 0; ks < 8; ++ks) { const bf16x8 bfr = W1f[(ks * 8 + wave) * 64 + lane];
#pragma unroll
        for (int m = 0; m < 8; ++m) acc[m] = __builtin_amdgcn_mfma_f32_16x16x32_bf16(*(const LAS bf16x8*)(RA + ((m * 8 + ks) * 64 + lane) * 16), bfr, acc[m], 0, 0, 0); }
    float sr = 0.f, si = 0.f;
    const float* lam16 = (const float*)(P.ws + WS_S5LAM) + (size_t)item * 128;
    const float Lr = lam16[2 * lane], Li = lam16[2 * lane + 1];
#pragma unroll
    for (int h2 = 0; h2 < 2; ++h2) {
#pragma unroll
        for (int mm = 0; mm < 4; ++mm)
#pragma unroll
            for (int r = 0; r < 4; ++r) *(LAS float*)(RB + ((16 * mm + 4 * q + r) * 128 + 16 * wave + n_i) * 4) = acc[4 * h2 + mm][r];
        __syncthreads();
        if (wave == 0) {
            for (int rl = 0; rl < 64; ++rl) { const int c = 64 * h2 + rl; const float lr_ = *(const LAS float*)(RB + (rl * 128 + 2 * lane) * 4), li_ = *(const LAS float*)(RB + (rl * 128 + 2 * lane + 1) * 4);
                *(LAS unsigned*)(RS + ((c >> 4) * 4 + (lane >> 4)) * 1024 + ((c & 15) + 16 * ((lane & 15) >> 2)) * 16 + (lane & 3) * 4) = pg8::cvt_pk_bf16(sr, si);
                const float nsr = Lr * sr - Li * si + lr_, nsi = Lr * si + Li * sr + li_; sr = nsr; si = nsi; }
        }
        __syncthreads();
    }
    f32x4 a2[8][2];
#pragma unroll
    for (int m = 0; m < 8; ++m) { a2[m][0] = (f32x4){0.f, 0.f, 0.f, 0.f}; a2[m][1] = a2[m][0]; }
    for (int ks = 0; ks <= wave; ++ks) { const bf16x8 b0 = W23f[(ks * 16 + 2 * wave) * 64 + lane], b1 = W23f[(ks * 16 + 2 * wave + 1) * 64 + lane];
#pragma unroll
        for (int m = 0; m < 8; ++m) { const bf16x8 a = *(const LAS bf16x8*)(RA + ((m * 8 + ks) * 64 + lane) * 16);
            a2[m][0] = __builtin_amdgcn_mfma_f32_16x16x32_bf16(a, b0, a2[m][0], 0, 0, 0); a2[m][1] = __builtin_amdgcn_mfma_f32_16x16x32_bf16(a, b1, a2[m][1], 0, 0, 0); } }
#pragma unroll
    for (int ks = 0; ks < 4; ++ks) { const bf16x8 b0 = W23f[((8 + ks) * 16 + 2 * wave) * 64 + lane], b1 = W23f[((8 + ks) * 16 + 2 * wave + 1) * 64 + lane];
#pragma unroll
        for (int m = 0; m < 8; ++m) { const bf16x8 a = *(const LAS bf16x8*)(RS + ((m * 4 + ks) * 64 + lane) * 16);
            a2[m][0] = __builtin_amdgcn_mfma_f32_16x16x32_bf16(a, b0, a2[m][0], 0, 0, 0); a2[m][1] = __builtin_amdgcn_mfma_f32_16x16x32_bf16(a, b1, a2[m][1], 0, 0, 0); } }
#pragma unroll
    for (int m = 0; m < 8; ++m)
#pragma unroll
        for (int j = 0; j < 2; ++j)
#pragma unroll
            for (int r = 0; r < 4; ++r) { const int chunk = 16 * m + 4 * q + r; ys5[((size_t)(b * SEQ + chunk * 16 + 2 * wave + j)) * 256 + g * 16 + n_i] = (bf16_t)f2bf(gelu_tanh_fast(a2[m][j][r])); }
    __syncthreads();
}

constexpr int GREC = 49152, GR_WNEG = 0, GR_QG = 8192, GR_ATTN = 16384, GR_KDT = 24576, GR_U = 32768;
constexpr int GC_K = 0, GC_V = 9216, GC_L = 18432, GC_G = 26880, GC_B = 27136, GC_BYTES = 27392;
constexpr size_t R1_GREC = R1_GQKV, R1_EGL = R1_KMEAN + 131072;
__host__ __device__ constexpr int tri_off(int i) { return i == 0 ? 0 : 4 * ((((i - 1) >> 2) + 1) * (2 * ((i - 1) >> 2) + ((i - 1) & 3))); }
__device__ __forceinline__ int afrag_byte(int row, int k) { const int f = (row >> 4) * 2 + (k >> 5), kp = k & 31, q4 = (kp & 15) >> 2, j = (kp >> 4) * 4 + (kp & 3); return f * 1024 + ((row & 15) + 16 * q4) * 16 + j * 2; }
__device__ __forceinline__ bf16x8 pack8(const float* v) { u32x4 w; w.x = pg8::cvt_pk_bf16(v[0], v[1]); w.y = pg8::cvt_pk_bf16(v[2], v[3]); w.z = pg8::cvt_pk_bf16(v[4], v[5]); w.w = pg8::cvt_pk_bf16(v[6], v[7]); return __builtin_bit_cast(bf16x8, w); }
__device__ __forceinline__ bf16x8 pack44(const f32x4& a, const f32x4& b) { u32x4 w; w.x = pg8::cvt_pk_bf16(a[0], a[1]); w.y = pg8::cvt_pk_bf16(a[2], a[3]); w.z = pg8::cvt_pk_bf16(b[0], b[1]); w.w = pg8::cvt_pk_bf16(b[2], b[3]); return __builtin_bit_cast(bf16x8, w); }

template <int X> __device__ __forceinline__ void gdn_conv(const bf16_t* h, const float* conv_w, int b, int hh, int c, int w2, int i16, int q4, float (&dst)[2][2][8]) {
#pragma unroll
    for (int ks = 0; ks < 2; ++ks) {
        const int ch0 = X * 384 + hh * 64 + 32 * ks + 8 * q4;
        float wj[4][8];
#pragma unroll
        for (int j = 0; j < 4; ++j) { const f32x4 a = *(const f32x4*)(conv_w + j * 1152 + ch0), bq = *(const f32x4*)(conv_w + j * 1152 + ch0 + 4);
            wj[j][0] = a[0]; wj[j][1] = a[1]; wj[j][2] = a[2]; wj[j][3] = a[3]; wj[j][4] = bq[0]; wj[j][5] = bq[1]; wj[j][6] = bq[2]; wj[j][7] = bq[3]; }
#pragma unroll
        for (int m = 0; m < 2; ++m) {
            const int tseq = c * 64 + 32 * w2 + 16 * m + i16;
            float acc[8];
#pragma unroll
            for (int jj = 0; jj < 8; ++jj) acc[jj] = 0.f;
#pragma unroll
            for (int j = 0; j < 4; ++j) { const int tt = tseq - 3 + j; const float msk = tt >= 0 ? 1.f : 0.f; const int ttc = tt >= 0 ? tt : 0;
                const u32x4 raw = *(const u32x4*)(h + ((size_t)b * SEQ + ttc) * INP + C_GQ + ch0);
#pragma unroll
                for (int jj = 0; jj < 4; ++jj) { acc[2 * jj] += msk * wj[j][2 * jj] * __uint_as_float(raw[jj] << 16); acc[2 * jj + 1] += msk * wj[j][2 * jj + 1] * __uint_as_float(raw[jj] & 0xffff0000u); } }
#pragma unroll
            for (int jj = 0; jj < 8; ++jj) dst[m][ks][jj] = siluf_(acc[jj]);
        }
        asm volatile("" ::: "memory");
    }
}

__device__ __forceinline__ void gdn_local_unit(const Params& P, int l, int unit, LAS unsigned char* lds) {
    const int tid = opaque((int)threadIdx.x), lane = tid & 63, wave = __builtin_amdgcn_readfirstlane(tid >> 6), pr = wave >> 1, w2 = wave & 1;
    const int i16 = lane & 15, q4 = lane >> 4;
    const int bh = unit >> 3, c = (unit & 7) * 4 + pr; const int b = bh / NH, hh = bh % NH;
    const bf16_t* h = (const bf16_t*)(P.ws + WS_R1 + R1_H); const float* aux = (const float*)(P.ws + WS_R1 + R1_AUX); const float* conv_w = P.in[13] + (size_t)l * 4 * 1152;
    unsigned char* rec = P.ws + WS_R1 + R1_GREC + (size_t)(bh * 32 + c) * GREC; float* egl = (float*)(P.ws + WS_R1 + R1_EGL);
    LAS unsigned char* Lc = lds + pr * GC_BYTES;
    LAS float* gcL = (LAS float*)(Lc + GC_G); LAS float* btL = (LAS float*)(Lc + GC_B); LAS float* Ltri = (LAS float*)(Lc + GC_L);
    const size_t tok0 = (size_t)b * SEQ + c * 64;
    float gc;
    { const float a = aux[(tok0 + lane) * 16 + hh] + P.in[15][l * NH + hh]; const float sp = a > 20.f ? a : log1pf(expf(a)); gc = -expf(P.in[14][l * NH + hh]) * sp;
      const float beta = sigmoidf_(aux[(tok0 + lane) * 16 + 6 + hh]);
#pragma unroll
      for (int o = 1; o < 64; o <<= 1) { const float t = __shfl_up(gc, o); if (lane >= o) gc += t; }
      if (w2 == 0) { gcL[lane] = gc; btL[lane] = beta; } }
    const float gl = __shfl(gc, 63);
    if (w2 == 0 && lane == 0) egl[bh * 32 + c] = expf(gl);
    bf16x8 qf[2][2], kf[2][2];
    {   float qv[2][2][8];
        gdn_conv<0>(h, conv_w, b, hh, c, w2, i16, q4, qv);
#pragma unroll
        for (int m = 0; m < 2; ++m) {
            const int tl = 32 * w2 + 16 * m + i16;
            float sq = 0.f;
#pragma unroll
            for (int ks = 0; ks < 2; ++ks)
#pragma unroll
                for (int jj = 0; jj < 8; ++jj) sq += qv[m][ks][jj] * qv[m][ks][jj];
            sq += __shfl_xor(sq, 16); sq += __shfl_xor(sq, 32);
            const float rq = rsqrtf(sq + RMS_EPS) * 0.125f; const float eg = expf(__shfl(gc, tl));
#pragma unroll
            for (int ks = 0; ks < 2; ++ks) {
                float qn[8], qg[8];
#pragma unroll
                for (int jj = 0; jj < 8; ++jj) { qn[jj] = qv[m][ks][jj] * rq; qg[jj] = qn[jj] * eg; }
                qf[m][ks] = pack8(qn);
                const int f = (2 * w2 + m) * 2 + ks;
                const int offA = f * 1024 + (i16 + 16 * ((2 * q4) & 3)) * 16 + (q4 >> 1) * 8, offB = f * 1024 + (i16 + 16 * ((2 * q4 + 1) & 3)) * 16 + (q4 >> 1) * 8;
                u32x2 wa; wa.x = pg8::cvt_pk_bf16(qg[0], qg[1]); wa.y = pg8::cvt_pk_bf16(qg[2], qg[3]); *(u32x2*)(rec + GR_QG + offA) = wa;
                u32x2 wb; wb.x = pg8::cvt_pk_bf16(qg[4], qg[5]); wb.y = pg8::cvt_pk_bf16(qg[6], qg[7]); *(u32x2*)(rec + GR_QG + offB) = wb;
            }
        }
    }
    asm volatile("" ::: "memory");
    {   float kv[2][2][8];
        gdn_conv<1>(h, conv_w, b, hh, c, w2, i16, q4, kv);
#pragma unroll
        for (int m = 0; m < 2; ++m) {
            const int tl = 32 * w2 + 16 * m + i16;
            float sk = 0.f;
#pragma unroll
            for (int ks = 0; ks < 2; ++ks)
#pragma unroll
                for (int jj = 0; jj < 8; ++jj) sk += kv[m][ks][jj] * kv[m][ks][jj];
            sk += __shfl_xor(sk, 16); sk += __shfl_xor(sk, 32);
            const float rk = rsqrtf(sk + RMS_EPS); const float ekd = expf(gl - __shfl(gc, tl));
#pragma unroll
            for (int ks = 0; ks < 2; ++ks) {
                float kn[8];
#pragma unroll
                for (int jj = 0; jj < 8; ++jj) kn[jj] = kv[m][ks][jj] * rk;
                kf[m][ks] = pack8(kn);
                *(LAS bf16x8*)(Lc + GC_K + tl * 144 + (32 * ks + 8 * q4) * 2) = kf[m][ks];
#pragma unroll
                for (int jj = 0; jj < 8; ++jj) *(bf16_t*)(rec + GR_KDT + afrag_byte(32 * ks + 8 * q4 + jj, tl)) = (bf16_t)f2bf(kn[jj] * ekd);
            }
        }
    }
    asm volatile("" ::: "memory");
    {   float vv[2][2][8];
        gdn_conv<2>(h, conv_w, b, hh, c, w2, i16, q4, vv);
#pragma unroll
        for (int m = 0; m < 2; ++m) { const int tl = 32 * w2 + 16 * m + i16;
#pragma unroll
            for (int ks = 0; ks < 2; ++ks) *(LAS bf16x8*)(Lc + GC_V + tl * 144 + (32 * ks + 8 * q4) * 2) = pack8(vv[m][ks]); }
    }
    __syncthreads();
#pragma unroll
    for (int mm = 0; mm < 2; ++mm) {
        const int mt = 2 * w2 + mm;
#pragma unroll
        for (int nt = 0; nt < 4; ++nt) {
            if (nt <= mt) {
                const bf16x8 bk0 = *(const LAS bf16x8*)(Lc + GC_K + (16 * nt + i16) * 144 + (8 * q4) * 2), bk1 = *(const LAS bf16x8*)(Lc + GC_K + (16 * nt + i16) * 144 + (32 + 8 * q4) * 2);
                f32x4 kk = __builtin_amdgcn_mfma_f32_16x16x32_bf16(kf[mm][0], bk0, (f32x4){0.f, 0.f, 0.f, 0.f}, 0, 0, 0); kk = __builtin_amdgcn_mfma_f32_16x16x32_bf16(kf[mm][1], bk1, kk, 0, 0, 0);
                f32x4 qk = __builtin_amdgcn_mfma_f32_16x16x32_bf16(qf[mm][0], bk0, (f32x4){0.f, 0.f, 0.f, 0.f}, 0, 0, 0); qk = __builtin_amdgcn_mfma_f32_16x16x32_bf16(qf[mm][1], bk1, qk, 0, 0, 0);
                const int s = 16 * nt + i16; const float gs = gcL[s];
#pragma unroll
                for (int rr = 0; rr < 4; ++rr) { const int r = 16 * mt + 4 * q4 + rr; const float dec = __expf(fminf(gcL[r] - gs, 0.f));
                    if (s < r) { const int n1 = r - 1, a1 = n1 >> 2, b1 = n1 & 3; Ltri[4 * ((a1 + 1) * (2 * a1 + b1)) + s] = btL[r] * kk[rr] * dec; }
                    *(bf16_t*)(rec + GR_ATTN + afrag_byte(r, s)) = (bf16_t)f2bf(s <= r ? qk[rr] * dec : 0.f); }
            } else if (nt == mt + 1 && (mt & 1) == 0) {
#pragma unroll
                for (int rr = 0; rr < 4; ++rr) *(bf16_t*)(rec + GR_ATTN + afrag_byte(16 * mt + 4 * q4 + rr, 16 * nt + i16)) = (bf16_t)0;
            }
        }
    }
    __syncthreads();
    {
        const LAS bf16_t* src = (const LAS bf16_t*)(Lc + (w2 ? GC_K : GC_V));
        float x[64];
#pragma unroll
        for (int i = 0; i < 64; ++i) {
            const float sc = btL[i] * __expf(w2 ? gcL[i] : 0.f);
            float acc = sc * bf2f(src[i * 72 + lane]);
#pragma unroll
            for (int j4 = 0; j4 < i; j4 += 4) { const f32x4 Lr = *(const LAS f32x4*)(Ltri + tri_off(i) + j4);
#pragma unroll
                for (int jj = 0; jj < 4; ++jj) if (j4 + jj < i) acc -= Lr[jj] * x[j4 + jj]; }
            asm volatile("" : "+v"(acc) :: "memory");
            x[i] = acc;
        }
        if (w2 == 0) {
            const int w = lane >> 4, n = lane & 15;
#pragma unroll
            for (int a = 0; a < 16; ++a) *(f32x4*)(rec + GR_U + ((w * 4 + (a >> 2)) * 64 + n + 16 * (a & 3)) * 16) = (f32x4){x[4 * a], x[4 * a + 1], x[4 * a + 2], x[4 * a + 3]};
        } else {
#pragma unroll
            for (int cc = 0; cc < 64; ++cc) *(bf16_t*)(rec + GR_WNEG + afrag_byte(cc, lane)) = (bf16_t)f2bf(-x[cc]);
        }
    }
    __syncthreads();
}

__device__ __forceinline__ void gdn_scan_unit(const Params& P, int l, int bh, LAS unsigned char* lds) {
    const int tid = opaque((int)threadIdx.x), lane = tid & 63, wave = __builtin_amdgcn_readfirstlane(tid >> 6), q = lane >> 4, n = lane & 15;
    const int b = bh / NH, hh = bh % NH;
    const unsigned char* rec0 = P.ws + WS_R1 + R1_GREC + (size_t)bh * 32 * GREC; const float* egl = (const float*)(P.ws + WS_R1 + R1_EGL) + bh * 32;
    const bf16_t* h = (const bf16_t*)(P.ws + WS_R1 + R1_H); bf16_t* mix = (bf16_t*)(P.ws + WS_R1 + R1_MIX);
    LAS float* xs = (LAS float*)(lds + 2 * GREC);
#define GDN_ISSUE(cc, bufi) do { _Pragma("unroll") for (int k_ = 0; k_ < 6; ++k_) { const int piece = wave * 6 + k_; \
        __builtin_amdgcn_global_load_lds((const unsigned*)(rec0 + (size_t)(cc) * GREC + piece * 1024 + lane * 16), (LAS unsigned*)(lds + (bufi) * GREC + piece * 1024), 16, 0, 0); } } while (0)
#define GDN_AF(base, t, s) (*(const LAS bf16x8*)(buf + (base) + (((t) * 2 + (s)) * 64 + lane) * 16))
    const float eglv = egl[lane & 31];
    const int e = 16 * (wave & 3) + n;
    const float nw = P.in[16][l * HD + e];
    GDN_ISSUE(0, 0);
    asm volatile("s_waitcnt vmcnt(0)" ::: "memory"); __syncthreads();
    f32x4 St[4]; bf16x8 Sb[2]; f32x4 o[4];
#pragma unroll
    for (int t = 0; t < 4; ++t) { St[t] = (f32x4){0.f, 0.f, 0.f, 0.f}; o[t] = St[t]; }
    Sb[0] = (bf16x8){0, 0, 0, 0, 0, 0, 0, 0}; Sb[1] = Sb[0];
    for (int c = 0; c < 32; ++c) {
        const LAS unsigned char* buf = lds + (c & 1) * GREC;
        float zv[16];
        if (wave < 4) {
#pragma unroll
            for (int t = 0; t < 4; ++t)
#pragma unroll
                for (int r = 0; r < 4; ++r) zv[t * 4 + r] = bf2f(h[((size_t)b * SEQ + c * 64 + 16 * t + 4 * q + r) * INP + C_GZ + hh * 64 + e]);
        }
        if (c + 1 < 32) GDN_ISSUE(c + 1, (c + 1) & 1);
        if (wave < 4) {
            const float eg = __int_as_float(__builtin_amdgcn_readlane(__float_as_int(eglv), c));
            f32x4 vn[4];
#pragma unroll
            for (int t = 0; t < 4; ++t) vn[t] = *(const LAS f32x4*)(buf + GR_U + ((wave * 4 + t) * 64 + lane) * 16);
#pragma unroll
            for (int t = 0; t < 4; ++t)
#pragma unroll
                for (int s = 0; s < 2; ++s) vn[t] = __builtin_amdgcn_mfma_f32_16x16x32_bf16(GDN_AF(GR_WNEG, t, s), Sb[s], vn[t], 0, 0, 0);
#pragma unroll
            for (int t = 0; t < 4; ++t) { o[t] = (f32x4){0.f, 0.f, 0.f, 0.f};
#pragma unroll
                for (int s = 0; s < 2; ++s) o[t] = __builtin_amdgcn_mfma_f32_16x16x32_bf16(GDN_AF(GR_QG, t, s), Sb[s], o[t], 0, 0, 0); }
            bf16x8 Vb[2]; Vb[0] = pack44(vn[0], vn[1]); Vb[1] = pack44(vn[2], vn[3]);
#pragma unroll
            for (int t = 0; t < 4; ++t)
#pragma unroll
                for (int s = 0; s < 2; ++s) if (!(s == 1 && t < 2)) o[t] = __builtin_amdgcn_mfma_f32_16x16x32_bf16(GDN_AF(GR_ATTN, t, s), Vb[s], o[t], 0, 0, 0);
#pragma unroll
            for (int t = 0; t < 4; ++t) { St[t] = St[t] * eg;
#pragma unroll
                for (int s = 0; s < 2; ++s) St[t] = __builtin_amdgcn_mfma_f32_16x16x32_bf16(GDN_AF(GR_KDT, t, s), Vb[s], St[t], 0, 0, 0); }
            Sb[0] = pack44(St[0], St[1]); Sb[1] = pack44(St[2], St[3]);
#pragma unroll
            for (int t = 0; t < 4; ++t)
#pragma unroll
                for (int r = 0; r < 4; ++r) { float v = o[t][r] * o[t][r]; v += __shfl_xor(v, 1); v += __shfl_xor(v, 2); v += __shfl_xor(v, 4); v += __shfl_xor(v, 8);
                    if (n == 0) xs[((c & 1) * 4 + wave) * 64 + 16 * t + 4 * q + r] = v; }
        }
        asm volatile("s_waitcnt vmcnt(0)" ::: "memory"); __syncthreads();
        if (wave < 4) {
#pragma unroll
            for (int t = 0; t < 4; ++t)
#pragma unroll
                for (int r = 0; r < 4; ++r) { const int pos = 16 * t + 4 * q + r; const LAS float* xp = xs + (c & 1) * 256 + pos;
                    const float tot = (xp[0] + xp[64]) + (xp[128] + xp[192]); const float rstd = rsqrtf(tot * (1.f / 64.f) + RMS_EPS);
                    mix[((size_t)b * SEQ + c * 64 + pos) * DM + 640 + hh * 64 + e] = (bf16_t)f2bf(o[t][r] * rstd * nw * siluf_(zv[t * 4 + r])); }
        }
    }
    __syncthreads();
#undef GDN_ISSUE
#undef GDN_AF
}

constexpr int MB_KV = 9216;
constexpr int MB_K0 = 0, MB_V0 = 2 * MB_KV, MB_MSK = 4 * MB_KV, MB_WG = MB_MSK + 1024, MB_BYTES = MB_WG + 64;
constexpr float MB_C = 0.125f * 1.4426950408889634f;
constexpr float MB_NEG = -1e30f;
__device__ __forceinline__ void moba_unit(const Params& P, int bh, int qb, LAS unsigned char* lds) {
    const int tid = opaque((int)threadIdx.x), lane = tid & 63, wave = __builtin_amdgcn_readfirstlane(tid >> 6), q4 = lane >> 4, n_i = lane & 15;
    const int b = bh / NH, hh = bh % NH;
    const bf16_t* h = (const bf16_t*)(P.ws + WS_R1 + R1_H); const float* kmean = (const float*)(P.ws + WS_R1 + R1_KMEAN); bf16_t* mix = (bf16_t*)(P.ws + WS_R1 + R1_MIX);
    const size_t row0 = (size_t)b * SEQ;
    const int q0 = qb * 256 + 32 * wave;
    LAS unsigned* mskL = (LAS unsigned*)(lds + MB_MSK); LAS unsigned* wgL = (LAS unsigned*)(lds + MB_WG);
    {   const int qi = lane & 31, half = lane >> 5;
        const bf16_t* qp = h + (row0 + q0 + qi) * INP + C_MQ + hh * HD;
        float gt[4] = {0.f, 0.f, 0.f, 0.f};
#pragma unroll
        for (int c8 = 0; c8 < 8; ++c8) { const u32x4 w = *(const u32x4*)(qp + c8 * 8); float qv[8];
#pragma unroll
            for (int jj = 0; jj < 4; ++jj) { qv[2 * jj] = __uint_as_float(w[jj] << 16); qv[2 * jj + 1] = __uint_as_float(w[jj] & 0xffff0000u); }
#pragma unroll
            for (int jb = 0; jb < 4; ++jb) { const float* km = kmean + (size_t)(b * 8 + 4 * half + jb) * 384 + hh * HD + c8 * 8; const f32x4 k0 = *(const f32x4*)km, k1 = *(const f32x4*)(km + 4);
                gt[jb] += (qv[0] * k0[0] + qv[1] * k0[1]) + (qv[2] * k0[2] + qv[3] * k0[3]) + (qv[4] * k1[0] + qv[5] * k1[1]) + (qv[6] * k1[2] + qv[7] * k1[3]); }
            asm volatile("" : "+v"(gt[0]), "+v"(gt[1]), "+v"(gt[2]), "+v"(gt[3]) :: "memory"); }
#pragma unroll
        for (int jb = 0; jb < 4; ++jb) gt[jb] = (4 * half + jb < qb) ? gt[jb] * 0.125f : -INFINITY;
        float gate[8];
#pragma unroll
        for (int jb = 0; jb < 4; ++jb) { const float o = __shfl_xor(gt[jb], 32); gate[jb] = half ? o : gt[jb]; gate[4 + jb] = half ? gt[jb] : o; }
        unsigned sel = 0;
#pragma unroll
        for (int j = 0; j < 8; ++j) { int rank = 0;
#pragma unroll
            for (int i = 0; i < 8; ++i) rank += (gate[i] > gate[j] || (gate[i] == gate[j] && i < j)) ? 1 : 0;
            if (j < qb && rank < 3) sel |= 1u << j; }
        if (lane < 32) mskL[wave * 32 + lane] = sel;
        unsigned wsel = sel;
#pragma unroll
        for (int o = 1; o < 32; o <<= 1) wsel |= __shfl_xor(wsel, o);
        if (lane == 0) wgL[wave] = wsel;
    }
    bf16x8 Qf[2][2];
#pragma unroll
    for (int qt = 0; qt < 2; ++qt)
#pragma unroll
        for (int ks = 0; ks < 2; ++ks) Qf[qt][ks] = *(const bf16x8*)(h + (row0 + q0 + 16 * qt + n_i) * INP + C_MQ + hh * HD + 32 * ks + 8 * q4);
    __syncthreads();
    unsigned wgmask = 0;
#pragma unroll
    for (int w = 0; w < 8; ++w) wgmask |= wgL[w];
    wgmask = (unsigned)__builtin_amdgcn_readfirstlane((int)wgmask);
    const unsigned msk0 = mskL[wave * 32 + n_i], msk1 = mskL[wave * 32 + 16 + n_i];
    const unsigned wvmask = (unsigned)__builtin_amdgcn_readfirstlane((int)wgL[wave]);
    const int nblk = 1 + __builtin_popcount(wgmask);
    const int ntile = 4 * nblk;
    const int skey = tid >> 3, sch = tid & 7;
    auto tile_block = [&](int t) -> int { const int bi = t >> 2; if (bi == 0) return qb; unsigned m = wgmask; int j = 0;
        for (int k = 1; k < bi; ++k) m &= m - 1u; j = __builtin_ctz(m); return j; };
    u32x4 kreg, vreg;
    { const int jb = qb; const size_t kr = (row0 + jb * 256 + skey) * INP + hh * HD + sch * 8; kreg = *(const u32x4*)(h + kr + C_MK); vreg = *(const u32x4*)(h + kr + C_MV); }
    *(LAS u32x4*)(lds + MB_K0 + skey * 144 + sch * 16) = kreg; *(LAS u32x4*)(lds + MB_V0 + skey * 144 + sch * 16) = vreg;
    __syncthreads();
    f32x4 ot[4][2];
#pragma unroll
    for (int dt = 0; dt < 4; ++dt) { ot[dt][0] = (f32x4){0.f, 0.f, 0.f, 0.f}; ot[dt][1] = ot[dt][0]; }
    float mrow[2] = {MB_NEG, MB_NEG}, lrow[2] = {0.f, 0.f};
    for (int t = 0; t < ntile; ++t) {
        const int cur = t & 1; const int jb = tile_block(t); const int tt = t & 3;
        if (t + 1 < ntile) { const int jn = tile_block(t + 1); const size_t kr = (row0 + jn * 256 + ((t + 1) & 3) * 64 + skey) * INP + hh * HD + sch * 8; kreg = *(const u32x4*)(h + kr + C_MK); vreg = *(const u32x4*)(h + kr + C_MV); }
        const bool own = (t < 4);
        const bool active = own ? (64 * tt <= 32 * wave + 31) : (((wvmask >> jb) & 1u) != 0u);
        if (active) {
            const LAS unsigned char* kL = lds + MB_K0 + cur * MB_KV; const LAS unsigned char* vL = lds + MB_V0 + cur * MB_KV;
            f32x4 st[4][2];
#pragma unroll
            for (int kt = 0; kt < 4; ++kt) { const bf16x8 k0 = *(const LAS bf16x8*)(kL + (16 * kt + n_i) * 144 + (8 * q4) * 2), k1 = *(const LAS bf16x8*)(kL + (16 * kt + n_i) * 144 + (32 + 8 * q4) * 2);
#pragma unroll
                for (int qt = 0; qt < 2; ++qt) { f32x4 a = __builtin_amdgcn_mfma_f32_16x16x32_bf16(k0, Qf[qt][0], (f32x4){0.f, 0.f, 0.f, 0.f}, 0, 0, 0); st[kt][qt] = __builtin_amdgcn_mfma_f32_16x16x32_bf16(k1, Qf[qt][1], a, 0, 0, 0); } }
            if (own) {
#pragma unroll
                for (int kt = 0; kt < 4; ++kt)
#pragma unroll
                    for (int qt = 0; qt < 2; ++qt)
#pragma unroll
                        for (int r = 0; r < 4; ++r) { const int key = 64 * tt + 16 * kt + 4 * q4 + r, qq = 32 * wave + 16 * qt + n_i; if (key > qq) st[kt][qt][r] = MB_NEG; }
            } else {
                const bool s0 = ((msk0 >> jb) & 1u) != 0u, s1 = ((msk1 >> jb) & 1u) != 0u;
#pragma unroll
                for (int kt = 0; kt < 4; ++kt)
#pragma unroll
                    for (int r = 0; r < 4; ++r) { if (!s0) st[kt][0][r] = MB_NEG; if (!s1) st[kt][1][r] = MB_NEG; }
            }
            bf16x8 Pb[2][2];
#pragma unroll
            for (int qt = 0; qt < 2; ++qt) {
                float mx = st[0][qt][0];
#pragma unroll
                for (int kt = 0; kt < 4; ++kt)
#pragma unroll
                    for (int r = 0; r < 4; ++r) mx = fmaxf(mx, st[kt][qt][r]);
                mx = fmaxf(mx, __shfl_xor(mx, 16)); mx = fmaxf(mx, __shfl_xor(mx, 32));
                const float mn = fmaxf(mrow[qt], mx); const float alpha = __builtin_amdgcn_exp2f((mrow[qt] - mn) * MB_C); mrow[qt] = mn; const float mc = mn * MB_C;
                float ps = 0.f;
#pragma unroll
                for (int kt = 0; kt < 4; ++kt)
#pragma unroll
                    for (int r = 0; r < 4; ++r) { const float p = __builtin_amdgcn_exp2f(st[kt][qt][r] * MB_C - mc); st[kt][qt][r] = p; ps += p; }
                lrow[qt] = lrow[qt] * alpha + ps;
#pragma unroll
                for (int dt = 0; dt < 4; ++dt) ot[dt][qt] = ot[dt][qt] * alpha;
                Pb[qt][0] = pack44(st[0][qt], st[1][qt]); Pb[qt][1] = pack44(st[2][qt], st[3][qt]);
            }
            const int qq = (lane & 15) >> 2, pp = lane & 3;
#pragma unroll
            for (int dt = 0; dt < 4; ++dt)
#pragma unroll
                for (int s2 = 0; s2 < 2; ++s2) {
                    typedef short v4s __attribute__((ext_vector_type(4)));
                    const v4s lo = __builtin_bit_cast(v4s, __builtin_amdgcn_ds_read_tr16_b64_v4i16((LAS v4s*)(vL + (32 * s2 + 4 * q4 + qq) * 144 + (16 * dt + 4 * pp) * 2)));
                    const v4s hi = __builtin_bit_cast(v4s, __builtin_amdgcn_ds_read_tr16_b64_v4i16((LAS v4s*)(vL + (32 * s2 + 16 + 4 * q4 + qq) * 144 + (16 * dt + 4 * pp) * 2)));
                    const bf16x8 vf = (bf16x8){lo[0], lo[1], lo[2], lo[3], hi[0], hi[1], hi[2], hi[3]};
                    ot[dt][0] = __builtin_amdgcn_mfma_f32_16x16x32_bf16(vf, Pb[0][s2], ot[dt][0], 0, 0, 0);
                    ot[dt][1] = __builtin_amdgcn_mfma_f32_16x16x32_bf16(vf, Pb[1][s2], ot[dt][1], 0, 0, 0);
                }
        }
        if (t + 1 < ntile) { *(LAS u32x4*)(lds + MB_K0 + (cur ^ 1) * MB_KV + skey * 144 + sch * 16) = kreg; *(LAS u32x4*)(lds + MB_V0 + (cur ^ 1) * MB_KV + skey * 144 + sch * 16) = vreg; }
        __syncthreads();
    }
#pragma unroll
    for (int qt = 0; qt < 2; ++qt) { float lt = lrow[qt]; lt += __shfl_xor(lt, 16); lt += __shfl_xor(lt, 32); const float inv = 1.f / lt;
#pragma unroll
        for (int dt = 0; dt < 4; ++dt) { u32x2 w; w.x = pg8::cvt_pk_bf16(ot[dt][qt][0] * inv, ot[dt][qt][1] * inv); w.y = pg8::cvt_pk_bf16(ot[dt][qt][2] * inv, ot[dt][qt][3] * inv);
            *(u32x2*)(mix + (row0 + q0 + 16 * qt + n_i) * DM + 256 + hh * HD + 16 * dt + 4 * q4) = w; } }
    __syncthreads();
}

constexpr size_t WS_GLUW = 863 * MiB + 65536;
__device__ __forceinline__ void gluprep(const Params& P, int l, int tid0, int nthr) {
    bf16_t* GW = (bf16_t*)(P.ws + WS_GLUW + (size_t)l * 131072); const float* W = P.in[11] + (size_t)l * 65536;
    for (int e = tid0; e < 65536; e += nthr) { const int k = e >> 8, col = e & 255; GW[(((k >> 5) * 16 + (col >> 4)) * 64 + (col & 15) + 16 * ((k & 31) >> 3)) * 8 + (k & 7)] = (bf16_t)f2bf(W[e]); }
}
__device__ __forceinline__ void glu_unit(const Params& P, int l, int unit) {
    const int tid = opaque((int)threadIdx.x), lane = tid & 63, wave = __builtin_amdgcn_readfirstlane(tid >> 6), q4 = lane >> 4, n_i = lane & 15;
    const bf16_t* ys = (const bf16_t*)(P.ws + WS_R1 + R1_YS5); bf16_t* mix = (bf16_t*)(P.ws + WS_R1 + R1_MIX);
    const bf16x8* GW = (const bf16x8*)(P.ws + WS_GLUW + (size_t)l * 131072); const float* bias = P.in[12] + l * 256;
    const int tok0 = unit * 256 + 32 * wave;
    bf16x8 af[2][8];
#pragma unroll
    for (int mt = 0; mt < 2; ++mt)
#pragma unroll
        for (int ks = 0; ks < 8; ++ks) af[mt][ks] = *(const bf16x8*)(ys + (size_t)(tok0 + 16 * mt + n_i) * 256 + 32 * ks + 8 * q4);
#pragma unroll 2
    for (int nt = 0; nt < 16; ++nt) {
        f32x4 a0 = (f32x4){0.f, 0.f, 0.f, 0.f}, a1 = a0;
#pragma unroll
        for (int ks = 0; ks < 8; ++ks) { const bf16x8 bfr = GW[(ks * 16 + nt) * 64 + lane]; a0 = __builtin_amdgcn_mfma_f32_16x16x32_bf16(af[0][ks], bfr, a0, 0, 0, 0); a1 = __builtin_amdgcn_mfma_f32_16x16x32_bf16(af[1][ks], bfr, a1, 0, 0, 0); }
        const int col = 16 * nt + n_i; const float bv = bias[col];
#pragma unroll
        for (int r = 0; r < 4; ++r) { const size_t t0 = (size_t)(tok0 + 4 * q4 + r), t1 = t0 + 16;
            mix[t0 * DM + col] = (bf16_t)f2bf(bf2f(ys[t0 * 256 + col]) * sigmoidf_(a0[r] + bv)); mix[t1 * DM + col] = (bf16_t)f2bf(bf2f(ys[t1 * 256 + col]) * sigmoidf_(a1[r] + bv)); }
    }
}

__device__ __forceinline__ void ln1_row(const Params& P, int l, int row, int lane) {
    unsigned char* ws = P.ws; const int moe = l & 1;
    const float* xin = l == 0 ? P.in[0] : (const float*)P.out; const float* y = (const float*)(ws + WS_Y);
    const float* g = P.in[17] + l * DM; const float* bvec = P.in[18] + l * DM;
    float* x1 = (float*)(ws + WS_X1); bf16_t* x1b = (bf16_t*)(ws + WS_X1B);
    const float* router = P.in[24] + (size_t)(l >> 1) * DM * NE;
    const f32x4* xr = (const f32x4*)(xin + (size_t)row * DM) + lane; const f32x4* yr = (const f32x4*)(y + (size_t)row * DM) + lane;
    f32x4 v[4]; float s = 0.f;
#pragma unroll
    for (int j = 0; j < 4; ++j) { v[j] = xr[64 * j] * ALPHA + yr[64 * j]; s += (v[j][0] + v[j][1]) + (v[j][2] + v[j][3]); }
    const float mean = wave_sum(s) * (1.f / DM); float s2 = 0.f;
#pragma unroll
    for (int j = 0; j < 4; ++j) { v[j] = v[j] - mean; s2 += (v[j][0] * v[j][0] + v[j][1] * v[j][1]) + (v[j][2] * v[j][2] + v[j][3] * v[j][3]); }
    const float rstd = rsqrtf(wave_sum(s2) * (1.f / DM) + LN_EPS);
    float lg[8];
#pragma unroll
    for (int e = 0; e < 8; ++e) lg[e] = 0.f;
#pragma unroll
    for (int j = 0; j < 4; ++j) { const f32x4 gg = ((const f32x4*)g)[lane + 64 * j], bb = ((const f32x4*)bvec)[lane + 64 * j];
        v[j] = v[j] * rstd * gg + bb;
        ((f32x4*)(x1 + (size_t)row * DM))[lane + 64 * j] = v[j];
        u32x2 o; o.x = pk2(v[j][0], v[j][1]); o.y = pk2(v[j][2], v[j][3]); ((u32x2*)(x1b + (size_t)row * DM))[lane + 64 * j] = o;
        if (moe) {
#pragma unroll
            for (int c = 0; c < 4; ++c) { const f32x4* rp = (const f32x4*)(router + (size_t)(4 * (lane + 64 * j) + c) * 8); const f32x4 r0 = rp[0], r1 = rp[1];
                lg[0] += v[j][c] * r0[0]; lg[1] += v[j][c] * r0[1]; lg[2] += v[j][c] * r0[2]; lg[3] += v[j][c] * r0[3];
                lg[4] += v[j][c] * r1[0]; lg[5] += v[j][c] * r1[1]; lg[6] += v[j][c] * r1[2]; lg[7] += v[j][c] * r1[3]; } }
    }
    if (moe) {
        unsigned* cntw = (unsigned*)(ws + WS_CTL) + CW_CNT + 16 * (l >> 1);
        int* tok_e = (int*)(ws + WS_MISC + MISC_TOKE); int* tok_p = (int*)(ws + WS_MISC + MISC_TOKP); float* tok_w = (float*)(ws + WS_MISC + MISC_TOKW); int* rowtok_v = (int*)(ws + WS_MISC + MISC_ROWTOKV);
#pragma unroll
        for (int e = 0; e < 8; ++e) lg[e] = wave_sum(lg[e]);
        int e1 = 0; float v1 = lg[0];
#pragma unroll
        for (int e = 1; e < 8; ++e) if (lg[e] > v1) { v1 = lg[e]; e1 = e; }
        int e2 = -1; float v2 = -INFINITY;
#pragma unroll
        for (int e = 0; e < 8; ++e) if (e != e1 && lg[e] > v2) { v2 = lg[e]; e2 = e; }
        const float w1 = 1.f / (1.f + __expf(v2 - v1)), w2 = 1.f - w1;
        if (lane == 0) {
            const int p1 = (int)atomicAdd(cntw + e1, 1u), p2 = (int)atomicAdd(cntw + e2, 1u);
            tok_e[row * 2] = e1; tok_e[row * 2 + 1] = e2; tok_p[row * 2] = p1; tok_p[row * 2 + 1] = p2; tok_w[row * 2] = w1; tok_w[row * 2 + 1] = w2;
            rowtok_v[e1 * MTOK + p1] = row; rowtok_v[e2 * MTOK + p2] = row;
        }
    }
}
__device__ __forceinline__ void permute_row(const Params& P, int l, int c, int lane) {
    unsigned char* ws = P.ws; unsigned* ctl = (unsigned*)(ws + WS_CTL); const unsigned* cntw = ctl + CW_CNT + 16 * (l >> 1);
    const bf16_t* x1b = (const bf16_t*)(ws + WS_X1B); bf16_t* xperm = (bf16_t*)(ws + WS_Y); const int* rowtok_v = (const int*)(ws + WS_MISC + MISC_ROWTOKV); int* tile_e = (int*)(ws + WS_MISC + MISC_TILEE);
    int cnt[8], tb[9]; tb[0] = 0;
#pragma unroll
    for (int e = 0; e < 8; ++e) { cnt[e] = (int)cntw[e]; tb[e + 1] = tb[e] + ((cnt[e] + 255) >> 8); }
    const int NT = tb[8];
    if (c == 0 && lane == 0) ctl[CW_NT] = (unsigned)NT;
    if (c >= NT * 256) return;
    const int tile = c >> 8; int e = 0, tbe = 0, cne = cnt[0];
#pragma unroll
    for (int i = 1; i < 8; ++i) if (tile >= tb[i]) { e = i; tbe = tb[i]; cne = cnt[i]; }
    if ((c & 255) == 0 && lane == 0) tile_e[tile] = e;
    const int pos = c - tbe * 256;
    u32x4 v0 = (u32x4){0u, 0u, 0u, 0u}, v1 = v0;
    if (pos < cne) { const int tok = rowtok_v[e * MTOK + pos]; const u32x4* s = (const u32x4*)(x1b + (size_t)tok * DM); v0 = s[lane]; v1 = s[lane + 64]; }
    u32x4* d = (u32x4*)(xperm + (size_t)c * DM); d[lane] = v0; d[lane + 64] = v1;
}
__device__ __forceinline__ void ln2_row(const Params& P, int l, int row, int lane) {
    unsigned char* ws = P.ws; const int moe = l & 1; const unsigned* cntw = (const unsigned*)(ws + WS_CTL) + CW_CNT + 16 * (l >> 1);
    const float* x1 = (const float*)(ws + WS_X1); const bf16_t* yp = (const bf16_t*)(ws + WS_Y); const float* g = P.in[19] + l * DM; const float* bvec = P.in[20] + l * DM;
    float* xout = P.out; bf16_t* xb = (bf16_t*)(ws + WS_XB);
    const int* tok_e = (const int*)(ws + WS_MISC + MISC_TOKE); const int* tok_p = (const int*)(ws + WS_MISC + MISC_TOKP); const float* tok_w = (const float*)(ws + WS_MISC + MISC_TOKW);
    int r1 = row, r2 = row; float w1 = 1.f, w2 = 0.f;
    if (moe) { int tb[9]; tb[0] = 0;
#pragma unroll
        for (int e = 0; e < 8; ++e) tb[e + 1] = tb[e] + (((int)cntw[e] + 255) >> 8);
        const int e1 = tok_e[row * 2], e2 = tok_e[row * 2 + 1]; int b1 = 0, b2 = 0;
#pragma unroll
        for (int e = 0; e < 8; ++e) { if (e == e1) b1 = tb[e]; if (e == e2) b2 = tb[e]; }
        r1 = b1 * 256 + tok_p[row * 2]; r2 = b2 * 256 + tok_p[row * 2 + 1]; w1 = tok_w[row * 2]; w2 = tok_w[row * 2 + 1]; }
    const f32x4* xr = (const f32x4*)(x1 + (size_t)row * DM) + lane; const u32x2* y1 = (const u32x2*)(yp + (size_t)r1 * DM) + lane; const u32x2* y2 = (const u32x2*)(yp + (size_t)r2 * DM) + lane;
    f32x4 v[4]; float s = 0.f;
#pragma unroll
    for (int j = 0; j < 4; ++j) { const u32x2 a = y1[64 * j], c = y2[64 * j];
        f32x4 f; f[0] = w1 * __uint_as_float(a.x << 16) + w2 * __uint_as_float(c.x << 16); f[1] = w1 * __uint_as_float(a.x & 0xffff0000u) + w2 * __uint_as_float(c.x & 0xffff0000u);
        f[2] = w1 * __uint_as_float(a.y << 16) + w2 * __uint_as_float(c.y << 16); f[3] = w1 * __uint_as_float(a.y & 0xffff0000u) + w2 * __uint_as_float(c.y & 0xffff0000u);
        v[j] = xr[64 * j] * ALPHA + f; s += (v[j][0] + v[j][1]) + (v[j][2] + v[j][3]); }
    const float mean = wave_sum(s) * (1.f / DM); float s2 = 0.f;
#pragma unroll
    for (int j = 0; j < 4; ++j) { v[j] = v[j] - mean; s2 += (v[j][0] * v[j][0] + v[j][1] * v[j][1]) + (v[j][2] * v[j][2] + v[j][3] * v[j][3]); }
    const float rstd = rsqrtf(wave_sum(s2) * (1.f / DM) + LN_EPS);
#pragma unroll
    for (int j = 0; j < 4; ++j) { const f32x4 gg = ((const f32x4*)g)[lane + 64 * j], bb = ((const f32x4*)bvec)[lane + 64 * j];
        v[j] = v[j] * rstd * gg + bb;
        ((f32x4*)(xout + (size_t)row * DM))[lane + 64 * j] = v[j];
        u32x2 o; o.x = pk2(v[j][0], v[j][1]); o.y = pk2(v[j][2], v[j][3]); ((u32x2*)(xb + (size_t)row * DM))[lane + 64 * j] = o; }
}

template <class Epi> __device__ __forceinline__ void run_gemm(LAS unsigned char* lds, const bf16_t* A, const bf16_t* Bt, int nM, int nN, int K, size_t bstride, const int* tile_e, const unsigned* nt_word, const Epi& E) {
    LAS int* te = (LAS int*)(lds + LDS_TE);
    if (nt_word) nM = (int)__builtin_amdgcn_readfirstlane(__hip_atomic_load(nt_word, __ATOMIC_RELAXED, __HIP_MEMORY_SCOPE_AGENT));
    if (tile_e) { const int t_ = opaque((int)threadIdx.x); if (t_ < nM) te[t_] = __hip_atomic_load(tile_e + t_, __ATOMIC_RELAXED, __HIP_MEMORY_SCOPE_AGENT); }
    __syncthreads();
    pg8::Gemm g{A, Bt, nM, nN, K, bstride, tile_e ? (const LAS int*)te : (const LAS int*)nullptr};
    pg8::StaticOrder S; S.init(nM, nN, (int)gridDim.x, (int)blockIdx.x, g.tile_e);
    pg8::gemm_phase<Epi, true>(lds, g, S, E);
}

__global__ void __launch_bounds__(512, 2) mega_fwd(Params P) {
    extern __shared__ __attribute__((aligned(16))) unsigned char smem[];
    LAS unsigned char* lds = (LAS unsigned char*)smem;
    volatile LAS unsigned* MISC = (volatile LAS unsigned*)(lds + LDS_MISC);
    const int tid = threadIdx.x, lane = tid & 63, wave = __builtin_amdgcn_readfirstlane(tid >> 6);
    const int G = gridDim.x, blk = blockIdx.x;
    unsigned char* ws = P.ws; unsigned* ctl = (unsigned*)(ws + WS_CTL);
    if (tid < 32) MISC[tid] = 0u;
    __syncthreads();
    XcdBarrier bar = xcd_barrier_post(ctl + CW_BAR, MISC + 8);
    const int gw = blk * NWAVES + wave, NGW = G * NWAVES;

    phase_prep(P, lds);
    for (int it = blk; it < DEPTH * S5G; it += G) s5prep_item(P, it, lds);
    for (int l2 = 0; l2 < DEPTH; ++l2) gluprep(P, l2, blk * 512 + tid, G * 512);
    xcd_barrier(bar);

    bf16_t* xb = (bf16_t*)(ws + WS_XB); bf16_t* x1b = (bf16_t*)(ws + WS_X1B); bf16_t* ybf = (bf16_t*)(ws + WS_Y); float* yf = (float*)(ws + WS_Y);
    bf16_t* hbuf = (bf16_t*)(ws + WS_R1 + R1_H); float* aux = (float*)(ws + WS_R1 + R1_AUX); bf16_t* mix = (bf16_t*)(ws + WS_R1 + R1_MIX); bf16_t* Hbuf = (bf16_t*)(ws + WS_R1);
    const int* tile_e = (const int*)(ws + WS_MISC + MISC_TILEE);

    for (int l = 0; l < DEPTH; ++l) {
        const int moe = l & 1; const int slot0 = moe ? 2 + (l >> 1) * 8 : (l >> 1);
        { pg8::EpiBf16 E{hbuf, aux, INP, 11};
          run_gemm(lds, xb, (const bf16_t*)(ws + WS_WIN) + (size_t)l * INP * DM, MTOK / 256, INP / 256, DM, 0, nullptr, nullptr, E); }
        xcd_barrier(bar);
        if (blk < 128) { s5_unit(P, l, blk, lds); gdn_local_unit(P, l, blk, lds); }
        else if (blk < 256) { gdn_local_unit(P, l, 128 + (blk - 128) * 2, lds); gdn_local_unit(P, l, 129 + (blk - 128) * 2, lds); }
        for (int it = gw; it < BATCH * 8 * 6; it += NGW) kmean_item(P, it, opaque(lane));
        xcd_barrier(bar);
        if (blk < BATCH * NH) gdn_scan_unit(P, l, blk, lds);
        for (;;) {
            if (tid == 0) MISC[16] = atomicAdd(ctl + CW_Q + l, 1u);
            __syncthreads();
            const int u = (int)MISC[16];
            __syncthreads();
            if (u >= 384 + 64) break;
            if (u < 384) moba_unit(P, u % 48, 7 - u / 48, lds); else glu_unit(P, l, u - 384);
        }
        xcd_barrier(bar);
        { pg8::EpiF32 E{yf, DM, 0};
          run_gemm(lds, mix, (const bf16_t*)(ws + WS_WOUT) + (size_t)l * DM * DM, MTOK / 256, DM / 256, DM, 0, nullptr, nullptr, E); }
        xcd_barrier(bar);
        for (int r = gw; r < MTOK; r += NGW) ln1_row(P, l, r, opaque(lane));
        xcd_barrier(bar);
        if (moe) { for (int c = gw; c < MAXT * 256; c += NGW) permute_row(P, l, c, opaque(lane)); xcd_barrier(bar); }
        { pg8::EpiSwiglu E{Hbuf, DFF, 0};
          run_gemm(lds, moe ? (const bf16_t*)ybf : (const bf16_t*)x1b, (const bf16_t*)(ws + WS_WGU) + (size_t)slot0 * 2 * DFF * DM, MTOK / 256, 2 * DFF / 256, DM, (size_t)2 * DFF * DM,
                   moe ? tile_e : nullptr, moe ? ctl + CW_NT : nullptr, E); }
        xcd_barrier(bar);
        { pg8::EpiBf16 E{ybf, nullptr, DM, -1};
          run_gemm(lds, Hbuf, (const bf16_t*)(ws + WS_WD) + (size_t)slot0 * DM * DFF, MTOK / 256, DM / 256, DFF, (size_t)DM * DFF, moe ? tile_e : nullptr, moe ? ctl + CW_NT : nullptr, E); }
        xcd_barrier(bar);
        for (int r = gw; r < MTOK; r += NGW) ln2_row(P, l, r, opaque(lane));
        if (l + 1 < DEPTH) xcd_barrier(bar);
    }
}

extern "C" void kernel_launch(void* const* d_in, const int* in_sizes, int n_in, void* d_out, int out_size, void* d_ws, size_t ws_size, hipStream_t stream) {
    static int grid = 0;
    if (grid == 0) {
        if (n_in != 28 || out_size != MTOK * DM || ws_size < WS_END) { fprintf(stderr, "kernel_launch: unexpected arguments (n_in %d out %d ws %zu)\n", n_in, out_size, ws_size); grid = -1; return; }
        int dev = 0, cus = 0;
        if (hipGetDevice(&dev) != hipSuccess || hipDeviceGetAttribute(&cus, hipDeviceAttributeMultiprocessorCount, dev) != hipSuccess) { grid = -1; return; }
        if (hipFuncSetAttribute((const void*)mega_fwd, hipFuncAttributeMaxDynamicSharedMemorySize, LDS_BYTES) != hipSuccess) { fprintf(stderr, "kernel_launch: hipFuncSetAttribute failed\n"); grid = -1; return; }
        int per_cu = 0;
        if (hipOccupancyMaxActiveBlocksPerMultiprocessor(&per_cu, (const void*)mega_fwd, NWAVES * 64, LDS_BYTES) != hipSuccess || per_cu < 1) { fprintf(stderr, "kernel_launch: occupancy query says %d\n", per_cu); }
        (void)hipGetLastError();
        grid = cus;
        if (grid < 256) { fprintf(stderr, "kernel_launch: needs 256 CUs\n"); grid = -1; return; }
        grid = 256;
    }
    if (grid < 0) return;
    (void)hipMemsetAsync((char*)d_ws + WS_CTL, 0, 1 * MiB, stream);
    Params p{};
    for (int i = 0; i < 28; ++i) p.in[i] = (const float*)d_in[i];
    p.out = (float*)d_out; p.ws = (unsigned char*)d_ws;
    hipLaunchKernelGGL(mega_fwd, dim3(grid), dim3(NWAVES * 64), LDS_BYTES, stream, p);
}
```

```cpp
#include <hip/hip_runtime.h>
#ifndef PROBE
#define PROBE 0
#endif
#include <cstdio>
#include <cstdint>

constexpr int BATCH = 8, SEQ = 2048, DM = 1024, DEPTH = 4, MTOK = BATCH * SEQ;
constexpr int INC = 2956, INP = 3072;
constexpr int C_S5 = 0, C_MQ = 256, C_MK = 640, C_MV = 1024, C_GQ = 1408, C_GK = 1792, C_GV = 2176, C_GZ = 2560, C_GA = 2944;
constexpr int DFF = 3584, NE = 8;
constexpr int S5G = 16, S5P = 16, S5N = 64;
constexpr int NH = 6, HD = 64;
constexpr float ALPHA = 1.681792830507429f;
constexpr float LN_EPS = 1e-5f, RMS_EPS = 1e-6f;
constexpr int MAXT = 136;

constexpr size_t MiB = 1u << 20;
constexpr size_t WS_CTL = 0;
constexpr size_t WS_WIN = 1 * MiB;
constexpr size_t WS_WOUT = 25 * MiB;
constexpr size_t WS_WGU = 33 * MiB;
constexpr size_t WS_WD = 285 * MiB;
constexpr size_t WS_XB = 411 * MiB;
constexpr size_t WS_X1 = 443 * MiB;
constexpr size_t WS_X1B = 507 * MiB;
constexpr size_t WS_Y = 539 * MiB;
constexpr size_t WS_R1 = 607 * MiB;
constexpr size_t R1_H = 0, R1_AUX = 96 * MiB, R1_MIX = 97 * MiB, R1_YS5 = 129 * MiB, R1_GQKV = 145 * MiB, R1_KMEAN = 217 * MiB;
constexpr size_t WS_MISC = 845 * MiB;
constexpr size_t MISC_TOKE = 0, MISC_TOKP = 128 * 1024, MISC_TOKW = 256 * 1024, MISC_ROWTOKV = 384 * 1024  , MISC_TILEE = 896 * 1024;
constexpr size_t WS_END = 864 * MiB;
constexpr int CW_CNT = 1024;
constexpr int CW_NT = 128;
constexpr int CW_Q = 192;

typedef unsigned short bf16_t;
typedef short bf16x8 __attribute__((ext_vector_type(8)));
typedef float f32x4 __attribute__((ext_vector_type(4)));
typedef unsigned u32x4 __attribute__((ext_vector_type(4)));
typedef unsigned u32x2 __attribute__((ext_vector_type(2)));
#define LAS __attribute__((address_space(3)))

__device__ __forceinline__ float bf2f(bf16_t v) { return __uint_as_float(((unsigned)v) << 16); }
__device__ __forceinline__ unsigned f2bf(float f) { unsigned u = __float_as_uint(f); return (u + 0x7fffu + ((u >> 16) & 1u)) >> 16; }
__device__ __forceinline__ unsigned pk2(float lo, float hi) { return f2bf(lo) | (f2bf(hi) << 16); }
__device__ __forceinline__ float wave_sum(float v) {
#pragma unroll
    for (int o = 1; o < 64; o <<= 1) v += __shfl_xor(v, o);
    return v;
}
__device__ __forceinline__ int opaque(int v) { asm volatile("" : "+v"(v)); return v; }
__device__ __forceinline__ float row16_sum(float v) {
    v += __int_as_float(__builtin_amdgcn_update_dpp(0, __float_as_int(v), 0xB1, 0xF, 0xF, true));
    v += __int_as_float(__builtin_amdgcn_update_dpp(0, __float_as_int(v), 0x4E, 0xF, 0xF, true));
    v += __int_as_float(__builtin_amdgcn_update_dpp(0, __float_as_int(v), 0x141, 0xF, 0xF, true));
    v += __int_as_float(__builtin_amdgcn_update_dpp(0, __float_as_int(v), 0x140, 0xF, 0xF, true));
    return v;
}
__device__ __forceinline__ float sigmoidf_(float x) { return 1.f / (1.f + __expf(-x)); }
__device__ __forceinline__ float siluf_(float x) { return x / (1.f + __expf(-x)); }

namespace pg8 {
constexpr int BM = 256, BK = 64, HALF = 128, HTB = HALF * BK * 2, STAGE_BYTES = 8 * HTB, NXCD = 8, WGM = 8;
__host__ __device__ __forceinline__ int lds_byte(int r, int c) { const int st = (r >> 4) * 2 + (c >> 5), rr = r & 15, cc = c & 31, ob = rr * 64 + cc * 2; return st * 1024 + (ob ^ (((ob >> 9) & 1) << 5)); }
__host__ __device__ __forceinline__ void stage_rc(int b, int& R, int& C) { const int st = b / 1024, sb = b % 1024, swz = sb ^ (((sb >> 9) & 1) << 5); R = (st >> 1) * 16 + swz / 64; C = (st & 1) * 32 + (swz % 64) / 2; }
__host__ __device__ __forceinline__ int perm32(int rho) { const int n = rho >> 4, i = rho & 15; return 8 * (i >> 2) + 4 * n + (i & 3); }

struct Unit { int pm, pn, e; };
struct Gemm { const bf16_t* A; const bf16_t* Bt; int nM, nN, K; size_t bstride; const LAS int* tile_e; };

struct StaticOrder {
    int nM, nN, nwg, G, c; const LAS int* te;
    __device__ void init(int nM_, int nN_, int G_, int c_, const LAS int* te_) { nM = nM_; nN = nN_; nwg = nM * nN; G = G_; c = c_; te = te_; }
    __device__ bool next(int i, Unit& u) const {
        const long L = (long)i * G + c; if (L >= nwg) return false;
        int wgid = (int)L; { const int q = nwg / NXCD, r = nwg % NXCD, xcd = wgid % NXCD, off = wgid / NXCD; wgid = (xcd < r ? xcd * (q + 1) : r * (q + 1) + (xcd - r) * q) + off; }
        const int nig = WGM * nN, gid = wgid / nig, fm = gid * WGM, gsz = (nM - fm) < WGM ? (nM - fm) : WGM;
        u.pm = fm + ((wgid % nig) % gsz); u.pn = (wgid % nig) / gsz; u.e = te ? te[u.pm] : 0; return true;
    }
};

typedef float f32x2_t __attribute__((ext_vector_type(2))); typedef __bf16 bf16x2_t __attribute__((ext_vector_type(2)));
__device__ __forceinline__ unsigned cvt_pk_bf16(float lo, float hi) { f32x2_t v = {lo, hi}; bf16x2_t r = __builtin_convertvector(v, bf16x2_t); return __builtin_bit_cast(unsigned, r); }

struct EpiF32 {
    static constexpr bool PERM = false;
    float* C; int ldc; int pad;
    __device__ __forceinline__ void operator()(const f32x4 (&acc)[2][2][4][2], const Unit& u, int wr, int wc, int fr, int fq) const {
        const int row0 = u.pm * BM + wr * 64 + fr, col0 = u.pn * BM + wc * 32 + 4 * fq;
#pragma unroll
        for (int ai = 0; ai < 2; ++ai)
#pragma unroll
            for (int m = 0; m < 4; ++m) { float* rowp = C + (size_t)(row0 + ai * HALF + m * 16) * ldc + col0;
#pragma unroll
                for (int bj = 0; bj < 2; ++bj)
#pragma unroll
                    for (int n = 0; n < 2; ++n) *(f32x4*)(rowp + bj * HALF + n * 16) = acc[ai][bj][m][n]; }
    }
};
struct EpiBf16 {
    static constexpr bool PERM = true;
    bf16_t* O; float* aux; int ldc; int aux_pn;
    __device__ __forceinline__ void operator()(const f32x4 (&acc)[2][2][4][2], const Unit& u, int wr, int wc, int fr, int fq) const {
        const int row0 = u.pm * BM + wr * 64 + fr; const int col0 = u.pn * BM + wc * 32 + 8 * fq;
#pragma unroll
        for (int ai = 0; ai < 2; ++ai)
#pragma unroll
            for (int m = 0; m < 4; ++m) { bf16_t* rowp = O + (size_t)(row0 + ai * HALF + m * 16) * ldc + col0;
#pragma unroll
                for (int bj = 0; bj < 2; ++bj) { const f32x4 v0 = acc[ai][bj][m][0], v1 = acc[ai][bj][m][1];
                    u32x4 w; w.x = cvt_pk_bf16(v0[0], v0[1]); w.y = cvt_pk_bf16(v0[2], v0[3]); w.z = cvt_pk_bf16(v1[0], v1[1]); w.w = cvt_pk_bf16(v1[2], v1[3]);
                    *(u32x4*)(rowp + bj * HALF) = w; } }
        if (aux && u.pn == aux_pn && wc == 0 && fq < 2) {
#pragma unroll
            for (int ai = 0; ai < 2; ++ai)
#pragma unroll
                for (int m = 0; m < 4; ++m) { float* ap = aux + (size_t)(row0 + ai * HALF + m * 16) * 16 + 8 * fq;
                    *(f32x4*)(ap) = acc[ai][1][m][0]; *(f32x4*)(ap + 4) = acc[ai][1][m][1]; }
        }
    }
};
struct EpiSwiglu {
    static constexpr bool PERM = true;
    bf16_t* O; int ldc; int pad;
    __device__ __forceinline__ void operator()(const f32x4 (&acc)[2][2][4][2], const Unit& u, int wr, int wc, int fr, int fq) const {
        const int row0 = u.pm * BM + wr * 64 + fr; const int col0 = u.pn * HALF + wc * 32 + 8 * fq;
#pragma unroll
        for (int ai = 0; ai < 2; ++ai)
#pragma unroll
            for (int m = 0; m < 4; ++m) { bf16_t* rowp = O + (size_t)(row0 + ai * HALF + m * 16) * ldc + col0;
                float r[8];
#pragma unroll
                for (int n = 0; n < 2; ++n)
#pragma unroll
                    for (int j = 0; j < 4; ++j) { const float g = acc[ai][0][m][n][j], up = acc[ai][1][m][n][j];
                        r[n * 4 + j] = g * __builtin_amdgcn_rcpf(1.f + __builtin_amdgcn_exp2f(-1.4426950408889634f * g)) * up; }
                u32x4 w; w.x = cvt_pk_bf16(r[0], r[1]); w.y = cvt_pk_bf16(r[2], r[3]); w.z = cvt_pk_bf16(r[4], r[5]); w.w = cvt_pk_bf16(r[6], r[7]);
                *(u32x4*)(rowp) = w; }
    }
};

template <class Epi, bool ALIGN_EPI = true>
__device__ __forceinline__ void gemm_phase(LAS unsigned char* lds, const Gemm g, const StaticOrder& S, const Epi& E) {
    const int tid = opaque((int)threadIdx.x), wid = __builtin_amdgcn_readfirstlane(tid >> 6), lane = tid & 63, wr = wid >> 2, wc = wid & 3, fr = lane & 15, fq = lane >> 4;
    const int K = g.K, nt = K / BK;
    unsigned voffA[2], voffB[2];
#pragma unroll
    for (int i = 0; i < 2; ++i) { int R, C; stage_rc(tid * 16 + i * 8192, R, C); const int Rb = Epi::PERM ? ((R & ~31) + perm32(R & 31)) : R;
        voffA[i] = (unsigned)(R * K + C) * 2u; voffB[i] = (unsigned)(Rb * K + C) * 2u; }
    const size_t kstep = (size_t)(BK * 2);
    const size_t hstep = (size_t)HALF * K * 2;
    const size_t tstep = 2 * hstep;
    const unsigned ldsw = (unsigned)wid * 1024u;
    const int aoff = lds_byte(wr * 64 + fr, fq * 8), boff = lds_byte(wc * 32 + fr, fq * 8);
#define PG8_SA(b, h) (((b) * 2 + (h)) * HTB)
#define PG8_SB(b, h) ((4 + (b) * 2 + (h)) * HTB)
#define PG8_STAGE(bufoff, gbase, voff) do { _Pragma("unroll") for (int _i = 0; _i < 2; ++_i) \
        __builtin_amdgcn_global_load_lds((const unsigned*)((const char*)(gbase) + (voff)[_i]), (LAS unsigned*)(lds + (bufoff) + ldsw + _i * 8192), 16, 0, 0); } while (0)
#define PG8_LDA(dst, b, h) do { _Pragma("unroll") for (int m = 0; m < 4; ++m) _Pragma("unroll") for (int k = 0; k < 2; ++k) dst[m][k] = *(const LAS bf16x8*)(lds + PG8_SA(b, h) + aoff + m * 2048 + k * 1024); } while (0)
#define PG8_LDB(dst, b, h) do { _Pragma("unroll") for (int n = 0; n < 2; ++n) _Pragma("unroll") for (int k = 0; k < 2; ++k) dst[n][k] = *(const LAS bf16x8*)(lds + PG8_SB(b, h) + boff + n * 2048 + k * 1024); } while (0)
#define PG8_MMA(ai, bj, At, Bt) do { __builtin_amdgcn_s_setprio(1); _Pragma("unroll") for (int m = 0; m < 4; ++m) _Pragma("unroll") for (int n = 0; n < 2; ++n) _Pragma("unroll") for (int k = 0; k < 2; ++k) \
        acc[ai][bj][m][n] = __builtin_amdgcn_mfma_f32_16x16x32_bf16(Bt[n][k], At[m][k], acc[ai][bj][m][n], 0, 0, 0); __builtin_amdgcn_s_setprio(0); } while (0)
#define PG8_WAIT_V(n) asm volatile("s_waitcnt vmcnt(" #n ")" ::: "memory")
#define PG8_WAIT_L(n) asm volatile("s_waitcnt lgkmcnt(" #n ")" ::: "memory")
#define PG8_BAR __builtin_amdgcn_s_barrier()
#define PG8_SCHED __builtin_amdgcn_sched_barrier(0)
    Unit cur, nxt; int ui = 0;
    if (!S.next(0, cur)) return;
    f32x4 acc[2][2][4][2];
#pragma unroll
    for (int a = 0; a < 2; ++a)
#pragma unroll
        for (int b = 0; b < 2; ++b)
#pragma unroll
            for (int m = 0; m < 4; ++m)
#pragma unroll
                for (int n = 0; n < 2; ++n) acc[a][b][m][n] = (f32x4){0.f, 0.f, 0.f, 0.f};
    bf16x8 At[4][2], B0[2][2], B1[2][2];
    const char* cA = (const char*)g.A + (size_t)cur.pm * tstep; const char* cB = (const char*)(g.Bt + (size_t)cur.e * g.bstride) + (size_t)cur.pn * tstep;
    PG8_STAGE(PG8_SB(0, 0), cB, voffB); PG8_STAGE(PG8_SB(0, 1), cB + hstep, voffB); PG8_STAGE(PG8_SA(0, 0), cA, voffA); PG8_STAGE(PG8_SA(0, 1), cA + hstep, voffA);
    if (wr == 1) PG8_BAR;
    PG8_WAIT_V(2); PG8_BAR;
    PG8_STAGE(PG8_SB(1, 0), cB + kstep, voffB); PG8_STAGE(PG8_SA(1, 0), cA + kstep, voffA); PG8_STAGE(PG8_SB(1, 1), cB + hstep + kstep, voffB);
    PG8_WAIT_V(6); PG8_BAR;
    for (;;) {
        const bool has_next = S.next(ui + 1, nxt);
        const char* nA = has_next ? (const char*)g.A + (size_t)nxt.pm * tstep : cA; const char* nB = has_next ? (const char*)(g.Bt + (size_t)nxt.e * g.bstride) + (size_t)nxt.pn * tstep : cB;
        for (int t = 0; t < nt; t += 2) {
            const bool last = (t == nt - 2);
            const char* a1 = cA + (size_t)(t + 1) * kstep;
            const char* a2 = last ? nA : cA + (size_t)(t + 2) * kstep; const char* b2 = last ? nB : cB + (size_t)(t + 2) * kstep;
            const char* a3 = a2 + kstep; const char* b3 = b2 + kstep;
            PG8_LDB(B0, 0, 0); PG8_LDB(B1, 0, 1); PG8_SCHED; PG8_LDA(At, 0, 0); PG8_STAGE(PG8_SA(1, 1), a1 + hstep, voffA);
            PG8_WAIT_V(8); PG8_WAIT_L(0); PG8_BAR; PG8_MMA(0, 0, At, B0); PG8_MMA(0, 1, At, B1); PG8_BAR; PG8_SCHED;
            PG8_LDA(At, 0, 1); PG8_STAGE(PG8_SB(0, 0), b2, voffB); PG8_STAGE(PG8_SB(0, 1), b2 + hstep, voffB); PG8_STAGE(PG8_SA(0, 0), a2, voffA);
            PG8_WAIT_V(8); PG8_WAIT_L(0); PG8_BAR; PG8_MMA(1, 0, At, B0); PG8_MMA(1, 1, At, B1); PG8_BAR; PG8_SCHED;
            PG8_LDB(B0, 1, 0); PG8_LDB(B1, 1, 1); PG8_SCHED; PG8_LDA(At, 1, 0); PG8_STAGE(PG8_SA(0, 1), a2 + hstep, voffA);
            PG8_WAIT_V(8); PG8_WAIT_L(0); PG8_BAR; PG8_MMA(0, 0, At, B0); PG8_MMA(0, 1, At, B1); PG8_BAR; PG8_SCHED;
            PG8_LDA(At, 1, 1); PG8_STAGE(PG8_SB(1, 0), b3, voffB); PG8_STAGE(PG8_SB(1, 1), b3 + hstep, voffB); PG8_STAGE(PG8_SA(1, 0), a3, voffA);
            PG8_WAIT_V(8); PG8_WAIT_L(0); PG8_BAR; PG8_MMA(1, 0, At, B0); PG8_MMA(1, 1, At, B1); PG8_BAR; PG8_SCHED;
        }
        if constexpr (ALIGN_EPI) { if (wr == 0) PG8_BAR; }
        E(acc, cur, wr, wc, fr, fq);
        if (!has_next) break;
#pragma unroll
        for (int a = 0; a < 2; ++a)
#pragma unroll
            for (int b = 0; b < 2; ++b)
#pragma unroll
                for (int m = 0; m < 4; ++m)
#pragma unroll
                    for (int n = 0; n < 2; ++n) acc[a][b][m][n] = (f32x4){0.f, 0.f, 0.f, 0.f};
        cur = nxt; cA = nA; cB = nB; ++ui;
        if constexpr (ALIGN_EPI) { if (wr == 1) PG8_BAR; }
    }
    PG8_WAIT_V(0);
    if constexpr (!ALIGN_EPI) { if (wr == 0) PG8_BAR; }
    PG8_BAR;
#undef PG8_SA
#undef PG8_SB
#undef PG8_STAGE
#undef PG8_LDA
#undef PG8_LDB
#undef PG8_MMA
#undef PG8_WAIT_V
#undef PG8_WAIT_L
#undef PG8_BAR
#undef PG8_SCHED
}
}

constexpr int RING_BYTES = 131072;
constexpr int LDS_TE = RING_BYTES;
constexpr int LDS_MISC = RING_BYTES + 1024;
constexpr int LDS_BYTES = 147456;
constexpr int NWAVES = 8;

#define XB_TMO      128
#define XB_XCNT(j)  (256  + 64 * (j))
#define XB_XSUB(j)  (1280 + 64 * (j))
#define XB_XGEN(j)  (2304 + 64 * (j))
#define XB_TOP      3328
#define XB_TOPGEN   3392
#define XCD_BAR_WORDS 3456
#define XB_SPIN_CAP (1u << 18)
constexpr int CW_BAR = 4096;

__device__ __forceinline__ unsigned xb_ld(unsigned* p)              { return __hip_atomic_load(p, __ATOMIC_RELAXED, __HIP_MEMORY_SCOPE_AGENT); }
__device__ __forceinline__ unsigned xb_add(unsigned* p, unsigned v) { return __hip_atomic_fetch_add(p, v, __ATOMIC_RELAXED, __HIP_MEMORY_SCOPE_AGENT); }
__device__ __forceinline__ unsigned xb_xcc_id() { return (unsigned)__builtin_amdgcn_s_getreg((3 << 11) | 20) & 0xFu; }
#define XB_SPIN(cond, bar) do { unsigned _sp = 0; while (cond) { __builtin_amdgcn_s_sleep(1); \
    if ((++_sp & 255u) == 0u) { if (xb_ld(&(bar)[XB_TMO])) break; if (_sp > XB_SPIN_CAP) { atomicAdd(&(bar)[XB_TMO], 1u); break; } } } } while (0)
struct XcdBarrier { unsigned* bar; unsigned x; volatile LAS unsigned* st; };
__device__ __forceinline__ XcdBarrier xcd_barrier_post(unsigned* bar, volatile LAS unsigned* st) {
    XcdBarrier b; b.bar = bar; b.x = xb_xcc_id(); b.st = st;
    if (threadIdx.x == 0) (void)xb_add(&bar[XB_XCNT(b.x)], 1u);
    return b;
}
__device__ __forceinline__ void xcd_barrier_complete(unsigned* bar, unsigned x, unsigned& nloc, unsigned& nx) {
    const unsigned G = gridDim.x * gridDim.y * gridDim.z;
    unsigned sum, cnt, mine, sp = 0u;
    for (;;) {
        sum = 0u; cnt = 0u; mine = 0u;
#pragma unroll
        for (unsigned j = 0; j < 16; ++j) { const unsigned c = xb_ld(&bar[XB_XCNT(j)]); sum += c; cnt += (c > 0u) ? 1u : 0u; mine = (j == x) ? c : mine; }
        if (sum == G) break;
        __builtin_amdgcn_s_sleep(1);
        if ((++sp & 255u) == 0u) { if (xb_ld(&bar[XB_TMO])) break; if (sp > XB_SPIN_CAP) { atomicAdd(&bar[XB_TMO], 1u); break; } }
    }
    nloc = mine > 0u ? mine : 1u; nx = cnt > 0u ? cnt : 1u;
}
__device__ __forceinline__ void xcd_barrier1(const XcdBarrier& b) {
    asm volatile("s_waitcnt vmcnt(0)" ::: "memory");
    __syncthreads();
    if (threadIdx.x == 0) {
        unsigned* bar = b.bar;
        const unsigned bx = xb_xcc_id();
        __builtin_amdgcn_s_waitcnt(0);
        unsigned nloc = b.st[0], nx = b.st[1];
        if (nloc == 0u) { xcd_barrier_complete(bar, bx, nloc, nx); b.st[0] = nloc; b.st[1] = nx; }
        const unsigned old = xb_add(&bar[XB_XSUB(bx)], 1u);
        const unsigned gen = old / nloc;
        if (old + 1u == (gen + 1u) * nloc) {
            __builtin_amdgcn_fence(__ATOMIC_RELEASE, "agent");
            asm volatile("s_waitcnt vmcnt(0)" ::: "memory");
            const unsigned og = xb_add(&bar[XB_TOP], 1u);
            const unsigned tg = og / nx;
            if (og + 1u == (tg + 1u) * nx) xb_add(&bar[XB_TOPGEN], 1u);
            else XB_SPIN(xb_ld(&bar[XB_TOPGEN]) == tg, bar);
            __builtin_amdgcn_fence(__ATOMIC_ACQUIRE, "agent");
            xb_add(&bar[XB_XGEN(bx)], 1u);
            asm volatile("s_waitcnt vmcnt(0)" ::: "memory");
        } else {
            XB_SPIN(xb_ld(&bar[XB_XGEN(bx)]) == gen, bar);
            __builtin_amdgcn_fence(__ATOMIC_ACQUIRE, "agent");
            asm volatile("s_waitcnt vmcnt(0)" ::: "memory");
        }
    }
    __syncthreads();
}

__device__ __forceinline__ void xcd_barrier(const XcdBarrier& b) { xcd_barrier1(b); if (PROBE == 11) xcd_barrier1(b); }
struct Params { const float* in[28]; float* out; unsigned char* ws; };

__device__ __forceinline__ void prep_tile(const float* src, int K, int N, bf16_t* dst, int mode, int kt, int ntile, LAS float* scr) {
    const int t = threadIdx.x; const int k0 = kt * 64, n0 = ntile * 64;
#pragma unroll
    for (int j = 0; j < 2; ++j) { const int r = (t >> 4) + 32 * j, c4 = (t & 15) * 4; const int n = n0 + c4;
        f32x4 v = (f32x4){0.f, 0.f, 0.f, 0.f}; if (n < N) v = *(const f32x4*)(src + (size_t)(k0 + r) * N + n);
        scr[r * 65 + c4 + 0] = v[0]; scr[r * 65 + c4 + 1] = v[1]; scr[r * 65 + c4 + 2] = v[2]; scr[r * 65 + c4 + 3] = v[3]; }
    __syncthreads();
    { const int nl = t >> 3, kc = (t & 7) * 8; const int n = n0 + nl;
      int drow; if (mode == 0) drow = n; else if (mode == 1) drow = 256 * (n >> 7) + (n & 127); else drow = 256 * (n >> 7) + 128 + (n & 127);
      u32x4 o; o.x = pk2(scr[(kc + 0) * 65 + nl], scr[(kc + 1) * 65 + nl]); o.y = pk2(scr[(kc + 2) * 65 + nl], scr[(kc + 3) * 65 + nl]);
      o.z = pk2(scr[(kc + 4) * 65 + nl], scr[(kc + 5) * 65 + nl]); o.w = pk2(scr[(kc + 6) * 65 + nl], scr[(kc + 7) * 65 + nl]);
      *(u32x4*)(dst + (size_t)drow * K + k0 + kc) = o; }
    __syncthreads();
}
__device__ __forceinline__ void phase_prep(const Params& P, LAS unsigned char* lds) {
    LAS float* s = (LAS float*)lds; unsigned char* ws = P.ws;
    constexpr int T_IN = 16 * 48, T_OUT = 16 * 16, T_GU = 16 * 56, T_D = 56 * 16;
    constexpr int N_IN = 4 * T_IN, N_OUT = 4 * T_OUT, N_G = 18 * T_GU, N_U = 18 * T_GU, N_D = 18 * T_D;
    constexpr int TOTAL = N_IN + N_OUT + N_G + N_U + N_D;
    for (int it = blockIdx.x; it < TOTAL; it += gridDim.x) {
        int r = it;
        if (r < N_IN) { const int l = r / T_IN, q = r % T_IN; prep_tile(P.in[1] + (size_t)l * DM * INC, DM, INC, (bf16_t*)(ws + WS_WIN) + (size_t)l * INP * DM, 0, q / 48, q % 48, s); continue; } r -= N_IN;
        if (r < N_OUT) { const int l = r / T_OUT, q = r % T_OUT; prep_tile(P.in[2] + (size_t)l * DM * DM, DM, DM, (bf16_t*)(ws + WS_WOUT) + (size_t)l * DM * DM, 0, q / 16, q % 16, s); continue; } r -= N_OUT;
        if (r < N_G + N_U) { const int up = r >= N_G; if (up) r -= N_G; const int sl = r / T_GU, q = r % T_GU;
            const float* src = sl < 2 ? (up ? P.in[22] : P.in[21]) + (size_t)sl * DM * DFF : (up ? P.in[26] : P.in[25]) + (size_t)(sl - 2) * DM * DFF;
            prep_tile(src, DM, DFF, (bf16_t*)(ws + WS_WGU) + (size_t)sl * 2 * DFF * DM, up ? 2 : 1, q / 56, q % 56, s); continue; } r -= N_G + N_U;
        { const int sl = r / T_D, q = r % T_D; const float* src = sl < 2 ? P.in[23] + (size_t)sl * DFF * DM : P.in[27] + (size_t)(sl - 2) * DFF * DM;
          prep_tile(src, DFF, DM, (bf16_t*)(ws + WS_WD) + (size_t)sl * DM * DFF, 0, q / 16, q % 16, s); }
    }
    const float* x = P.in[0]; bf16_t* xb = (bf16_t*)(ws + WS_XB);
    for (size_t i = ((size_t)blockIdx.x * 512 + threadIdx.x) * 4; i < (size_t)MTOK * DM; i += (size_t)gridDim.x * 512 * 4) {
        const f32x4 v = *(const f32x4*)(x + i); u32x2 o; o.x = pk2(v[0], v[1]); o.y = pk2(v[2], v[3]); *(u32x2*)(xb + i) = o; }
}

__device__ __forceinline__ float gelu_tanh(float x) { const float u = 0.7978845608028654f * (x + 0.044715f * x * x * x); return 0.5f * x * (1.f + tanhf(u)); }

__device__ __forceinline__ void kmean_item(const Params& P, int item, int lane) {
    const bf16_t* h = (const bf16_t*)(P.ws + WS_R1 + R1_H); float* kmean = (float*)(P.ws + WS_R1 + R1_KMEAN);
    const int part = item & 3, it2 = item >> 2; const int bb = it2 / 6, c = (it2 % 6) * 64 + lane;
    const bf16_t* p = h + ((size_t)bb * 256 + part * 64) * INP + C_MK + c;
    float s0 = 0.f, s1 = 0.f, s2 = 0.f, s3 = 0.f;
#pragma unroll
    for (int r = 0; r < 64; r += 4) { s0 += bf2f(p[(size_t)r * INP]); s1 += bf2f(p[(size_t)(r + 1) * INP]); s2 += bf2f(p[(size_t)(r + 2) * INP]); s3 += bf2f(p[(size_t)(r + 3) * INP]); }
    kmean[(bb * 4 + part) * 384 + c] = ((s0 + s1) + (s2 + s3)) * (1.f / 256.f);
}


constexpr size_t WS_S5W1 = 847 * MiB, WS_S5W23 = 851 * MiB, WS_S5LAM = 863 * MiB;
__device__ __forceinline__ void s5prep_item(const Params& P, int item, LAS unsigned char* lds) {
    const int tid = opaque((int)threadIdx.x); const int l = item >> 4, g = item & 15;
    LAS float* lamp = (LAS float*)lds;
    LAS float* bbar = lamp + 17 * 64 * 2;
    LAS float* Cc = bbar + 64 * 16 * 2;
    LAS float* Km = Cc + 16 * 64 * 2;
    const float* lam_re = P.in[3] + l * S5G * S5N; const float* lam_im = P.in[4] + l * S5G * S5N; const float* log_dt = P.in[5] + l * S5G;
    const float* b_re = P.in[6] + (size_t)l * S5G * S5N * S5P; const float* b_im = P.in[7] + (size_t)l * S5G * S5N * S5P;
    const float* c_re = P.in[8] + (size_t)l * S5G * S5P * S5N; const float* c_im = P.in[9] + (size_t)l * S5G * S5P * S5N; const float* dskp = P.in[10] + l * S5G * S5P + g * S5P;
    if (tid < 64) { const int n = tid;
        const float lre = lam_re[g * S5N + n], lim = lam_im[g * S5N + n], dt = expf(log_dt[g]); const float a = lre * dt, bb = lim * dt;
        for (int k = 0; k <= 16; ++k) { float sn, cs; sincosf((float)k * bb, &sn, &cs); const float er = expf((float)k * a); lamp[(k * 64 + n) * 2] = er * cs; lamp[(k * 64 + n) * 2 + 1] = er * sn; }
        float sn, cs; sincosf(bb, &sn, &cs); const float sh = sinf(0.5f * bb); const float nr = expm1f(a) * cs - 2.f * sh * sh, ni = expf(a) * sn;
        const float den = lre * lre + lim * lim; const float fr = (nr * lre + ni * lim) / den, fi = (ni * lre - nr * lim) / den;
        for (int p = 0; p < S5P; ++p) { const float bre = b_re[(g * S5N + n) * S5P + p], bim = b_im[(g * S5N + n) * S5P + p]; bbar[(n * 16 + p) * 2] = fr * bre - fi * bim; bbar[(n * 16 + p) * 2 + 1] = fr * bim + fi * bre; }
    }
    for (int e = tid; e < 1024; e += 512) { const int p = e >> 6, n = e & 63; Cc[e * 2] = c_re[(g * S5P + p) * S5N + n]; Cc[e * 2 + 1] = c_im[(g * S5P + p) * S5N + n]; }
    __syncthreads();
    if (tid < 64) { float* lam16 = (float*)(P.ws + WS_S5LAM) + (size_t)item * 128; lam16[tid * 2] = lamp[(16 * 64 + tid) * 2]; lam16[tid * 2 + 1] = lamp[(16 * 64 + tid) * 2 + 1]; }
    for (int e = tid; e < 4096; e += 512) { const int d = e >> 8, pp = (e >> 4) & 15, q = e & 15; float s = 0.f;
        for (int n = 0; n < 64; ++n) { const float cr = Cc[(pp * 64 + n) * 2], ci = Cc[(pp * 64 + n) * 2 + 1], lr = lamp[(d * 64 + n) * 2], li = lamp[(d * 64 + n) * 2 + 1];
            const float zr = cr * lr - ci * li, zi = cr * li + ci * lr; s += zr * bbar[(n * 16 + q) * 2] - zi * bbar[(n * 16 + q) * 2 + 1]; }
        Km[e] = s; }
    __syncthreads();
    bf16_t* W1 = (bf16_t*)(P.ws + WS_S5W1 + (size_t)item * 65536);
    for (int e = tid; e < 256 * 128; e += 512) { const int k = e >> 7, col = e & 127; const int t = k >> 4, p = k & 15, n = col >> 1, ri = col & 1;
        const float lr = lamp[((15 - t) * 64 + n) * 2], li = lamp[((15 - t) * 64 + n) * 2 + 1], br = bbar[(n * 16 + p) * 2], bi = bbar[(n * 16 + p) * 2 + 1];
        const float val = ri ? (lr * bi + li * br) : (lr * br - li * bi);
        W1[(((k >> 5) * 8 + (col >> 4)) * 64 + (col & 15) + 16 * ((k & 31) >> 3)) * 8 + (k & 7)] = (bf16_t)f2bf(val); }
    bf16_t* W23 = (bf16_t*)(P.ws + WS_S5W23 + (size_t)item * 196608);
    for (int e = tid; e < 384 * 256; e += 512) { const int k = e >> 8, col = e & 255; const int tp = col >> 4, pp = col & 15; float val;
        if (k < 256) { const int tau = k >> 4, q = k & 15; val = tp >= tau ? Km[((tp - tau) * 16 + pp) * 16 + q] : 0.f; if (tau == tp && q == pp) val += dskp[pp]; }
        else { const int comp = k - 256, n = comp >> 1, ri = comp & 1; const float cr = Cc[(pp * 64 + n) * 2], ci = Cc[(pp * 64 + n) * 2 + 1], lr = lamp[((tp + 1) * 64 + n) * 2], li = lamp[((tp + 1) * 64 + n) * 2 + 1];
            val = ri ? -(cr * li + ci * lr) : (cr * lr - ci * li); }
        W23[(((k >> 5) * 16 + (col >> 4)) * 64 + (col & 15) + 16 * ((k & 31) >> 3)) * 8 + (k & 7)] = (bf16_t)f2bf(val); }
    __syncthreads();
}
__device__ __forceinline__ float gelu_tanh_fast(float x) { const float u2 = 1.5957691216057308f * (x + 0.044715f * x * x * x); return x / (1.f + __expf(-u2)); }
__device__ __forceinline__ void s5_unit(const Params& P, int l, int unit, LAS unsigned char* lds) {
    const int tid = opaque((int)threadIdx.x), lane = tid & 63, wave = __builtin_amdgcn_readfirstlane(tid >> 6), q = lane >> 4, n_i = lane & 15;
    const int b = unit >> 4, g = unit & 15, item = l * 16 + g;
    const bf16_t* h = (const bf16_t*)(P.ws + WS_R1 + R1_H); bf16_t* ys5 = (bf16_t*)(P.ws + WS_R1 + R1_YS5);
    const bf16x8* W1f = (const bf16x8*)(P.ws + WS_S5W1 + (size_t)item * 65536); const bf16x8* W23f = (const bf16x8*)(P.ws + WS_S5W23 + (size_t)item * 196608);
    LAS unsigned char* RA = lds; LAS unsigned char* RB = lds + 65536; LAS unsigned char* RS = lds + 98304;
#pragma unroll
    for (int ks = 0; ks < 8; ++ks) { const int tok = (16 * wave + n_i) * 16 + 2 * ks + (q >> 1);
        __builtin_amdgcn_global_load_lds((const unsigned*)(h + ((size_t)(b * SEQ + tok) * INP + C_S5 + g * 16 + 8 * (q & 1))), (LAS unsigned*)(RA + (wave * 8 + ks) * 1024), 16, 0, 0); }
    asm volatile("s_waitcnt vmcnt(0)" ::: "memory"); __syncthreads();
    f32x4 acc[8];
#pragma unroll
    for (int m = 0; m < 8; ++m) acc[m] = (f32x4){0.f, 0.f, 0.f, 0.f};
#pragma unroll
    for (int ks = 0; ks < 8; ++ks) { const bf16x8 bfr = W1f[(ks * 8 + wave) * 64 + lane];
#pragma unroll
        for (int m = 0; m < 8; ++m) acc[m] = __builtin_amdgcn_mfma_f32_16x16x32_bf16(*(const LAS bf16x8*)(RA + ((m * 8 + ks) * 64 + lane) * 16), bfr, acc[m], 0, 0, 0); }
    float sr = 0.f, si = 0.f;
    const float* lam16 = (const float*)(P.ws + WS_S5LAM) + (size_t)item * 128;
    const float Lr = lam16[2 * lane], Li = lam16[2 * lane + 1];
#pragma unroll
    for (int h2 = 0; h2 < 2; ++h2) {
#pragma unroll
        for (int mm = 0; mm < 4; ++mm)
#pragma unroll
            for (int r = 0; r < 4; ++r) *(LAS float*)(RB + ((16 * mm + 4 * q + r) * 128 + 16 * wave + n_i) * 4) = acc[4 * h2 + mm][r];
        __syncthreads();
        if (wave == 0) {
            for (int rl = 0; rl < 64; ++rl) { const int c = 64 * h2 + rl; const float lr_ = *(const LAS float*)(RB + (rl * 128 + 2 * lane) * 4), li_ = *(const LAS float*)(RB + (rl * 128 + 2 * lane + 1) * 4);
                *(LAS unsigned*)(RS + ((c >> 4) * 4 + (lane >> 4)) * 1024 + ((c & 15) + 16 * ((lane & 15) >> 2)) * 16 + (lane & 3) * 4) = pg8::cvt_pk_bf16(sr, si);
                const float nsr = Lr * sr - Li * si + lr_, nsi = Lr * si + Li * sr + li_; sr = nsr; si = nsi; }
        }
        __syncthreads();
    }
    f32x4 a2[8][2];
#pragma unroll
    for (int m = 0; m < 8; ++m) { a2[m][0] = (f32x4){0.f, 0.f, 0.f, 0.f}; a2[m][1] = a2[m][0]; }
    for (int ks = 0; ks <= wave; ++ks) { const bf16x8 b0 = W23f[(ks * 16 + 2 * wave) * 64 + lane], b1 = W23f[(ks * 16 + 2 * wave + 1) * 64 + lane];
#pragma unroll
        for (int m = 0; m < 8; ++m) { const bf16x8 a = *(const LAS bf16x8*)(RA + ((m * 8 + ks) * 64 + lane) * 16);
            a2[m][0] = __builtin_amdgcn_mfma_f32_16x16x32_bf16(a, b0, a2[m][0], 0, 0, 0); a2[m][1] = __builtin_amdgcn_mfma_f32_16x16x32_bf16(a, b1, a2[m][1], 0, 0, 0); } }
#pragma unroll
    for (int ks = 0; ks < 4; ++ks) { const bf16x8 b0 = W23f[((8 + ks) * 16 + 2 * wave) * 64 + lane], b1 = W23f[((8 + ks) * 16 + 2 * wave + 1) * 64 + lane];
#pragma unroll
        for (int m = 0; m < 8; ++m) { const bf16x8 a = *(const LAS bf16x8*)(RS + ((m * 4 + ks) * 64 + lane) * 16);
            a2[m][0] = __builtin_amdgcn_mfma_f32_16x16x32_bf16(a, b0, a2[m][0], 0, 0, 0); a2[m][1] = __builtin_amdgcn_mfma_f32_16x16x32_bf16(a, b1, a2[m][1], 0, 0, 0); } }
#pragma unroll
    for (int m = 0; m < 8; ++m)
#pragma unroll
        for (int j = 0; j < 2; ++j)
#pragma unroll
            for (int r = 0; r < 4; ++r) { const int chunk = 16 * m + 4 * q + r; ys5[((size_t)(b * SEQ + chunk * 16 + 2 * wave + j)) * 256 + g * 16 + n_i] = (bf16_t)f2bf(gelu_tanh_fast(a2[m][j][r])); }
    __syncthreads();
}

constexpr int GREC = 49152, GR_WNEG = 0, GR_QG = 8192, GR_ATTN = 16384, GR_KDT = 24576, GR_U = 32768;
constexpr int GC_K = 0, GC_V = 9216, GC_L = 18432, GC_G = 26880, GC_B = 27136, GC_BYTES = 27392;
constexpr size_t R1_GREC = R1_GQKV, R1_EGL = R1_KMEAN + 524288;
__host__ __device__ constexpr int tri_off(int i) { return i == 0 ? 0 : 4 * ((((i - 1) >> 2) + 1) * (2 * ((i - 1) >> 2) + ((i - 1) & 3))); }
__device__ __forceinline__ int afrag_byte(int row, int k) { const int f = (row >> 4) * 2 + (k >> 5), kp = k & 31, q4 = (kp & 15) >> 2, j = (kp >> 4) * 4 + (kp & 3); return f * 1024 + ((row & 15) + 16 * q4) * 16 + j * 2; }
__device__ __forceinline__ bf16x8 pack8(const float* v) { u32x4 w; w.x = pg8::cvt_pk_bf16(v[0], v[1]); w.y = pg8::cvt_pk_bf16(v[2], v[3]); w.z = pg8::cvt_pk_bf16(v[4], v[5]); w.w = pg8::cvt_pk_bf16(v[6], v[7]); return __builtin_bit_cast(bf16x8, w); }
__device__ __forceinline__ bf16x8 pack44(const f32x4& a, const f32x4& b) { u32x4 w; w.x = pg8::cvt_pk_bf16(a[0], a[1]); w.y = pg8::cvt_pk_bf16(a[2], a[3]); w.z = pg8::cvt_pk_bf16(b[0], b[1]); w.w = pg8::cvt_pk_bf16(b[2], b[3]); return __builtin_bit_cast(bf16x8, w); }

template <int X> __device__ __forceinline__ void gdn_conv(const bf16_t* h, const float* conv_w, int b, int hh, int c, int w2, int i16, int q4, float (&dst)[2][2][8]) {
#pragma unroll
    for (int ks = 0; ks < 2; ++ks) {
        const int ch0 = X * 384 + hh * 64 + 32 * ks + 8 * q4;
        float wj[4][8];
#pragma unroll
        for (int j = 0; j < 4; ++j) { const f32x4 a = *(const f32x4*)(conv_w + j * 1152 + ch0), bq = *(const f32x4*)(conv_w + j * 1152 + ch0 + 4);
            wj[j][0] = a[0]; wj[j][1] = a[1]; wj[j][2] = a[2]; wj[j][3] = a[3]; wj[j][4] = bq[0]; wj[j][5] = bq[1]; wj[j][6] = bq[2]; wj[j][7] = bq[3]; }
#pragma unroll
        for (int m = 0; m < 2; ++m) {
            const int tseq = c * 64 + 32 * w2 + 16 * m + i16;
            float acc[8];
#pragma unroll
            for (int jj = 0; jj < 8; ++jj) acc[jj] = 0.f;
#pragma unroll
            for (int j = 0; j < 4; ++j) { const int tt = tseq - 3 + j; const float msk = tt >= 0 ? 1.f : 0.f; const int ttc = tt >= 0 ? tt : 0;
                const u32x4 raw = *(const u32x4*)(h + ((size_t)b * SEQ + ttc) * INP + C_GQ + ch0);
#pragma unroll
                for (int jj = 0; jj < 4; ++jj) { acc[2 * jj] += msk * wj[j][2 * jj] * __uint_as_float(raw[jj] << 16); acc[2 * jj + 1] += msk * wj[j][2 * jj + 1] * __uint_as_float(raw[jj] & 0xffff0000u); } }
#pragma unroll
            for (int jj = 0; jj < 8; ++jj) dst[m][ks][jj] = siluf_(acc[jj]);
        }
        asm volatile("" ::: "memory");
    }
}

__device__ __forceinline__ void gdn_local_unit(const Params& P, int l, int unit, LAS unsigned char* lds) {
    const int tid = opaque((int)threadIdx.x), lane = tid & 63, wave = __builtin_amdgcn_readfirstlane(tid >> 6), pr = wave >> 1, w2 = wave & 1;
    const int i16 = lane & 15, q4 = lane >> 4;
    const int bh = unit >> 3, c = (unit & 7) * 4 + pr; const int b = bh / NH, hh = bh % NH;
    const bf16_t* h = (const bf16_t*)(P.ws + WS_R1 + R1_H); const float* aux = (const float*)(P.ws + WS_R1 + R1_AUX); const float* conv_w = P.in[13] + (size_t)l * 4 * 1152;
    unsigned char* rec = P.ws + WS_R1 + R1_GREC + (size_t)(bh * 32 + c) * GREC; float* egl = (float*)(P.ws + WS_R1 + R1_EGL);
    LAS unsigned char* Lc = lds + pr * GC_BYTES;
    LAS float* gcL = (LAS float*)(Lc + GC_G); LAS float* btL = (LAS float*)(Lc + GC_B); LAS float* Ltri = (LAS float*)(Lc + GC_L);
    const size_t tok0 = (size_t)b * SEQ + c * 64;
    float gc;
    { const float a = aux[(tok0 + lane) * 16 + hh] + P.in[15][l * NH + hh]; const float sp = a > 20.f ? a : log1pf(expf(a)); gc = -expf(P.in[14][l * NH + hh]) * sp;
      const float beta = sigmoidf_(aux[(tok0 + lane) * 16 + 6 + hh]);
#pragma unroll
      for (int o = 1; o < 64; o <<= 1) { const float t = __shfl_up(gc, o); if (lane >= o) gc += t; }
      if (w2 == 0) { gcL[lane] = gc; btL[lane] = beta; } }
    const float gl = __shfl(gc, 63);
    if (w2 == 0 && lane == 0) egl[bh * 32 + c] = expf(gl);
    bf16x8 qf[2][2], kf[2][2];
    {   float qv[2][2][8];
        gdn_conv<0>(h, conv_w, b, hh, c, w2, i16, q4, qv);
#pragma unroll
        for (int m = 0; m < 2; ++m) {
            const int tl = 32 * w2 + 16 * m + i16;
            float sq = 0.f;
#pragma unroll
            for (int ks = 0; ks < 2; ++ks)
#pragma unroll
                for (int jj = 0; jj < 8; ++jj) sq += qv[m][ks][jj] * qv[m][ks][jj];
            sq += __shfl_xor(sq, 16); sq += __shfl_xor(sq, 32);
            const float rq = rsqrtf(sq + RMS_EPS) * 0.125f; const float eg = expf(__shfl(gc, tl));
#pragma unroll
            for (int ks = 0; ks < 2; ++ks) {
                float qn[8], qg[8];
#pragma unroll
                for (int jj = 0; jj < 8; ++jj) { qn[jj] = qv[m][ks][jj] * rq; qg[jj] = qn[jj] * eg; }
                qf[m][ks] = pack8(qn);
                const int f = (2 * w2 + m) * 2 + ks;
                const int offA = f * 1024 + (i16 + 16 * ((2 * q4) & 3)) * 16 + (q4 >> 1) * 8, offB = f * 1024 + (i16 + 16 * ((2 * q4 + 1) & 3)) * 16 + (q4 >> 1) * 8;
                u32x2 wa; wa.x = pg8::cvt_pk_bf16(qg[0], qg[1]); wa.y = pg8::cvt_pk_bf16(qg[2], qg[3]); *(u32x2*)(rec + GR_QG + offA) = wa;
                u32x2 wb; wb.x = pg8::cvt_pk_bf16(qg[4], qg[5]); wb.y = pg8::cvt_pk_bf16(qg[6], qg[7]); *(u32x2*)(rec + GR_QG + offB) = wb;
            }
        }
    }
    asm volatile("" ::: "memory");
    {   float kv[2][2][8];
        gdn_conv<1>(h, conv_w, b, hh, c, w2, i16, q4, kv);
#pragma unroll
        for (int m = 0; m < 2; ++m) {
            const int tl = 32 * w2 + 16 * m + i16;
            float sk = 0.f;
#pragma unroll
            for (int ks = 0; ks < 2; ++ks)
#pragma unroll
                for (int jj = 0; jj < 8; ++jj) sk += kv[m][ks][jj] * kv[m][ks][jj];
            sk += __shfl_xor(sk, 16); sk += __shfl_xor(sk, 32);
            const float rk = rsqrtf(sk + RMS_EPS); const float ekd = expf(gl - __shfl(gc, tl));
#pragma unroll
            for (int ks = 0; ks < 2; ++ks) {
                float kn[8];
#pragma unroll
                for (int jj = 0; jj < 8; ++jj) kn[jj] = kv[m][ks][jj] * rk;
                kf[m][ks] = pack8(kn);
                *(LAS bf16x8*)(Lc + GC_K + tl * 144 + (32 * ks + 8 * q4) * 2) = kf[m][ks];
#pragma unroll
                for (int jj = 0; jj < 8; ++jj) *(bf16_t*)(rec + GR_KDT + afrag_byte(32 * ks + 8 * q4 + jj, tl)) = (bf16_t)f2bf(kn[jj] * ekd);
            }
        }
    }
    asm volatile("" ::: "memory");
    {   float vv[2][2][8];
        gdn_conv<2>(h, conv_w, b, hh, c, w2, i16, q4, vv);
#pragma unroll
        for (int m = 0; m < 2; ++m) { const int tl = 32 * w2 + 16 * m + i16;
#pragma unroll
            for (int ks = 0; ks < 2; ++ks) *(LAS bf16x8*)(Lc + GC_V + tl * 144 + (32 * ks + 8 * q4) * 2) = pack8(vv[m][ks]); }
    }
    __syncthreads();
#pragma unroll
    for (int mm = 0; mm < 2; ++mm) {
        const int mt = 2 * w2 + mm;
#pragma unroll
        for (int nt = 0; nt < 4; ++nt) {
            if (nt <= mt) {
                const bf16x8 bk0 = *(const LAS bf16x8*)(Lc + GC_K + (16 * nt + i16) * 144 + (8 * q4) * 2), bk1 = *(const LAS bf16x8*)(Lc + GC_K + (16 * nt + i16) * 144 + (32 + 8 * q4) * 2);
                f32x4 kk = __builtin_amdgcn_mfma_f32_16x16x32_bf16(kf[mm][0], bk0, (f32x4){0.f, 0.f, 0.f, 0.f}, 0, 0, 0); kk = __builtin_amdgcn_mfma_f32_16x16x32_bf16(kf[mm][1], bk1, kk, 0, 0, 0);
                f32x4 qk = __builtin_amdgcn_mfma_f32_16x16x32_bf16(qf[mm][0], bk0, (f32x4){0.f, 0.f, 0.f, 0.f}, 0, 0, 0); qk = __builtin_amdgcn_mfma_f32_16x16x32_bf16(qf[mm][1], bk1, qk, 0, 0, 0);
                const int s = 16 * nt + i16; const float gs = gcL[s];
#pragma unroll
                for (int rr = 0; rr < 4; ++rr) { const int r = 16 * mt + 4 * q4 + rr; const float dec = __expf(fminf(gcL[r] - gs, 0.f));
                    if (s < r) { const int n1 = r - 1, a1 = n1 >> 2, b1 = n1 & 3; Ltri[4 * ((a1 + 1) * (2 * a1 + b1)) + s] = btL[r] * kk[rr] * dec; }
                    *(bf16_t*)(rec + GR_ATTN + afrag_byte(r, s)) = (bf16_t)f2bf(s <= r ? qk[rr] * dec : 0.f); }
            } else if (nt == mt + 1 && (mt & 1) == 0) {
#pragma unroll
                for (int rr = 0; rr < 4; ++rr) *(bf16_t*)(rec + GR_ATTN + afrag_byte(16 * mt + 4 * q4 + rr, 16 * nt + i16)) = (bf16_t)0;
            }
        }
    }
    __syncthreads();
    {
        const LAS bf16_t* src = (const LAS bf16_t*)(Lc + (w2 ? GC_K : GC_V));
        float x[64];
#pragma unroll
        for (int i = 0; i < 64; ++i) {
            const float sc = btL[i] * __expf(w2 ? gcL[i] : 0.f);
            float acc = sc * bf2f(src[i * 72 + lane]);
#pragma unroll
            for (int j4 = 0; j4 < i; j4 += 4) { const f32x4 Lr = *(const LAS f32x4*)(Ltri + tri_off(i) + j4);
#pragma unroll
                for (int jj = 0; jj < 4; ++jj) if (j4 + jj < i) acc -= Lr[jj] * x[j4 + jj]; }
            asm volatile("" : "+v"(acc) :: "memory");
            x[i] = acc;
        }
        if (w2 == 0) {
            const int w = lane >> 4, n = lane & 15;
#pragma unroll
            for (int a = 0; a < 16; ++a) *(f32x4*)(rec + GR_U + ((w * 4 + (a >> 2)) * 64 + n + 16 * (a & 3)) * 16) = (f32x4){x[4 * a], x[4 * a + 1], x[4 * a + 2], x[4 * a + 3]};
        } else {
#pragma unroll
            for (int cc = 0; cc < 64; ++cc) *(bf16_t*)(rec + GR_WNEG + afrag_byte(cc, lane)) = (bf16_t)f2bf(-x[cc]);
        }
    }
    __syncthreads();
}

__device__ __forceinline__ void gdn_scan_unit(const Params& P, int l, int bh, LAS unsigned char* lds) {
    const int tid = opaque((int)threadIdx.x), lane = tid & 63, wave = __builtin_amdgcn_readfirstlane(tid >> 6), q = lane >> 4, n = lane & 15;
    const int b = bh / NH, hh = bh % NH;
    const unsigned char* rec0 = P.ws + WS_R1 + R1_GREC + (size_t)bh * 32 * GREC; const float* egl = (const float*)(P.ws + WS_R1 + R1_EGL) + bh * 32;
    const bf16_t* h = (const bf16_t*)(P.ws + WS_R1 + R1_H); bf16_t* mix = (bf16_t*)(P.ws + WS_R1 + R1_MIX);
    LAS float* xs = (LAS float*)(lds + 2 * GREC);
#define GDN_ISSUE(cc, bufi) do { _Pragma("unroll") for (int k_ = 0; k_ < 6; ++k_) { const int piece = wave * 6 + k_; \
        __builtin_amdgcn_global_load_lds((const unsigned*)(rec0 + (size_t)(cc) * GREC + piece * 1024 + lane * 16), (LAS unsigned*)(lds + (bufi) * GREC + piece * 1024), 16, 0, 0); } } while (0)
#define GDN_AF(base, t, s) (*(const LAS bf16x8*)(buf + (base) + (((t) * 2 + (s)) * 64 + lane) * 16))
    const float eglv = egl[lane & 31];
    const int e = 16 * (wave & 3) + n;
    const float nw = P.in[16][l * HD + e];
    GDN_ISSUE(0, 0);
    asm volatile("s_waitcnt vmcnt(0)" ::: "memory"); __syncthreads();
    f32x4 St[4]; bf16x8 Sb[2]; f32x4 o[4];
#pragma unroll
    for (int t = 0; t < 4; ++t) { St[t] = (f32x4){0.f, 0.f, 0.f, 0.f}; o[t] = St[t]; }
    Sb[0] = (bf16x8){0, 0, 0, 0, 0, 0, 0, 0}; Sb[1] = Sb[0];
    for (int c = 0; c < 32; ++c) {
        const LAS unsigned char* buf = lds + (c & 1) * GREC;
        unsigned short zr[16];
        if (wave < 4) {
#pragma unroll
            for (int t = 0; t < 4; ++t)
#pragma unroll
                for (int r = 0; r < 4; ++r) zr[t * 4 + r] = h[((size_t)b * SEQ + c * 64 + 16 * t + 4 * q + r) * INP + C_GZ + hh * 64 + e];
        }
        if (c + 1 < 32) GDN_ISSUE(c + 1, (c + 1) & 1);
        if (wave < 4) {
            const float eg = __int_as_float(__builtin_amdgcn_readlane(__float_as_int(eglv), c));
            f32x4 vn[4]; bf16x8 fw[4][2], fq[4][2], fa[4][2], fk[4][2];
#pragma unroll
            for (int t = 0; t < 4; ++t) { vn[t] = *(const LAS f32x4*)(buf + GR_U + ((wave * 4 + t) * 64 + lane) * 16);
#pragma unroll
                for (int s2 = 0; s2 < 2; ++s2) { fw[t][s2] = GDN_AF(GR_WNEG, t, s2); fq[t][s2] = GDN_AF(GR_QG, t, s2); fa[t][s2] = GDN_AF(GR_ATTN, t, s2); fk[t][s2] = GDN_AF(GR_KDT, t, s2); } }
#pragma unroll
            for (int t = 0; t < 4; ++t)
#pragma unroll
                for (int s2 = 0; s2 < 2; ++s2) vn[t] = __builtin_amdgcn_mfma_f32_16x16x32_bf16(fw[t][s2], Sb[s2], vn[t], 0, 0, 0);
#pragma unroll
            for (int t = 0; t < 4; ++t) { o[t] = (f32x4){0.f, 0.f, 0.f, 0.f};
#pragma unroll
                for (int s2 = 0; s2 < 2; ++s2) o[t] = __builtin_amdgcn_mfma_f32_16x16x32_bf16(fq[t][s2], Sb[s2], o[t], 0, 0, 0); }
            bf16x8 Vb[2]; Vb[0] = pack44(vn[0], vn[1]); Vb[1] = pack44(vn[2], vn[3]);
#pragma unroll
            for (int t = 0; t < 4; ++t) { St[t] = St[t] * eg;
#pragma unroll
                for (int s2 = 0; s2 < 2; ++s2) St[t] = __builtin_amdgcn_mfma_f32_16x16x32_bf16(fk[t][s2], Vb[s2], St[t], 0, 0, 0); }
#pragma unroll
            for (int t = 0; t < 4; ++t)
#pragma unroll
                for (int s2 = 0; s2 < 2; ++s2) if (!(s2 == 1 && t < 2)) o[t] = __builtin_amdgcn_mfma_f32_16x16x32_bf16(fa[t][s2], Vb[s2], o[t], 0, 0, 0);
            Sb[0] = pack44(St[0], St[1]); Sb[1] = pack44(St[2], St[3]);
#pragma unroll
            for (int t = 0; t < 4; ++t)
#pragma unroll
                for (int r = 0; r < 4; ++r) { const float v = row16_sum(o[t][r] * o[t][r]); if (n == 0) xs[((c & 1) * 4 + wave) * 64 + 16 * t + 4 * q + r] = v; }
        }
        asm volatile("s_waitcnt vmcnt(0)" ::: "memory"); __syncthreads();
        if (wave < 4) {
#pragma unroll
            for (int t = 0; t < 4; ++t)
#pragma unroll
                for (int r = 0; r < 4; ++r) { const int pos = 16 * t + 4 * q + r; const LAS float* xp = xs + (c & 1) * 256 + pos;
                    const float tot = (xp[0] + xp[64]) + (xp[128] + xp[192]); const float rstd = rsqrtf(tot * (1.f / 64.f) + RMS_EPS);
                    mix[((size_t)b * SEQ + c * 64 + pos) * DM + 640 + hh * 64 + e] = (bf16_t)f2bf(o[t][r] * rstd * nw * siluf_(bf2f(zr[t * 4 + r]))); }
        }
    }
    __syncthreads();
#undef GDN_ISSUE
#undef GDN_AF
}

constexpr int MB_KV = 9216;
constexpr int MB_K0 = 0, MB_V0 = 2 * MB_KV, MB_MSK = 4 * MB_KV, MB_WG = MB_MSK + 1024, MB_BYTES = MB_WG + 64;
constexpr float MB_C = 0.125f * 1.4426950408889634f;
constexpr float MB_NEG = -1e30f;
__device__ __forceinline__ void moba_unit(const Params& P, int bh, int qb, LAS unsigned char* lds) {
    const int tid = opaque((int)threadIdx.x), lane = tid & 63, wave = __builtin_amdgcn_readfirstlane(tid >> 6), q4 = lane >> 4, n_i = lane & 15;
    const int b = bh / NH, hh = bh % NH;
    const bf16_t* h = (const bf16_t*)(P.ws + WS_R1 + R1_H); const float* kmean = (const float*)(P.ws + WS_R1 + R1_KMEAN); bf16_t* mix = (bf16_t*)(P.ws + WS_R1 + R1_MIX);
    const size_t row0 = (size_t)b * SEQ;
    const int q0 = qb * 256 + 32 * wave;
    LAS unsigned* mskL = (LAS unsigned*)(lds + MB_MSK); LAS unsigned* wgL = (LAS unsigned*)(lds + MB_WG);
    {   const int qi = lane & 31, half = lane >> 5;
        const bf16_t* qp = h + (row0 + q0 + qi) * INP + C_MQ + hh * HD;
        float gt[4] = {0.f, 0.f, 0.f, 0.f};
#pragma unroll
        for (int c8 = 0; c8 < 8; ++c8) { const u32x4 w = *(const u32x4*)(qp + c8 * 8); float qv[8];
#pragma unroll
            for (int jj = 0; jj < 4; ++jj) { qv[2 * jj] = __uint_as_float(w[jj] << 16); qv[2 * jj + 1] = __uint_as_float(w[jj] & 0xffff0000u); }
#pragma unroll
            for (int jb = 0; jb < 4; ++jb) { const float* km = kmean + (size_t)(b * 8 + 4 * half + jb) * 4 * 384 + hh * HD + c8 * 8;
                const f32x4 k0 = (*(const f32x4*)km + *(const f32x4*)(km + 384)) + (*(const f32x4*)(km + 768) + *(const f32x4*)(km + 1152)), k1 = (*(const f32x4*)(km + 4) + *(const f32x4*)(km + 388)) + (*(const f32x4*)(km + 772) + *(const f32x4*)(km + 1156));
                gt[jb] += (qv[0] * k0[0] + qv[1] * k0[1]) + (qv[2] * k0[2] + qv[3] * k0[3]) + (qv[4] * k1[0] + qv[5] * k1[1]) + (qv[6] * k1[2] + qv[7] * k1[3]); }
            asm volatile("" : "+v"(gt[0]), "+v"(gt[1]), "+v"(gt[2]), "+v"(gt[3]) :: "memory"); }
#pragma unroll
        for (int jb = 0; jb < 4; ++jb) gt[jb] = (4 * half + jb < qb) ? gt[jb] * 0.125f : -INFINITY;
        float gate[8];
#pragma unroll
        for (int jb = 0; jb < 4; ++jb) { const float o = __shfl_xor(gt[jb], 32); gate[jb] = half ? o : gt[jb]; gate[4 + jb] = half ? gt[jb] : o; }
        unsigned sel = 0;
#pragma unroll
        for (int j = 0; j < 8; ++j) { int rank = 0;
#pragma unroll
            for (int i = 0; i < 8; ++i) rank += (gate[i] > gate[j] || (gate[i] == gate[j] && i < j)) ? 1 : 0;
            if (j < qb && rank < 3) sel |= 1u << j; }
        if (lane < 32) mskL[wave * 32 + lane] = sel;
        unsigned wsel = sel;
#pragma unroll
        for (int o = 1; o < 32; o <<= 1) wsel |= __shfl_xor(wsel, o);
        if (lane == 0) wgL[wave] = wsel;
    }
    bf16x8 Qf[2][2];
#pragma unroll
    for (int qt = 0; qt < 2; ++qt)
#pragma unroll
        for (int ks = 0; ks < 2; ++ks) Qf[qt][ks] = *(const bf16x8*)(h + (row0 + q0 + 16 * qt + n_i) * INP + C_MQ + hh * HD + 32 * ks + 8 * q4);
    __syncthreads();
    unsigned wgmask = 0;
#pragma unroll
    for (int w = 0; w < 8; ++w) wgmask |= wgL[w];
    wgmask = (unsigned)__builtin_amdgcn_readfirstlane((int)wgmask);
    const unsigned msk0 = mskL[wave * 32 + n_i], msk1 = mskL[wave * 32 + 16 + n_i];
    const unsigned wvmask = (unsigned)__builtin_amdgcn_readfirstlane((int)wgL[wave]);
    const int nblk = 1 + __builtin_popcount(wgmask);
    const int ntile = 4 * nblk;
    const int skey = tid >> 3, sch = tid & 7;
    auto tile_block = [&](int t) -> int { const int bi = t >> 2; if (bi == 0) return qb; unsigned m = wgmask; int j = 0;
        for (int k = 1; k < bi; ++k) m &= m - 1u; j = __builtin_ctz(m); return j; };
    u32x4 kreg, vreg;
    { const int jb = qb; const size_t kr = (row0 + jb * 256 + skey) * INP + hh * HD + sch * 8; kreg = *(const u32x4*)(h + kr + C_MK); vreg = *(const u32x4*)(h + kr + C_MV); }
    *(LAS u32x4*)(lds + MB_K0 + skey * 144 + sch * 16) = kreg; *(LAS u32x4*)(lds + MB_V0 + skey * 144 + sch * 16) = vreg;
    __syncthreads();
    f32x4 ot[4][2];
#pragma unroll
    for (int dt = 0; dt < 4; ++dt) { ot[dt][0] = (f32x4){0.f, 0.f, 0.f, 0.f}; ot[dt][1] = ot[dt][0]; }
    float mrow[2] = {MB_NEG, MB_NEG}, lrow[2] = {0.f, 0.f};
    for (int t = 0; t < ntile; ++t) {
        const int cur = t & 1; const int jb = tile_block(t); const int tt = t & 3;
        if (t + 1 < ntile) { const int jn = tile_block(t + 1); const size_t kr = (row0 + jn * 256 + ((t + 1) & 3) * 64 + skey) * INP + hh * HD + sch * 8; kreg = *(const u32x4*)(h + kr + C_MK); vreg = *(const u32x4*)(h + kr + C_MV); }
        const bool own = (t < 4);
        const bool active = own ? (64 * tt <= 32 * wave + 31) : (((wvmask >> jb) & 1u) != 0u);
        if (active) {
            const LAS unsigned char* kL = lds + MB_K0 + cur * MB_KV; const LAS unsigned char* vL = lds + MB_V0 + cur * MB_KV;
            f32x4 st[4][2];
#pragma unroll
            for (int kt = 0; kt < 4; ++kt) { const bf16x8 k0 = *(const LAS bf16x8*)(kL + (16 * kt + n_i) * 144 + (8 * q4) * 2), k1 = *(const LAS bf16x8*)(kL + (16 * kt + n_i) * 144 + (32 + 8 * q4) * 2);
#pragma unroll
                for (int qt = 0; qt < 2; ++qt) { f32x4 a = __builtin_amdgcn_mfma_f32_16x16x32_bf16(k0, Qf[qt][0], (f32x4){0.f, 0.f, 0.f, 0.f}, 0, 0, 0); st[kt][qt] = __builtin_amdgcn_mfma_f32_16x16x32_bf16(k1, Qf[qt][1], a, 0, 0, 0); } }
            if (own) {
#pragma unroll
                for (int kt = 0; kt < 4; ++kt)
#pragma unroll
                    for (int qt = 0; qt < 2; ++qt)
#pragma unroll
                        for (int r = 0; r < 4; ++r) { const int key = 64 * tt + 16 * kt + 4 * q4 + r, qq = 32 * wave + 16 * qt + n_i; if (key > qq) st[kt][qt][r] = MB_NEG; }
            } else {
                const bool s0 = ((msk0 >> jb) & 1u) != 0u, s1 = ((msk1 >> jb) & 1u) != 0u;
#pragma unroll
                for (int kt = 0; kt < 4; ++kt)
#pragma unroll
                    for (int r = 0; r < 4; ++r) { if (!s0) st[kt][0][r] = MB_NEG; if (!s1) st[kt][1][r] = MB_NEG; }
            }
            bf16x8 Pb[2][2];
#pragma unroll
            for (int qt = 0; qt < 2; ++qt) {
                float mx = st[0][qt][0];
#pragma unroll
                for (int kt = 0; kt < 4; ++kt)
#pragma unroll
                    for (int r = 0; r < 4; ++r) mx = fmaxf(mx, st[kt][qt][r]);
                mx = fmaxf(mx, __shfl_xor(mx, 16)); mx = fmaxf(mx, __shfl_xor(mx, 32));
                const float mn = fmaxf(mrow[qt], mx); const float alpha = __builtin_amdgcn_exp2f((mrow[qt] - mn) * MB_C); mrow[qt] = mn; const float mc = mn * MB_C;
                float ps = 0.f;
#pragma unroll
                for (int kt = 0; kt < 4; ++kt)
#pragma unroll
                    for (int r = 0; r < 4; ++r) { const float p = __builtin_amdgcn_exp2f(st[kt][qt][r] * MB_C - mc); st[kt][qt][r] = p; ps += p; }
                lrow[qt] = lrow[qt] * alpha + ps;
#pragma unroll
                for (int dt = 0; dt < 4; ++dt) ot[dt][qt] = ot[dt][qt] * alpha;
                Pb[qt][0] = pack44(st[0][qt], st[1][qt]); Pb[qt][1] = pack44(st[2][qt], st[3][qt]);
            }
            const int qq = (lane & 15) >> 2, pp = lane & 3;
#pragma unroll
            for (int dt = 0; dt < 4; ++dt)
#pragma unroll
                for (int s2 = 0; s2 < 2; ++s2) {
                    typedef short v4s __attribute__((ext_vector_type(4)));
                    const v4s lo = __builtin_bit_cast(v4s, __builtin_amdgcn_ds_read_tr16_b64_v4i16((LAS v4s*)(vL + (32 * s2 + 4 * q4 + qq) * 144 + (16 * dt + 4 * pp) * 2)));
                    const v4s hi = __builtin_bit_cast(v4s, __builtin_amdgcn_ds_read_tr16_b64_v4i16((LAS v4s*)(vL + (32 * s2 + 16 + 4 * q4 + qq) * 144 + (16 * dt + 4 * pp) * 2)));
                    const bf16x8 vf = (bf16x8){lo[0], lo[1], lo[2], lo[3], hi[0], hi[1], hi[2], hi[3]};
                    ot[dt][0] = __builtin_amdgcn_mfma_f32_16x16x32_bf16(vf, Pb[0][s2], ot[dt][0], 0, 0, 0);
                    ot[dt][1] = __builtin_amdgcn_mfma_f32_16x16x32_bf16(vf, Pb[1][s2], ot[dt][1], 0, 0, 0);
                }
        }
        if (t + 1 < ntile) { *(LAS u32x4*)(lds + MB_K0 + (cur ^ 1) * MB_KV + skey * 144 + sch * 16) = kreg; *(LAS u32x4*)(lds + MB_V0 + (cur ^ 1) * MB_KV + skey * 144 + sch * 16) = vreg; }
        __syncthreads();
    }
#pragma unroll
    for (int qt = 0; qt < 2; ++qt) { float lt = lrow[qt]; lt += __shfl_xor(lt, 16); lt += __shfl_xor(lt, 32); const float inv = 1.f / lt;
#pragma unroll
        for (int dt = 0; dt < 4; ++dt) { u32x2 w; w.x = pg8::cvt_pk_bf16(ot[dt][qt][0] * inv, ot[dt][qt][1] * inv); w.y = pg8::cvt_pk_bf16(ot[dt][qt][2] * inv, ot[dt][qt][3] * inv);
            *(u32x2*)(mix + (row0 + q0 + 16 * qt + n_i) * DM + 256 + hh * HD + 16 * dt + 4 * q4) = w; } }
    __syncthreads();
}

constexpr size_t WS_GLUW = 863 * MiB + 65536;
__device__ __forceinline__ void gluprep(const Params& P, int l, int tid0, int nthr) {
    bf16_t* GW = (bf16_t*)(P.ws + WS_GLUW + (size_t)l * 131072); const float* W = P.in[11] + (size_t)l * 65536;
    for (int e = tid0; e < 65536; e += nthr) { const int k = e >> 8, col = e & 255; GW[(((k >> 5) * 16 + (col >> 4)) * 64 + (col & 15) + 16 * ((k & 31) >> 3)) * 8 + (k & 7)] = (bf16_t)f2bf(W[e]); }
}
__device__ __forceinline__ void glu_unit(const Params& P, int l, int unit) {
    const int tid = opaque((int)threadIdx.x), lane = tid & 63, wave = __builtin_amdgcn_readfirstlane(tid >> 6), q4 = lane >> 4, n_i = lane & 15;
    const bf16_t* ys = (const bf16_t*)(P.ws + WS_R1 + R1_YS5); bf16_t* mix = (bf16_t*)(P.ws + WS_R1 + R1_MIX);
    const bf16x8* GW = (const bf16x8*)(P.ws + WS_GLUW + (size_t)l * 131072); const float* bias = P.in[12] + l * 256;
    const int tok0 = unit * 256 + 32 * wave;
    bf16x8 af[2][8];
#pragma unroll
    for (int mt = 0; mt < 2; ++mt)
#pragma unroll
        for (int ks = 0; ks < 8; ++ks) af[mt][ks] = *(const bf16x8*)(ys + (size_t)(tok0 + 16 * mt + n_i) * 256 + 32 * ks + 8 * q4);
#pragma unroll 2
    for (int nt = 0; nt < 16; ++nt) {
        f32x4 a0 = (f32x4){0.f, 0.f, 0.f, 0.f}, a1 = a0;
#pragma unroll
        for (int ks = 0; ks < 8; ++ks) { const bf16x8 bfr = GW[(ks * 16 + nt) * 64 + lane]; a0 = __builtin_amdgcn_mfma_f32_16x16x32_bf16(af[0][ks], bfr, a0, 0, 0, 0); a1 = __builtin_amdgcn_mfma_f32_16x16x32_bf16(af[1][ks], bfr, a1, 0, 0, 0); }
        const int col = 16 * nt + n_i; const float bv = bias[col];
#pragma unroll
        for (int r = 0; r < 4; ++r) { const size_t t0 = (size_t)(tok0 + 4 * q4 + r), t1 = t0 + 16;
            mix[t0 * DM + col] = (bf16_t)f2bf(bf2f(ys[t0 * 256 + col]) * sigmoidf_(a0[r] + bv)); mix[t1 * DM + col] = (bf16_t)f2bf(bf2f(ys[t1 * 256 + col]) * sigmoidf_(a1[r] + bv)); }
    }
}

__device__ __forceinline__ void ln1_row(const Params& P, int l, int row, int lane, int& re1, int& re2, float& rw1) {
    unsigned char* ws = P.ws; const int moe = l & 1;
    const float* xin = l == 0 ? P.in[0] : (const float*)P.out; const float* y = (const float*)(ws + WS_Y);
    const float* g = P.in[17] + l * DM; const float* bvec = P.in[18] + l * DM;
    float* x1 = (float*)(ws + WS_X1); bf16_t* x1b = (bf16_t*)(ws + WS_X1B);
    const float* router = P.in[24] + (size_t)(l >> 1) * DM * NE;
    const f32x4* xr = (const f32x4*)(xin + (size_t)row * DM) + lane; const f32x4* yr = (const f32x4*)(y + (size_t)row * DM) + lane;
    f32x4 v[4]; float s = 0.f;
#pragma unroll
    for (int j = 0; j < 4; ++j) { v[j] = xr[64 * j] * ALPHA + yr[64 * j]; s += (v[j][0] + v[j][1]) + (v[j][2] + v[j][3]); }
    const float mean = wave_sum(s) * (1.f / DM); float s2 = 0.f;
#pragma unroll
    for (int j = 0; j < 4; ++j) { v[j] = v[j] - mean; s2 += (v[j][0] * v[j][0] + v[j][1] * v[j][1]) + (v[j][2] * v[j][2] + v[j][3] * v[j][3]); }
    const float rstd = rsqrtf(wave_sum(s2) * (1.f / DM) + LN_EPS);
    float lg[8];
#pragma unroll
    for (int e = 0; e < 8; ++e) lg[e] = 0.f;
#pragma unroll
    for (int j = 0; j < 4; ++j) { const f32x4 gg = ((const f32x4*)g)[lane + 64 * j], bb = ((const f32x4*)bvec)[lane + 64 * j];
        v[j] = v[j] * rstd * gg + bb;
        ((f32x4*)(x1 + (size_t)row * DM))[lane + 64 * j] = v[j];
        u32x2 o; o.x = pk2(v[j][0], v[j][1]); o.y = pk2(v[j][2], v[j][3]); ((u32x2*)(x1b + (size_t)row * DM))[lane + 64 * j] = o;
        if (moe) {
#pragma unroll
            for (int c = 0; c < 4; ++c) { const f32x4* rp = (const f32x4*)(router + (size_t)(4 * (lane + 64 * j) + c) * 8); const f32x4 r0 = rp[0], r1 = rp[1];
                lg[0] += v[j][c] * r0[0]; lg[1] += v[j][c] * r0[1]; lg[2] += v[j][c] * r0[2]; lg[3] += v[j][c] * r0[3];
                lg[4] += v[j][c] * r1[0]; lg[5] += v[j][c] * r1[1]; lg[6] += v[j][c] * r1[2]; lg[7] += v[j][c] * r1[3]; } }
    }
    if (moe) {
#pragma unroll
        for (int e = 0; e < 8; ++e) lg[e] = wave_sum(lg[e]);
        int e1 = 0; float v1 = lg[0];
#pragma unroll
        for (int e = 1; e < 8; ++e) if (lg[e] > v1) { v1 = lg[e]; e1 = e; }
        int e2 = -1; float v2 = -INFINITY;
#pragma unroll
        for (int e = 0; e < 8; ++e) if (e != e1 && lg[e] > v2) { v2 = lg[e]; e2 = e; }
        re1 = e1; re2 = e2; rw1 = 1.f / (1.f + __expf(v2 - v1));
    }
}
__device__ __forceinline__ void permute_row(const Params& P, int l, int c, int lane) {
    unsigned char* ws = P.ws; unsigned* ctl = (unsigned*)(ws + WS_CTL); const unsigned* cntw = ctl + CW_CNT + 512 * (l >> 1);
    const bf16_t* x1b = (const bf16_t*)(ws + WS_X1B); bf16_t* xperm = (bf16_t*)(ws + WS_Y); const int* rowtok_v = (const int*)(ws + WS_MISC + MISC_ROWTOKV); int* tile_e = (int*)(ws + WS_MISC + MISC_TILEE);
    int cnt[8], tb[9]; tb[0] = 0;
#pragma unroll
    for (int e = 0; e < 8; ++e) { cnt[e] = (int)cntw[64 * e]; tb[e + 1] = tb[e] + ((cnt[e] + 255) >> 8); }
    const int NT = tb[8];
    if (c == 0 && lane == 0) ctl[CW_NT] = (unsigned)NT;
    if (c >= NT * 256) return;
    const int tile = c >> 8; int e = 0, tbe = 0, cne = cnt[0];
#pragma unroll
    for (int i = 1; i < 8; ++i) if (tile >= tb[i]) { e = i; tbe = tb[i]; cne = cnt[i]; }
    if ((c & 255) == 0 && lane == 0) tile_e[tile] = e;
    const int pos = c - tbe * 256;
    u32x4 v0 = (u32x4){0u, 0u, 0u, 0u}, v1 = v0;
    if (pos < cne) { const int tok = rowtok_v[e * MTOK + pos]; const u32x4* s = (const u32x4*)(x1b + (size_t)tok * DM); v0 = s[lane]; v1 = s[lane + 64]; }
    u32x4* d = (u32x4*)(xperm + (size_t)c * DM); d[lane] = v0; d[lane + 64] = v1;
}
__device__ __forceinline__ void ln2_row(const Params& P, int l, int row, int lane) {
    unsigned char* ws = P.ws; const int moe = l & 1; const unsigned* cntw = (const unsigned*)(ws + WS_CTL) + CW_CNT + 512 * (l >> 1);
    const float* x1 = (const float*)(ws + WS_X1); const bf16_t* yp = (const bf16_t*)(ws + WS_Y); const float* g = P.in[19] + l * DM; const float* bvec = P.in[20] + l * DM;
    float* xout = P.out; bf16_t* xb = (bf16_t*)(ws + WS_XB);
    const int* tok_e = (const int*)(ws + WS_MISC + MISC_TOKE); const int* tok_p = (const int*)(ws + WS_MISC + MISC_TOKP); const float* tok_w = (const float*)(ws + WS_MISC + MISC_TOKW);
    int r1 = row, r2 = row; float w1 = 1.f, w2 = 0.f;
    if (moe) { int tb[9]; tb[0] = 0;
#pragma unroll
        for (int e = 0; e < 8; ++e) tb[e + 1] = tb[e] + (((int)cntw[64 * e] + 255) >> 8);
        const int e1 = tok_e[row * 2], e2 = tok_e[row * 2 + 1]; int b1 = 0, b2 = 0;
#pragma unroll
        for (int e = 0; e < 8; ++e) { if (e == e1) b1 = tb[e]; if (e == e2) b2 = tb[e]; }
        r1 = b1 * 256 + tok_p[row * 2]; r2 = b2 * 256 + tok_p[row * 2 + 1]; w1 = tok_w[row * 2]; w2 = tok_w[row * 2 + 1]; }
    const f32x4* xr = (const f32x4*)(x1 + (size_t)row * DM) + lane; const u32x2* y1 = (const u32x2*)(yp + (size_t)r1 * DM) + lane; const u32x2* y2 = (const u32x2*)(yp + (size_t)r2 * DM) + lane;
    f32x4 v[4]; float s = 0.f;
#pragma unroll
    for (int j = 0; j < 4; ++j) { const u32x2 a = y1[64 * j], c = y2[64 * j];
        f32x4 f; f[0] = w1 * __uint_as_float(a.x << 16) + w2 * __uint_as_float(c.x << 16); f[1] = w1 * __uint_as_float(a.x & 0xffff0000u) + w2 * __uint_as_float(c.x & 0xffff0000u);
        f[2] = w1 * __uint_as_float(a.y << 16) + w2 * __uint_as_float(c.y << 16); f[3] = w1 * __uint_as_float(a.y & 0xffff0000u) + w2 * __uint_as_float(c.y & 0xffff0000u);
        v[j] = xr[64 * j] * ALPHA + f; s += (v[j][0] + v[j][1]) + (v[j][2] + v[j][3]); }
    const float mean = wave_sum(s) * (1.f / DM); float s2 = 0.f;
#pragma unroll
    for (int j = 0; j < 4; ++j) { v[j] = v[j] - mean; s2 += (v[j][0] * v[j][0] + v[j][1] * v[j][1]) + (v[j][2] * v[j][2] + v[j][3] * v[j][3]); }
    const float rstd = rsqrtf(wave_sum(s2) * (1.f / DM) + LN_EPS);
#pragma unroll
    for (int j = 0; j < 4; ++j) { const f32x4 gg = ((const f32x4*)g)[lane + 64 * j], bb = ((const f32x4*)bvec)[lane + 64 * j];
        v[j] = v[j] * rstd * gg + bb;
        ((f32x4*)(xout + (size_t)row * DM))[lane + 64 * j] = v[j];
        u32x2 o; o.x = pk2(v[j][0], v[j][1]); o.y = pk2(v[j][2], v[j][3]); ((u32x2*)(xb + (size_t)row * DM))[lane + 64 * j] = o; }
}

template <class Epi> __device__ __forceinline__ void run_gemm(LAS unsigned char* lds, const bf16_t* A, const bf16_t* Bt, int nM, int nN, int K, size_t bstride, const int* tile_e, const unsigned* nt_word, const Epi& E) {
    LAS int* te = (LAS int*)(lds + LDS_TE);
    if (nt_word) nM = (int)__builtin_amdgcn_readfirstlane(__hip_atomic_load(nt_word, __ATOMIC_RELAXED, __HIP_MEMORY_SCOPE_AGENT));
    if (tile_e) { const int t_ = opaque((int)threadIdx.x); if (t_ < nM) te[t_] = __hip_atomic_load(tile_e + t_, __ATOMIC_RELAXED, __HIP_MEMORY_SCOPE_AGENT); }
    __syncthreads();
    pg8::Gemm g{A, Bt, nM, nN, K, bstride, tile_e ? (const LAS int*)te : (const LAS int*)nullptr};
    pg8::StaticOrder S; S.init(nM, nN, (int)gridDim.x, (int)blockIdx.x, g.tile_e);
    pg8::gemm_phase<Epi, true>(lds, g, S, E);
}

__global__ void __launch_bounds__(512, 2) mega_fwd(Params P) {
    extern __shared__ __attribute__((aligned(16))) unsigned char smem[];
    LAS unsigned char* lds = (LAS unsigned char*)smem;
    volatile LAS unsigned* MISC = (volatile LAS unsigned*)(lds + LDS_MISC);
    const int tid = threadIdx.x, lane = tid & 63, wave = __builtin_amdgcn_readfirstlane(tid >> 6);
    const int G = gridDim.x, blk = blockIdx.x;
    unsigned char* ws = P.ws; unsigned* ctl = (unsigned*)(ws + WS_CTL);
    if (tid < 32) MISC[tid] = 0u;
    __syncthreads();
    XcdBarrier bar = xcd_barrier_post(ctl + CW_BAR, MISC + 8);
    const int gw = blk * NWAVES + wave, NGW = G * NWAVES;

    phase_prep(P, lds);
#if PROBE == 2
    xcd_barrier(bar); phase_prep(P, lds);
#endif
    for (int r10_ = 0; r10_ < (PROBE == 10 ? 2 : 1); ++r10_) {
    for (int it = blk; it < DEPTH * S5G; it += G) s5prep_item(P, it, lds);
    for (int l2 = 0; l2 < DEPTH; ++l2) gluprep(P, l2, blk * 512 + tid, G * 512);
    }
    xcd_barrier(bar);

    bf16_t* xb = (bf16_t*)(ws + WS_XB); bf16_t* x1b = (bf16_t*)(ws + WS_X1B); bf16_t* ybf = (bf16_t*)(ws + WS_Y); float* yf = (float*)(ws + WS_Y);
    bf16_t* hbuf = (bf16_t*)(ws + WS_R1 + R1_H); float* aux = (float*)(ws + WS_R1 + R1_AUX); bf16_t* mix = (bf16_t*)(ws + WS_R1 + R1_MIX); bf16_t* Hbuf = (bf16_t*)(ws + WS_R1);
    const int* tile_e = (const int*)(ws + WS_MISC + MISC_TILEE);

    for (int l = 0; l < DEPTH; ++l) {
        const int moe = l & 1; const int slot0 = moe ? 2 + (l >> 1) * 8 : (l >> 1);
        { pg8::EpiBf16 E{hbuf, aux, INP, 11};
          for (int rp_ = 0; rp_ < (PROBE == 4 ? 2 : 1); ++rp_) { if (rp_) xcd_barrier(bar); run_gemm(lds, xb, (const bf16_t*)(ws + WS_WIN) + (size_t)l * INP * DM, MTOK / 256, INP / 256, DM, 0, nullptr, nullptr, E); } }
        xcd_barrier(bar);
#if PROBE == 1
        for (int rep_ = 0; rep_ < 2; ++rep_) {
#else
        { const int rep_ = 0;
#endif
        for (int r5_ = 0; r5_ < (PROBE == 5 ? 2 : 1); ++r5_) {
        if (blk < 128) { for (int r8_ = 0; r8_ < (PROBE == 8 ? 2 : 1); ++r8_) s5_unit(P, l, blk, lds); for (int r9_ = 0; r9_ < (PROBE == 9 ? 2 : 1); ++r9_) gdn_local_unit(P, l, blk, lds); }
        else if (blk < 256) { for (int r9_ = 0; r9_ < (PROBE == 9 ? 2 : 1); ++r9_) { gdn_local_unit(P, l, 128 + (blk - 128) * 2, lds); gdn_local_unit(P, l, 129 + (blk - 128) * 2, lds); } }
        for (int it = gw; it < BATCH * 8 * 6 * 4; it += NGW) kmean_item(P, it, opaque(lane));
        xcd_barrier(bar);
        }
        for (int r6_ = 0; r6_ < (PROBE == 6 ? 2 : 1); ++r6_) {
        if (blk < BATCH * NH) for (int r7_ = 0; r7_ < (PROBE == 7 ? 2 : 1); ++r7_) gdn_scan_unit(P, l, blk, lds);
        for (;;) {
            if (tid == 0) MISC[16] = atomicAdd(ctl + CW_Q + l + 4 * rep_ + 8 * r6_, 1u);
            __syncthreads();
            const int u = (int)MISC[16];
            __syncthreads();
            if (u >= 384 + 64) break;
            if (u < 384) moba_unit(P, u % 48, 7 - u / 48, lds); else glu_unit(P, l, u - 384);
        }
        xcd_barrier(bar);
        }
        }
        { pg8::EpiF32 E{yf, DM, 0};
          for (int rp_ = 0; rp_ < (PROBE == 4 ? 2 : 1); ++rp_) { if (rp_) xcd_barrier(bar); run_gemm(lds, mix, (const bf16_t*)(ws + WS_WOUT) + (size_t)l * DM * DM, MTOK / 256, DM / 256, DM, 0, nullptr, nullptr, E); } }
        xcd_barrier(bar);
        if (!moe) { for (int rp_ = 0; rp_ < (PROBE == 3 ? 2 : 1); ++rp_) for (int r = gw; r < MTOK; r += NGW) { int e1_, e2_; float w1_; ln1_row(P, l, r, opaque(lane), e1_, e2_, w1_); } }
        else {
            LAS int* lc = (LAS int*)lds; LAS int* rinfo = lc + 32;
            int* tok_e = (int*)(ws + WS_MISC + MISC_TOKE); int* tok_p = (int*)(ws + WS_MISC + MISC_TOKP); float* tok_w = (float*)(ws + WS_MISC + MISC_TOKW); int* rowtok_v = (int*)(ws + WS_MISC + MISC_ROWTOKV);
            unsigned* cntw = ctl + CW_CNT + 512 * (l >> 1);
            { const int t8 = opaque(tid); if (t8 < 8) lc[t8] = 0; }
            __syncthreads();
            for (int i = 0; i < 8; ++i) { const int rl = wave * 8 + i, row = blk * 64 + rl; int e1_, e2_; float w1_; ln1_row(P, l, row, opaque(lane), e1_, e2_, w1_);
                if (lane == 0) { const int r1 = __hip_atomic_fetch_add(lc + e1_, 1, __ATOMIC_RELAXED, __HIP_MEMORY_SCOPE_WORKGROUP), r2 = __hip_atomic_fetch_add(lc + e2_, 1, __ATOMIC_RELAXED, __HIP_MEMORY_SCOPE_WORKGROUP);
                    rinfo[rl * 4] = e1_; rinfo[rl * 4 + 1] = r1; rinfo[rl * 4 + 2] = e2_; rinfo[rl * 4 + 3] = r2;
                    tok_e[row * 2] = e1_; tok_e[row * 2 + 1] = e2_; tok_w[row * 2] = w1_; tok_w[row * 2 + 1] = 1.f - w1_; } }
            __syncthreads();
            { const int t8 = opaque(tid); if (t8 < 8) lc[16 + t8] = (int)atomicAdd(cntw + 64 * t8, (unsigned)lc[t8]); }
            __syncthreads();
            const int tq = opaque(tid);
            if (tq < 128) { const int rl = tq >> 1, sl = tq & 1, row = blk * 64 + rl; const int e = rinfo[rl * 4 + 2 * sl], p = lc[16 + e] + rinfo[rl * 4 + 2 * sl + 1];
                tok_p[row * 2 + sl] = p; rowtok_v[e * MTOK + p] = row; }
            __syncthreads();
        }
        xcd_barrier(bar);
        if (moe) { for (int r12_ = 0; r12_ < (PROBE == 12 ? 2 : 1); ++r12_) for (int c = gw; c < MAXT * 256; c += NGW) permute_row(P, l, c, opaque(lane)); xcd_barrier(bar); }
        { pg8::EpiSwiglu E{Hbuf, DFF, 0};
          for (int rp_ = 0; rp_ < (PROBE == 4 ? 2 : 1); ++rp_) { if (rp_) xcd_barrier(bar);
          run_gemm(lds, moe ? (const bf16_t*)ybf : (const bf16_t*)x1b, (const bf16_t*)(ws + WS_WGU) + (size_t)slot0 * 2 * DFF * DM, MTOK / 256, 2 * DFF / 256, DM, (size_t)2 * DFF * DM,
                   moe ? tile_e : nullptr, moe ? ctl + CW_NT : nullptr, E); } }
        xcd_barrier(bar);
        { pg8::EpiBf16 E{ybf, nullptr, DM, -1};
          for (int rp_ = 0; rp_ < (PROBE == 4 ? 2 : 1); ++rp_) { if (rp_) xcd_barrier(bar); run_gemm(lds, Hbuf, (const bf16_t*)(ws + WS_WD) + (size_t)slot0 * DM * DFF, MTOK / 256, DM / 256, DFF, (size_t)DM * DFF, moe ? tile_e : nullptr, moe ? ctl + CW_NT : nullptr, E); } }
        xcd_barrier(bar);
        for (int rp_ = 0; rp_ < (PROBE == 3 ? 2 : 1); ++rp_) for (int r = gw; r < MTOK; r += NGW) ln2_row(P, l, r, opaque(lane));
        if (l + 1 < DEPTH) xcd_barrier(bar);
    }
}

extern "C" void kernel_launch(void* const* d_in, const int* in_sizes, int n_in, void* d_out, int out_size, void* d_ws, size_t ws_size, hipStream_t stream) {
    static int grid = 0;
    if (grid == 0) {
        if (n_in != 28 || out_size != MTOK * DM || ws_size < WS_END) { fprintf(stderr, "kernel_launch: unexpected arguments (n_in %d out %d ws %zu)\n", n_in, out_size, ws_size); grid = -1; return; }
        int dev = 0, cus = 0;
        if (hipGetDevice(&dev) != hipSuccess || hipDeviceGetAttribute(&cus, hipDeviceAttributeMultiprocessorCount, dev) != hipSuccess) { grid = -1; return; }
        if (hipFuncSetAttribute((const void*)mega_fwd, hipFuncAttributeMaxDynamicSharedMemorySize, LDS_BYTES) != hipSuccess) { fprintf(stderr, "kernel_launch: hipFuncSetAttribute failed\n"); grid = -1; return; }
        int per_cu = 0;
        if (hipOccupancyMaxActiveBlocksPerMultiprocessor(&per_cu, (const void*)mega_fwd, NWAVES * 64, LDS_BYTES) != hipSuccess || per_cu < 1) { fprintf(stderr, "kernel_launch: occupancy query says %d\n", per_cu); }
        (void)hipGetLastError();
        grid = cus;
        if (grid < 256) { fprintf(stderr, "kernel_launch: needs 256 CUs\n"); grid = -1; return; }
        grid = 256;
    }
    if (grid < 0) return;
    (void)hipMemsetAsync((char*)d_ws + WS_CTL, 0, 1 * MiB, stream);
    Params p{};
    for (int i = 0; i < 28; ++i) p.in[i] = (const float*)d_in[i];
    p.out = (float*)d_out; p.ws = (unsigned char*)d_ws;
    hipLaunchKernelGGL(mega_fwd, dim3(grid), dim3(NWAVES * 64), LDS_BYTES, stream, p);
}
```

```cpp
#include <hip/hip_runtime.h>
#ifndef PROBE
#define PROBE 0
#endif
#include <cstdio>
#include <cstdint>

constexpr int BATCH = 8, SEQ = 2048, DM = 1024, DEPTH = 4, MTOK = BATCH * SEQ;
constexpr int INC = 2956, INP = 3072;
constexpr int C_S5 = 0, C_MQ = 256, C_MK = 640, C_MV = 1024, C_GQ = 1408, C_GK = 1792, C_GV = 2176, C_GZ = 2560, C_GA = 2944;
constexpr int DFF = 3584, NE = 8;
constexpr int S5G = 16, S5P = 16, S5N = 64;
constexpr int NH = 6, HD = 64;
constexpr float ALPHA = 1.681792830507429f;
constexpr float LN_EPS = 1e-5f, RMS_EPS = 1e-6f;
constexpr int MAXT = 136;

constexpr size_t MiB = 1u << 20;
constexpr size_t WS_CTL = 0;
constexpr size_t WS_WIN = 1 * MiB;
constexpr size_t WS_WOUT = 25 * MiB;
constexpr size_t WS_WGU = 33 * MiB;
constexpr size_t WS_WD = 285 * MiB;
constexpr size_t WS_XB = 411 * MiB;
constexpr size_t WS_X1 = 443 * MiB;
constexpr size_t WS_X1B = 507 * MiB;
constexpr size_t WS_Y = 539 * MiB;
constexpr size_t WS_R1 = 607 * MiB;
constexpr size_t R1_H = 0, R1_AUX = 96 * MiB, R1_MIX = 97 * MiB, R1_YS5 = 129 * MiB, R1_GSEQ = 137 * MiB  , R1_GPAR = 173 * MiB  , R1_GVS = 194 * MiB  , R1_KMEAN = 218 * MiB;
constexpr size_t WS_MISC = 845 * MiB;
constexpr size_t MISC_TOKE = 0, MISC_TOKP = 128 * 1024, MISC_TOKW = 256 * 1024, MISC_ROWTOKV = 384 * 1024  , MISC_TILEE = 896 * 1024;
constexpr size_t WS_END = 864 * MiB;
constexpr int CW_CNT = 1024;
constexpr int CW_NT = 128;
constexpr int CW_Q = 192;

typedef unsigned short bf16_t;
typedef short bf16x8 __attribute__((ext_vector_type(8)));
typedef float f32x4 __attribute__((ext_vector_type(4)));
typedef unsigned u32x4 __attribute__((ext_vector_type(4)));
typedef unsigned u32x2 __attribute__((ext_vector_type(2)));
#define LAS __attribute__((address_space(3)))

__device__ __forceinline__ float bf2f(bf16_t v) { return __uint_as_float(((unsigned)v) << 16); }
__device__ __forceinline__ unsigned f2bf(float f) { unsigned u = __float_as_uint(f); return (u + 0x7fffu + ((u >> 16) & 1u)) >> 16; }
__device__ __forceinline__ unsigned pk2(float lo, float hi) { return f2bf(lo) | (f2bf(hi) << 16); }
__device__ __forceinline__ int opaque(int v) { asm volatile("" : "+v"(v)); return v; }
__device__ __forceinline__ float row16_sum(float v) {
    v += __int_as_float(__builtin_amdgcn_update_dpp(0, __float_as_int(v), 0xB1, 0xF, 0xF, true));
    v += __int_as_float(__builtin_amdgcn_update_dpp(0, __float_as_int(v), 0x4E, 0xF, 0xF, true));
    v += __int_as_float(__builtin_amdgcn_update_dpp(0, __float_as_int(v), 0x141, 0xF, 0xF, true));
    v += __int_as_float(__builtin_amdgcn_update_dpp(0, __float_as_int(v), 0x140, 0xF, 0xF, true));
    return v;
}
__device__ __forceinline__ float wave_sum(float v) {
    v = row16_sum(v);
    const float r0 = __int_as_float(__builtin_amdgcn_readlane(__float_as_int(v), 0)), r1 = __int_as_float(__builtin_amdgcn_readlane(__float_as_int(v), 16));
    const float r2 = __int_as_float(__builtin_amdgcn_readlane(__float_as_int(v), 32)), r3 = __int_as_float(__builtin_amdgcn_readlane(__float_as_int(v), 48));
    return (r0 + r1) + (r2 + r3);
}
__device__ __forceinline__ float sigmoidf_(float x) { return 1.f / (1.f + __expf(-x)); }
__device__ __forceinline__ float siluf_(float x) { return x / (1.f + __expf(-x)); }

namespace pg8 {
constexpr int BM = 256, BK = 64, HALF = 128, HTB = HALF * BK * 2, STAGE_BYTES = 8 * HTB, NXCD = 8, WGM = 8;
__host__ __device__ __forceinline__ int lds_byte(int r, int c) { const int st = (r >> 4) * 2 + (c >> 5), rr = r & 15, cc = c & 31, ob = rr * 64 + cc * 2; return st * 1024 + (ob ^ (((ob >> 9) & 1) << 5)); }
__host__ __device__ __forceinline__ void stage_rc(int b, int& R, int& C) { const int st = b / 1024, sb = b % 1024, swz = sb ^ (((sb >> 9) & 1) << 5); R = (st >> 1) * 16 + swz / 64; C = (st & 1) * 32 + (swz % 64) / 2; }
__host__ __device__ __forceinline__ int perm32(int rho) { const int n = rho >> 4, i = rho & 15; return 8 * (i >> 2) + 4 * n + (i & 3); }

struct Unit { int pm, pn, e; };
struct Gemm { const bf16_t* A; const bf16_t* Bt; int nM, nN, K; size_t bstride; const LAS int* tile_e; };

struct StaticOrder {
    int nM, nN, nwg, G, c; const LAS int* te;
    __device__ void init(int nM_, int nN_, int G_, int c_, const LAS int* te_) { nM = nM_; nN = nN_; nwg = nM * nN; G = G_; c = c_; te = te_; }
    __device__ bool next(int i, Unit& u) const {
        const long L = (long)i * G + c; if (L >= nwg) return false;
        int wgid = (int)L; { const int q = nwg / NXCD, r = nwg % NXCD, xcd = wgid % NXCD, off = wgid / NXCD; wgid = (xcd < r ? xcd * (q + 1) : r * (q + 1) + (xcd - r) * q) + off; }
        const int nig = WGM * nN, gid = wgid / nig, fm = gid * WGM, gsz = (nM - fm) < WGM ? (nM - fm) : WGM;
        u.pm = fm + ((wgid % nig) % gsz); u.pn = (wgid % nig) / gsz; u.e = te ? te[u.pm] : 0; return true;
    }
};

typedef float f32x2_t __attribute__((ext_vector_type(2))); typedef __bf16 bf16x2_t __attribute__((ext_vector_type(2)));
__device__ __forceinline__ unsigned cvt_pk_bf16(float lo, float hi) { f32x2_t v = {lo, hi}; bf16x2_t r = __builtin_convertvector(v, bf16x2_t); return __builtin_bit_cast(unsigned, r); }

struct EpiF32 {
    static constexpr bool PERM = false;
    float* C; int ldc; int pad;
    __device__ __forceinline__ void operator()(const f32x4 (&acc)[2][2][4][2], const Unit& u, int wr, int wc, int fr, int fq) const {
        const int row0 = u.pm * BM + wr * 64 + fr, col0 = u.pn * BM + wc * 32 + 4 * fq;
#pragma unroll
        for (int ai = 0; ai < 2; ++ai)
#pragma unroll
            for (int m = 0; m < 4; ++m) { float* rowp = C + (size_t)(row0 + ai * HALF + m * 16) * ldc + col0;
#pragma unroll
                for (int bj = 0; bj < 2; ++bj)
#pragma unroll
                    for (int n = 0; n < 2; ++n) *(f32x4*)(rowp + bj * HALF + n * 16) = acc[ai][bj][m][n]; }
    }
};
struct EpiBf16 {
    static constexpr bool PERM = true;
    bf16_t* O; float* aux; int ldc; int aux_pn;
    __device__ __forceinline__ void operator()(const f32x4 (&acc)[2][2][4][2], const Unit& u, int wr, int wc, int fr, int fq) const {
        const int row0 = u.pm * BM + wr * 64 + fr; const int col0 = u.pn * BM + wc * 32 + 8 * fq;
#pragma unroll
        for (int ai = 0; ai < 2; ++ai)
#pragma unroll
            for (int m = 0; m < 4; ++m) { bf16_t* rowp = O + (size_t)(row0 + ai * HALF + m * 16) * ldc + col0;
#pragma unroll
                for (int bj = 0; bj < 2; ++bj) { const f32x4 v0 = acc[ai][bj][m][0], v1 = acc[ai][bj][m][1];
                    u32x4 w; w.x = cvt_pk_bf16(v0[0], v0[1]); w.y = cvt_pk_bf16(v0[2], v0[3]); w.z = cvt_pk_bf16(v1[0], v1[1]); w.w = cvt_pk_bf16(v1[2], v1[3]);
                    *(u32x4*)(rowp + bj * HALF) = w; } }
        if (aux && u.pn == aux_pn && wc == 0 && fq < 2) {
#pragma unroll
            for (int ai = 0; ai < 2; ++ai)
#pragma unroll
                for (int m = 0; m < 4; ++m) { float* ap = aux + (size_t)(row0 + ai * HALF + m * 16) * 16 + 8 * fq;
                    *(f32x4*)(ap) = acc[ai][1][m][0]; *(f32x4*)(ap + 4) = acc[ai][1][m][1]; }
        }
    }
};
struct EpiSwiglu {
    static constexpr bool PERM = true;
    bf16_t* O; int ldc; int pad;
    __device__ __forceinline__ void operator()(const f32x4 (&acc)[2][2][4][2], const Unit& u, int wr, int wc, int fr, int fq) const {
        const int row0 = u.pm * BM + wr * 64 + fr; const int col0 = u.pn * HALF + wc * 32 + 8 * fq;
#pragma unroll
        for (int ai = 0; ai < 2; ++ai)
#pragma unroll
            for (int m = 0; m < 4; ++m) { bf16_t* rowp = O + (size_t)(row0 + ai * HALF + m * 16) * ldc + col0;
                float r[8];
#pragma unroll
                for (int n = 0; n < 2; ++n)
#pragma unroll
                    for (int j = 0; j < 4; ++j) { const float g = acc[ai][0][m][n][j], up = acc[ai][1][m][n][j];
                        r[n * 4 + j] = g * __builtin_amdgcn_rcpf(1.f + __builtin_amdgcn_exp2f(-1.4426950408889634f * g)) * up; }
                u32x4 w; w.x = cvt_pk_bf16(r[0], r[1]); w.y = cvt_pk_bf16(r[2], r[3]); w.z = cvt_pk_bf16(r[4], r[5]); w.w = cvt_pk_bf16(r[6], r[7]);
                *(u32x4*)(rowp) = w; }
    }
};

template <class Epi, bool ALIGN_EPI = true>
__device__ __forceinline__ void gemm_phase(LAS unsigned char* lds, const Gemm g, const StaticOrder& S, const Epi& E) {
    const int tid = opaque((int)threadIdx.x), wid = __builtin_amdgcn_readfirstlane(tid >> 6), lane = tid & 63, wr = wid >> 2, wc = wid & 3, fr = lane & 15, fq = lane >> 4;
    const int K = g.K, nt = K / BK;
    unsigned voffA[2], voffB[2];
#pragma unroll
    for (int i = 0; i < 2; ++i) { int R, C; stage_rc(tid * 16 + i * 8192, R, C); const int Rb = Epi::PERM ? ((R & ~31) + perm32(R & 31)) : R;
        voffA[i] = (unsigned)(R * K + C) * 2u; voffB[i] = (unsigned)(Rb * K + C) * 2u; }
    const size_t kstep = (size_t)(BK * 2);
    const size_t hstep = (size_t)HALF * K * 2;
    const size_t tstep = 2 * hstep;
    const unsigned ldsw = (unsigned)wid * 1024u;
    const int aoff = lds_byte(wr * 64 + fr, fq * 8), boff = lds_byte(wc * 32 + fr, fq * 8);
#define PG8_SA(b, h) (((b) * 2 + (h)) * HTB)
#define PG8_SB(b, h) ((4 + (b) * 2 + (h)) * HTB)
#define PG8_STAGE(bufoff, gbase, voff) do { _Pragma("unroll") for (int _i = 0; _i < 2; ++_i) \
        __builtin_amdgcn_global_load_lds((const unsigned*)((const char*)(gbase) + (voff)[_i]), (LAS unsigned*)(lds + (bufoff) + ldsw + _i * 8192), 16, 0, 0); } while (0)
#define PG8_LDA(dst, b, h) do { _Pragma("unroll") for (int m = 0; m < 4; ++m) _Pragma("unroll") for (int k = 0; k < 2; ++k) dst[m][k] = *(const LAS bf16x8*)(lds + PG8_SA(b, h) + aoff + m * 2048 + k * 1024); } while (0)
#define PG8_LDB(dst, b, h) do { _Pragma("unroll") for (int n = 0; n < 2; ++n) _Pragma("unroll") for (int k = 0; k < 2; ++k) dst[n][k] = *(const LAS bf16x8*)(lds + PG8_SB(b, h) + boff + n * 2048 + k * 1024); } while (0)
#define PG8_MMA(ai, bj, At, Bt) do { __builtin_amdgcn_s_setprio(1); _Pragma("unroll") for (int m = 0; m < 4; ++m) _Pragma("unroll") for (int n = 0; n < 2; ++n) _Pragma("unroll") for (int k = 0; k < 2; ++k) \
        acc[ai][bj][m][n] = __builtin_amdgcn_mfma_f32_16x16x32_bf16(Bt[n][k], At[m][k], acc[ai][bj][m][n], 0, 0, 0); __builtin_amdgcn_s_setprio(0); } while (0)
#define PG8_WAIT_V(n) asm volatile("s_waitcnt vmcnt(" #n ")" ::: "memory")
#define PG8_WAIT_L(n) asm volatile("s_waitcnt lgkmcnt(" #n ")" ::: "memory")
#define PG8_BAR __builtin_amdgcn_s_barrier()
#define PG8_SCHED __builtin_amdgcn_sched_barrier(0)
    Unit cur, nxt; int ui = 0;
    if (!S.next(0, cur)) return;
    f32x4 acc[2][2][4][2];
#pragma unroll
    for (int a = 0; a < 2; ++a)
#pragma unroll
        for (int b = 0; b < 2; ++b)
#pragma unroll
            for (int m = 0; m < 4; ++m)
#pragma unroll
                for (int n = 0; n < 2; ++n) acc[a][b][m][n] = (f32x4){0.f, 0.f, 0.f, 0.f};
    bf16x8 At[4][2], B0[2][2], B1[2][2];
    const char* cA = (const char*)g.A + (size_t)cur.pm * tstep; const char* cB = (const char*)(g.Bt + (size_t)cur.e * g.bstride) + (size_t)cur.pn * tstep;
    PG8_STAGE(PG8_SB(0, 0), cB, voffB); PG8_STAGE(PG8_SB(0, 1), cB + hstep, voffB); PG8_STAGE(PG8_SA(0, 0), cA, voffA); PG8_STAGE(PG8_SA(0, 1), cA + hstep, voffA);
    if (wr == 1) PG8_BAR;
    PG8_WAIT_V(2); PG8_BAR;
    PG8_STAGE(PG8_SB(1, 0), cB + kstep, voffB); PG8_STAGE(PG8_SA(1, 0), cA + kstep, voffA); PG8_STAGE(PG8_SB(1, 1), cB + hstep + kstep, voffB);
    PG8_WAIT_V(6); PG8_BAR;
    for (;;) {
        const bool has_next = S.next(ui + 1, nxt);
        const char* nA = has_next ? (const char*)g.A + (size_t)nxt.pm * tstep : cA; const char* nB = has_next ? (const char*)(g.Bt + (size_t)nxt.e * g.bstride) + (size_t)nxt.pn * tstep : cB;
        for (int t = 0; t < nt; t += 2) {
            const bool last = (t == nt - 2);
            const char* a1 = cA + (size_t)(t + 1) * kstep;
            const char* a2 = last ? nA : cA + (size_t)(t + 2) * kstep; const char* b2 = last ? nB : cB + (size_t)(t + 2) * kstep;
            const char* a3 = a2 + kstep; const char* b3 = b2 + kstep;
            PG8_LDB(B0, 0, 0); PG8_LDB(B1, 0, 1); PG8_SCHED; PG8_LDA(At, 0, 0); PG8_STAGE(PG8_SA(1, 1), a1 + hstep, voffA);
            PG8_WAIT_V(8); PG8_WAIT_L(0); PG8_BAR; PG8_MMA(0, 0, At, B0); PG8_MMA(0, 1, At, B1); PG8_BAR; PG8_SCHED;
            PG8_LDA(At, 0, 1); PG8_STAGE(PG8_SB(0, 0), b2, voffB); PG8_STAGE(PG8_SB(0, 1), b2 + hstep, voffB); PG8_STAGE(PG8_SA(0, 0), a2, voffA);
            PG8_WAIT_V(8); PG8_WAIT_L(0); PG8_BAR; PG8_MMA(1, 0, At, B0); PG8_MMA(1, 1, At, B1); PG8_BAR; PG8_SCHED;
            PG8_LDB(B0, 1, 0); PG8_LDB(B1, 1, 1); PG8_SCHED; PG8_LDA(At, 1, 0); PG8_STAGE(PG8_SA(0, 1), a2 + hstep, voffA);
            PG8_WAIT_V(8); PG8_WAIT_L(0); PG8_BAR; PG8_MMA(0, 0, At, B0); PG8_MMA(0, 1, At, B1); PG8_BAR; PG8_SCHED;
            PG8_LDA(At, 1, 1); PG8_STAGE(PG8_SB(1, 0), b3, voffB); PG8_STAGE(PG8_SB(1, 1), b3 + hstep, voffB); PG8_STAGE(PG8_SA(1, 0), a3, voffA);
            PG8_WAIT_V(8); PG8_WAIT_L(0); PG8_BAR; PG8_MMA(1, 0, At, B0); PG8_MMA(1, 1, At, B1); PG8_BAR; PG8_SCHED;
        }
        if constexpr (ALIGN_EPI) { if (wr == 0) PG8_BAR; }
        E(acc, cur, wr, wc, fr, fq);
        if (!has_next) break;
#pragma unroll
        for (int a = 0; a < 2; ++a)
#pragma unroll
            for (int b = 0; b < 2; ++b)
#pragma unroll
                for (int m = 0; m < 4; ++m)
#pragma unroll
                    for (int n = 0; n < 2; ++n) acc[a][b][m][n] = (f32x4){0.f, 0.f, 0.f, 0.f};
        cur = nxt; cA = nA; cB = nB; ++ui;
        if constexpr (ALIGN_EPI) { if (wr == 1) PG8_BAR; }
    }
    PG8_WAIT_V(0);
    if constexpr (!ALIGN_EPI) { if (wr == 0) PG8_BAR; }
    PG8_BAR;
#undef PG8_SA
#undef PG8_SB
#undef PG8_STAGE
#undef PG8_LDA
#undef PG8_LDB
#undef PG8_MMA
#undef PG8_WAIT_V
#undef PG8_WAIT_L
#undef PG8_BAR
#undef PG8_SCHED
}
}

constexpr int RING_BYTES = 131072;
constexpr int LDS_TE = RING_BYTES;
constexpr int LDS_MISC = RING_BYTES + 1024;
constexpr int LDS_PTAB = RING_BYTES + 1024 + 256;
constexpr int LDS_BYTES = 147456;
constexpr int NWAVES = 8;

#define XB_TMO      128
#define XB_XCNT(j)  (256  + 64 * (j))
#define XB_XSUB(j)  (1280 + 64 * (j))
#define XB_XGEN(j)  (2304 + 64 * (j))
#define XB_TOP      3328
#define XB_TOPGEN   3392
#define XCD_BAR_WORDS 3456
#define XB_SPIN_CAP (1u << 18)
constexpr int CW_BAR = 4096;

__device__ __forceinline__ unsigned xb_ld(unsigned* p)              { return __hip_atomic_load(p, __ATOMIC_RELAXED, __HIP_MEMORY_SCOPE_AGENT); }
__device__ __forceinline__ unsigned xb_add(unsigned* p, unsigned v) { return __hip_atomic_fetch_add(p, v, __ATOMIC_RELAXED, __HIP_MEMORY_SCOPE_AGENT); }
__device__ __forceinline__ unsigned xb_xcc_id() { return (unsigned)__builtin_amdgcn_s_getreg((3 << 11) | 20) & 0xFu; }
#define XB_SPIN(cond, bar) do { unsigned _sp = 0; while (cond) { __builtin_amdgcn_s_sleep(1); \
    if ((++_sp & 255u) == 0u) { if (xb_ld(&(bar)[XB_TMO])) break; if (_sp > XB_SPIN_CAP) { atomicAdd(&(bar)[XB_TMO], 1u); break; } } } } while (0)
struct XcdBarrier { unsigned* bar; unsigned x; volatile LAS unsigned* st; };
__device__ __forceinline__ XcdBarrier xcd_barrier_post(unsigned* bar, volatile LAS unsigned* st) {
    XcdBarrier b; b.bar = bar; b.x = xb_xcc_id(); b.st = st;
    if (threadIdx.x == 0) (void)xb_add(&bar[XB_XCNT(b.x)], 1u);
    return b;
}
__device__ __forceinline__ void xcd_barrier_complete(unsigned* bar, unsigned x, unsigned& nloc, unsigned& nx) {
    const unsigned G = gridDim.x * gridDim.y * gridDim.z;
    unsigned sum, cnt, mine, sp = 0u;
    for (;;) {
        sum = 0u; cnt = 0u; mine = 0u;
#pragma unroll
        for (unsigned j = 0; j < 16; ++j) { const unsigned c = xb_ld(&bar[XB_XCNT(j)]); sum += c; cnt += (c > 0u) ? 1u : 0u; mine = (j == x) ? c : mine; }
        if (sum == G) break;
        __builtin_amdgcn_s_sleep(1);
        if ((++sp & 255u) == 0u) { if (xb_ld(&bar[XB_TMO])) break; if (sp > XB_SPIN_CAP) { atomicAdd(&bar[XB_TMO], 1u); break; } }
    }
    nloc = mine > 0u ? mine : 1u; nx = cnt > 0u ? cnt : 1u;
}
__device__ __forceinline__ void xcd_barrier1(const XcdBarrier& b) {
    asm volatile("s_waitcnt vmcnt(0)" ::: "memory");
    __syncthreads();
    if (threadIdx.x == 0) {
        unsigned* bar = b.bar;
        const unsigned bx = xb_xcc_id();
        __builtin_amdgcn_s_waitcnt(0);
        unsigned nloc = b.st[0], nx = b.st[1];
        if (nloc == 0u) { xcd_barrier_complete(bar, bx, nloc, nx); b.st[0] = nloc; b.st[1] = nx; }
        const unsigned old = xb_add(&bar[XB_XSUB(bx)], 1u);
        const unsigned gen = old / nloc;
        if (old + 1u == (gen + 1u) * nloc) {
            __builtin_amdgcn_fence(__ATOMIC_RELEASE, "agent");
            asm volatile("s_waitcnt vmcnt(0)" ::: "memory");
            const unsigned og = xb_add(&bar[XB_TOP], 1u);
            const unsigned tg = og / nx;
            if (og + 1u == (tg + 1u) * nx) xb_add(&bar[XB_TOPGEN], 1u);
            else XB_SPIN(xb_ld(&bar[XB_TOPGEN]) == tg, bar);
            __builtin_amdgcn_fence(__ATOMIC_ACQUIRE, "agent");
            xb_add(&bar[XB_XGEN(bx)], 1u);
            asm volatile("s_waitcnt vmcnt(0)" ::: "memory");
        } else {
            XB_SPIN(xb_ld(&bar[XB_XGEN(bx)]) == gen, bar);
            __builtin_amdgcn_fence(__ATOMIC_ACQUIRE, "agent");
            asm volatile("s_waitcnt vmcnt(0)" ::: "memory");
        }
    }
    __syncthreads();
}

__device__ __forceinline__ void xcd_barrier(const XcdBarrier& b) { xcd_barrier1(b); if (PROBE == 11) xcd_barrier1(b); }
struct KArgs { const float* in[28]; float* out; unsigned char* ws; };
struct Params { const LAS unsigned* tab; float* out; unsigned char* ws; };
__device__ __forceinline__ const float* pin(const Params& P, int i) { const unsigned lo = (unsigned)__builtin_amdgcn_readfirstlane((int)P.tab[2 * i]), hi = (unsigned)__builtin_amdgcn_readfirstlane((int)P.tab[2 * i + 1]);
    return (const float*)(((unsigned long long)hi << 32) | lo); }

struct TileDesc { const float* src; bf16_t* dst; int K, N, mode, kt, nt, pad; };
__device__ __forceinline__ TileDesc prep_desc(const Params& P, int it) {
    unsigned char* ws = P.ws; TileDesc d; d.pad = 0;
    constexpr int T_IN = 16 * 48, T_OUT = 16 * 16, T_GU = 16 * 56, T_D = 56 * 16;
    constexpr int N_IN = 4 * T_IN, N_OUT = 4 * T_OUT, N_G = 18 * T_GU, N_U = 18 * T_GU;
    int r = it;
    if (r < N_IN) { const int l = r / T_IN, q = r % T_IN; d.src = pin(P, 1) + (size_t)l * DM * INC; d.K = DM; d.N = INC; d.dst = (bf16_t*)(ws + WS_WIN) + (size_t)l * INP * DM; d.mode = 0; d.kt = q / 48; d.nt = q % 48; return d; } r -= N_IN;
    if (r < N_OUT) { const int l = r / T_OUT, q = r % T_OUT; d.src = pin(P, 2) + (size_t)l * DM * DM; d.K = DM; d.N = DM; d.dst = (bf16_t*)(ws + WS_WOUT) + (size_t)l * DM * DM; d.mode = 0; d.kt = q / 16; d.nt = q % 16; return d; } r -= N_OUT;
    if (r < N_G + N_U) { const int up = r >= N_G; if (up) r -= N_G; const int sl = r / T_GU, q = r % T_GU;
        d.src = sl < 2 ? (up ? pin(P, 22) : pin(P, 21)) + (size_t)sl * DM * DFF : (up ? pin(P, 26) : pin(P, 25)) + (size_t)(sl - 2) * DM * DFF;
        d.K = DM; d.N = DFF; d.dst = (bf16_t*)(ws + WS_WGU) + (size_t)sl * 2 * DFF * DM; d.mode = up ? 2 : 1; d.kt = q / 56; d.nt = q % 56; return d; } r -= N_G + N_U;
    { const int sl = r / T_D, q = r % T_D; d.src = sl < 2 ? pin(P, 23) + (size_t)sl * DFF * DM : pin(P, 27) + (size_t)(sl - 2) * DFF * DM;
      d.K = DFF; d.N = DM; d.dst = (bf16_t*)(ws + WS_WD) + (size_t)sl * DM * DFF; d.mode = 0; d.kt = q / 16; d.nt = q % 16; return d; }
}
__device__ __forceinline__ void phase_prep(const Params& P, LAS unsigned char* lds) {
    unsigned char* ws = P.ws; const int t = opaque((int)threadIdx.x);
    constexpr int TOTAL = 4 * 16 * 48 + 4 * 16 * 16 + 3 * 18 * 16 * 56;
    for (int base = blockIdx.x * 4; base < TOTAL; base += gridDim.x * 4) {
        TileDesc d[4]; f32x4 v[4][2];
#pragma unroll
        for (int q = 0; q < 4; ++q) { d[q] = prep_desc(P, base + q < TOTAL ? base + q : TOTAL - 1);
#pragma unroll
            for (int j = 0; j < 2; ++j) { const int r = (t >> 4) + 32 * j, c4 = (t & 15) * 4; const int n = d[q].nt * 64 + c4;
                v[q][j] = (f32x4){0.f, 0.f, 0.f, 0.f}; if (n < d[q].N) v[q][j] = *(const f32x4*)(d[q].src + (size_t)(d[q].kt * 64 + r) * d[q].N + n); } }
#pragma unroll
        for (int q = 0; q < 4; ++q) { LAS float* scr = (LAS float*)(lds + q * 16640);
#pragma unroll
            for (int j = 0; j < 2; ++j) { const int r = (t >> 4) + 32 * j, c4 = (t & 15) * 4;
                scr[r * 65 + c4 + 0] = v[q][j][0]; scr[r * 65 + c4 + 1] = v[q][j][1]; scr[r * 65 + c4 + 2] = v[q][j][2]; scr[r * 65 + c4 + 3] = v[q][j][3]; } }
        __syncthreads();
#pragma unroll
        for (int q = 0; q < 4; ++q) { if (base + q < TOTAL) { const LAS float* scr = (const LAS float*)(lds + q * 16640);
            const int nl = t >> 3, kc = (t & 7) * 8; const int n = d[q].nt * 64 + nl;
            int drow; if (d[q].mode == 0) drow = n; else if (d[q].mode == 1) drow = 256 * (n >> 7) + (n & 127); else drow = 256 * (n >> 7) + 128 + (n & 127);
            u32x4 o; o.x = pk2(scr[(kc + 0) * 65 + nl], scr[(kc + 1) * 65 + nl]); o.y = pk2(scr[(kc + 2) * 65 + nl], scr[(kc + 3) * 65 + nl]);
            o.z = pk2(scr[(kc + 4) * 65 + nl], scr[(kc + 5) * 65 + nl]); o.w = pk2(scr[(kc + 6) * 65 + nl], scr[(kc + 7) * 65 + nl]);
            *(u32x4*)(d[q].dst + (size_t)drow * d[q].K + d[q].kt * 64 + kc) = o; } }
        __syncthreads();
    }
    const float* x = pin(P, 0); bf16_t* xb = (bf16_t*)(ws + WS_XB);
    for (size_t i = ((size_t)blockIdx.x * 512 + threadIdx.x) * 4; i < (size_t)MTOK * DM; i += (size_t)gridDim.x * 512 * 4) {
        const f32x4 v = *(const f32x4*)(x + i); u32x2 o; o.x = pk2(v[0], v[1]); o.y = pk2(v[2], v[3]); *(u32x2*)(xb + i) = o; }
}

__device__ __forceinline__ float gelu_tanh(float x) { const float u = 0.7978845608028654f * (x + 0.044715f * x * x * x); return 0.5f * x * (1.f + tanhf(u)); }

__device__ __forceinline__ void kmean_item(const Params& P, int item, int lane) {
    const bf16_t* h = (const bf16_t*)(P.ws + WS_R1 + R1_H); float* kmean = (float*)(P.ws + WS_R1 + R1_KMEAN);
    const int part = item & 3, it2 = item >> 2; const int bb = it2 / 6, c = (it2 % 6) * 64 + lane;
    const bf16_t* p = h + ((size_t)bb * 256 + part * 64) * INP + C_MK + c;
    float s0 = 0.f, s1 = 0.f, s2 = 0.f, s3 = 0.f;
#pragma unroll
    for (int r = 0; r < 64; r += 4) { s0 += bf2f(p[(size_t)r * INP]); s1 += bf2f(p[(size_t)(r + 1) * INP]); s2 += bf2f(p[(size_t)(r + 2) * INP]); s3 += bf2f(p[(size_t)(r + 3) * INP]); }
    kmean[(bb * 4 + part) * 384 + c] = ((s0 + s1) + (s2 + s3)) * (1.f / 256.f);
}


constexpr size_t WS_S5W1 = 847 * MiB, WS_S5W23 = 851 * MiB, WS_S5LAM = 863 * MiB;
__device__ __forceinline__ void s5prep_item(const Params& P, int item4, LAS unsigned char* lds) {
    const int tid = opaque((int)threadIdx.x); const int item = item4 >> 2, sub = item4 & 3; const int l = item >> 4, g = item & 15;
    LAS float* lamp = (LAS float*)lds;
    LAS float* bbar = lamp + 17 * 64 * 2;
    LAS float* Cc = bbar + 64 * 16 * 2;
    LAS float* Km = Cc + 16 * 64 * 2;
    const float* lam_re = pin(P, 3) + l * S5G * S5N; const float* lam_im = pin(P, 4) + l * S5G * S5N; const float* log_dt = pin(P, 5) + l * S5G;
    const float* b_re = pin(P, 6) + (size_t)l * S5G * S5N * S5P; const float* b_im = pin(P, 7) + (size_t)l * S5G * S5N * S5P;
    const float* c_re = pin(P, 8) + (size_t)l * S5G * S5P * S5N; const float* c_im = pin(P, 9) + (size_t)l * S5G * S5P * S5N; const float* dskp = pin(P, 10) + l * S5G * S5P + g * S5P;
    if (tid < 64) { const int n = tid;
        const float lre = lam_re[g * S5N + n], lim = lam_im[g * S5N + n], dt = expf(log_dt[g]); const float a = lre * dt, bb = lim * dt;
        for (int k = 0; k <= 16; ++k) { float sn, cs; sincosf((float)k * bb, &sn, &cs); const float er = expf((float)k * a); lamp[(k * 64 + n) * 2] = er * cs; lamp[(k * 64 + n) * 2 + 1] = er * sn; }
        float sn, cs; sincosf(bb, &sn, &cs); const float sh = sinf(0.5f * bb); const float nr = expm1f(a) * cs - 2.f * sh * sh, ni = expf(a) * sn;
        const float den = lre * lre + lim * lim; const float fr = (nr * lre + ni * lim) / den, fi = (ni * lre - nr * lim) / den;
        for (int p = 0; p < S5P; ++p) { const float bre = b_re[(g * S5N + n) * S5P + p], bim = b_im[(g * S5N + n) * S5P + p]; bbar[(n * 16 + p) * 2] = fr * bre - fi * bim; bbar[(n * 16 + p) * 2 + 1] = fr * bim + fi * bre; }
    }
    for (int e = tid; e < 1024; e += 512) { const int p = e >> 6, n = e & 63; Cc[e * 2] = c_re[(g * S5P + p) * S5N + n]; Cc[e * 2 + 1] = c_im[(g * S5P + p) * S5N + n]; }
    __syncthreads();
    if (tid < 64 && sub == 0) { float* lam16 = (float*)(P.ws + WS_S5LAM) + (size_t)item * 128; lam16[tid * 2] = lamp[(16 * 64 + tid) * 2]; lam16[tid * 2 + 1] = lamp[(16 * 64 + tid) * 2 + 1]; }
    for (int e = tid; e < 4096; e += 512) { const int d = e >> 8, pp = (e >> 4) & 15, q = e & 15; float s = 0.f;
        for (int n = 0; n < 64; ++n) { const float cr = Cc[(pp * 64 + n) * 2], ci = Cc[(pp * 64 + n) * 2 + 1], lr = lamp[(d * 64 + n) * 2], li = lamp[(d * 64 + n) * 2 + 1];
            const float zr = cr * lr - ci * li, zi = cr * li + ci * lr; s += zr * bbar[(n * 16 + q) * 2] - zi * bbar[(n * 16 + q) * 2 + 1]; }
        Km[e] = s; }
    __syncthreads();
    bf16_t* W1 = (bf16_t*)(P.ws + WS_S5W1 + (size_t)item * 65536);
    for (int e = tid; e < 256 * 32; e += 512) { const int k = e >> 5, col = 32 * sub + (e & 31); const int t = k >> 4, p = k & 15, n = col >> 1, ri = col & 1;
        const float lr = lamp[((15 - t) * 64 + n) * 2], li = lamp[((15 - t) * 64 + n) * 2 + 1], br = bbar[(n * 16 + p) * 2], bi = bbar[(n * 16 + p) * 2 + 1];
        const float val = ri ? (lr * bi + li * br) : (lr * br - li * bi);
        W1[(((k >> 5) * 8 + (col >> 4)) * 64 + (col & 15) + 16 * ((k & 31) >> 3)) * 8 + (k & 7)] = (bf16_t)f2bf(val); }
    bf16_t* W23 = (bf16_t*)(P.ws + WS_S5W23 + (size_t)item * 196608);
    for (int e = tid; e < 384 * 64; e += 512) { const int k = e >> 6, col = 64 * sub + (e & 63); const int tp = col >> 4, pp = col & 15; float val;
        if (k < 256) { const int tau = k >> 4, q = k & 15; val = tp >= tau ? Km[((tp - tau) * 16 + pp) * 16 + q] : 0.f; if (tau == tp && q == pp) val += dskp[pp]; }
        else { const int comp = k - 256, n = comp >> 1, ri = comp & 1; const float cr = Cc[(pp * 64 + n) * 2], ci = Cc[(pp * 64 + n) * 2 + 1], lr = lamp[((tp + 1) * 64 + n) * 2], li = lamp[((tp + 1) * 64 + n) * 2 + 1];
            val = ri ? -(cr * li + ci * lr) : (cr * lr - ci * li); }
        W23[(((k >> 5) * 16 + (col >> 4)) * 64 + (col & 15) + 16 * ((k & 31) >> 3)) * 8 + (k & 7)] = (bf16_t)f2bf(val); }
    __syncthreads();
}
__device__ __forceinline__ float gelu_tanh_fast(float x) { const float u2 = 1.5957691216057308f * (x + 0.044715f * x * x * x); return x / (1.f + __expf(-u2)); }
__device__ __forceinline__ void s5_unit(const Params& P, int l, int unit, LAS unsigned char* lds) {
    const int tid = opaque((int)threadIdx.x), lane = tid & 63, wave = __builtin_amdgcn_readfirstlane(tid >> 6), q = lane >> 4, n_i = lane & 15;
    const int b = unit >> 4, g = unit & 15, item = l * 16 + g;
    const bf16_t* h = (const bf16_t*)(P.ws + WS_R1 + R1_H); bf16_t* ys5 = (bf16_t*)(P.ws + WS_R1 + R1_YS5);
    const bf16x8* W1f = (const bf16x8*)(P.ws + WS_S5W1 + (size_t)item * 65536); const bf16x8* W23f = (const bf16x8*)(P.ws + WS_S5W23 + (size_t)item * 196608);
    LAS unsigned char* RA = lds; LAS unsigned char* RB = lds + 65536; LAS unsigned char* RS = lds + 98304;
#pragma unroll
    for (int ks = 0; ks < 8; ++ks) { const int tok = (16 * wave + n_i) * 16 + 2 * ks + (q >> 1);
        __builtin_amdgcn_global_load_lds((const unsigned*)(h + ((size_t)(b * SEQ + tok) * INP + C_S5 + g * 16 + 8 * (q & 1))), (LAS unsigned*)(RA + (wave * 8 + ks) * 1024), 16, 0, 0); }
    asm volatile("s_waitcnt vmcnt(0)" ::: "memory"); __syncthreads();
    f32x4 acc[8];
#pragma unroll
    for (int m = 0; m < 8; ++m) acc[m] = (f32x4){0.f, 0.f, 0.f, 0.f};
#pragma unroll
    for (int ks = 0; ks < 8; ++ks) { const bf16x8 bfr = W1f[(ks * 8 + wave) * 64 + lane];
#pragma unroll
        for (int m = 0; m < 8; ++m) acc[m] = __builtin_amdgcn_mfma_f32_16x16x32_bf16(*(const LAS bf16x8*)(RA + ((m * 8 + ks) * 64 + lane) * 16), bfr, acc[m], 0, 0, 0); }
    float sr = 0.f, si = 0.f;
    const float* lam16 = (const float*)(P.ws + WS_S5LAM) + (size_t)item * 128;
    const float Lr = lam16[2 * lane], Li = lam16[2 * lane + 1];
#pragma unroll
    for (int h2 = 0; h2 < 2; ++h2) {
#pragma unroll
        for (int mm = 0; mm < 4; ++mm)
#pragma unroll
            for (int r = 0; r < 4; ++r) *(LAS float*)(RB + ((16 * mm + 4 * q + r) * 128 + 16 * wave + n_i) * 4) = acc[4 * h2 + mm][r];
        __syncthreads();
        if (wave == 0) {
            for (int rl = 0; rl < 64; ++rl) { const int c = 64 * h2 + rl; const float lr_ = *(const LAS float*)(RB + (rl * 128 + 2 * lane) * 4), li_ = *(const LAS float*)(RB + (rl * 128 + 2 * lane + 1) * 4);
                *(LAS unsigned*)(RS + ((c >> 4) * 4 + (lane >> 4)) * 1024 + ((c & 15) + 16 * ((lane & 15) >> 2)) * 16 + (lane & 3) * 4) = pg8::cvt_pk_bf16(sr, si);
                const float nsr = Lr * sr - Li * si + lr_, nsi = Lr * si + Li * sr + li_; sr = nsr; si = nsi; }
        }
        __syncthreads();
    }
    f32x4 a2[8][2];
#pragma unroll
    for (int m = 0; m < 8; ++m) { a2[m][0] = (f32x4){0.f, 0.f, 0.f, 0.f}; a2[m][1] = a2[m][0]; }
    for (int ks = 0; ks <= wave; ++ks) { const bf16x8 b0 = W23f[(ks * 16 + 2 * wave) * 64 + lane], b1 = W23f[(ks * 16 + 2 * wave + 1) * 64 + lane];
#pragma unroll
        for (int m = 0; m < 8; ++m) { const bf16x8 a = *(const LAS bf16x8*)(RA + ((m * 8 + ks) * 64 + lane) * 16);
            a2[m][0] = __builtin_amdgcn_mfma_f32_16x16x32_bf16(a, b0, a2[m][0], 0, 0, 0); a2[m][1] = __builtin_amdgcn_mfma_f32_16x16x32_bf16(a, b1, a2[m][1], 0, 0, 0); } }
#pragma unroll
    for (int ks = 0; ks < 4; ++ks) { const bf16x8 b0 = W23f[((8 + ks) * 16 + 2 * wave) * 64 + lane], b1 = W23f[((8 + ks) * 16 + 2 * wave + 1) * 64 + lane];
#pragma unroll
        for (int m = 0; m < 8; ++m) { const bf16x8 a = *(const LAS bf16x8*)(RS + ((m * 4 + ks) * 64 + lane) * 16);
            a2[m][0] = __builtin_amdgcn_mfma_f32_16x16x32_bf16(a, b0, a2[m][0], 0, 0, 0); a2[m][1] = __builtin_amdgcn_mfma_f32_16x16x32_bf16(a, b1, a2[m][1], 0, 0, 0); } }
#pragma unroll
    for (int m = 0; m < 8; ++m)
#pragma unroll
        for (int j = 0; j < 2; ++j)
#pragma unroll
            for (int r = 0; r < 4; ++r) { const int chunk = 16 * m + 4 * q + r; ys5[((size_t)(b * SEQ + chunk * 16 + 2 * wave + j)) * 256 + g * 16 + n_i] = (bf16_t)f2bf(gelu_tanh_fast(a2[m][j][r])); }
    __syncthreads();
}

constexpr int SREC = 24576, SR_WNEG = 0, SR_KDT = 8192, SR_U = 16384;
constexpr int PREC = 14336, PR_QG = 0, PR_ATTN = 8192;
constexpr int VREC = 16384;
constexpr int GC_K = 0, GC_V = 9216, GC_L = 18432, GC_G = 26880, GC_B = 27136, GC_BYTES = 27392;
constexpr size_t R1_EGL = R1_KMEAN + 524288;
__host__ __device__ constexpr int tri_off(int i) { return i == 0 ? 0 : 4 * ((((i - 1) >> 2) + 1) * (2 * ((i - 1) >> 2) + ((i - 1) & 3))); }
__device__ __forceinline__ int attn6_byte(int row, int k) { const int t = row >> 4, s5 = k >> 5, f6 = t < 2 ? t : 2 + (t - 2) * 2 + s5, kp = k & 31, q4 = (kp & 15) >> 2, j = (kp >> 4) * 4 + (kp & 3); return f6 * 1024 + ((row & 15) + 16 * q4) * 16 + j * 2; }
__device__ __forceinline__ int afrag_byte(int row, int k) { const int f = (row >> 4) * 2 + (k >> 5), kp = k & 31, q4 = (kp & 15) >> 2, j = (kp >> 4) * 4 + (kp & 3); return f * 1024 + ((row & 15) + 16 * q4) * 16 + j * 2; }
__device__ __forceinline__ bf16x8 pack8(const float* v) { u32x4 w; w.x = pg8::cvt_pk_bf16(v[0], v[1]); w.y = pg8::cvt_pk_bf16(v[2], v[3]); w.z = pg8::cvt_pk_bf16(v[4], v[5]); w.w = pg8::cvt_pk_bf16(v[6], v[7]); return __builtin_bit_cast(bf16x8, w); }
__device__ __forceinline__ bf16x8 pack44(const f32x4& a, const f32x4& b) { u32x4 w; w.x = pg8::cvt_pk_bf16(a[0], a[1]); w.y = pg8::cvt_pk_bf16(a[2], a[3]); w.z = pg8::cvt_pk_bf16(b[0], b[1]); w.w = pg8::cvt_pk_bf16(b[2], b[3]); return __builtin_bit_cast(bf16x8, w); }

template <int X> __device__ __forceinline__ void gdn_conv(const bf16_t* h, const float* conv_w, int b, int hh, int c, int w2, int i16, int q4, float (&dst)[2][2][8]) {
#pragma unroll
    for (int ks = 0; ks < 2; ++ks) {
        const int ch0 = X * 384 + hh * 64 + 32 * ks + 8 * q4;
        float wj[4][8];
#pragma unroll
        for (int j = 0; j < 4; ++j) { const f32x4 a = *(const f32x4*)(conv_w + j * 1152 + ch0), bq = *(const f32x4*)(conv_w + j * 1152 + ch0 + 4);
            wj[j][0] = a[0]; wj[j][1] = a[1]; wj[j][2] = a[2]; wj[j][3] = a[3]; wj[j][4] = bq[0]; wj[j][5] = bq[1]; wj[j][6] = bq[2]; wj[j][7] = bq[3]; }
#pragma unroll
        for (int m = 0; m < 2; ++m) {
            const int tseq = c * 64 + 32 * w2 + 16 * m + i16;
            float acc[8];
#pragma unroll
            for (int jj = 0; jj < 8; ++jj) acc[jj] = 0.f;
#pragma unroll
            for (int j = 0; j < 4; ++j) { const int tt = tseq - 3 + j; const float msk = tt >= 0 ? 1.f : 0.f; const int ttc = tt >= 0 ? tt : 0;
                const u32x4 raw = *(const u32x4*)(h + ((size_t)b * SEQ + ttc) * INP + C_GQ + ch0);
#pragma unroll
                for (int jj = 0; jj < 4; ++jj) { acc[2 * jj] += msk * wj[j][2 * jj] * __uint_as_float(raw[jj] << 16); acc[2 * jj + 1] += msk * wj[j][2 * jj + 1] * __uint_as_float(raw[jj] & 0xffff0000u); } }
#pragma unroll
            for (int jj = 0; jj < 8; ++jj) dst[m][ks][jj] = siluf_(acc[jj]);
        }
    }
}

__device__ __forceinline__ void gdn_local_unit(const Params& P, int l, int unit, LAS unsigned char* lds) {
    const int tid = opaque((int)threadIdx.x), lane = tid & 63, wave = __builtin_amdgcn_readfirstlane(tid >> 6), pr = wave >> 1, w2 = wave & 1;
    const int i16 = lane & 15, q4 = lane >> 4;
    const int bh = unit >> 3, c = (unit & 7) * 4 + pr; const int b = bh / NH, hh = bh % NH;
    const bf16_t* h = (const bf16_t*)(P.ws + WS_R1 + R1_H); const float* aux = (const float*)(P.ws + WS_R1 + R1_AUX); const float* conv_w = pin(P, 13) + (size_t)l * 4 * 1152;
    unsigned char* srec = P.ws + WS_R1 + R1_GSEQ + (size_t)(bh * 32 + c) * SREC; unsigned char* prec = P.ws + WS_R1 + R1_GPAR + (size_t)(bh * 32 + c) * PREC; float* egl = (float*)(P.ws + WS_R1 + R1_EGL);
    LAS unsigned char* Lc = lds + pr * GC_BYTES;
    LAS float* gcL = (LAS float*)(Lc + GC_G); LAS float* btL = (LAS float*)(Lc + GC_B); LAS float* Ltri = (LAS float*)(Lc + GC_L);
    const size_t tok0 = (size_t)b * SEQ + c * 64;
    float gc;
    { const float a = aux[(tok0 + lane) * 16 + hh] + pin(P, 15)[l * NH + hh]; const float sp = a > 20.f ? a : log1pf(expf(a)); gc = -expf(pin(P, 14)[l * NH + hh]) * sp;
      const float beta = sigmoidf_(aux[(tok0 + lane) * 16 + 6 + hh]);
      gc += __int_as_float(__builtin_amdgcn_update_dpp(0, __float_as_int(gc), 0x111, 0xF, 0xF, true));
      gc += __int_as_float(__builtin_amdgcn_update_dpp(0, __float_as_int(gc), 0x112, 0xF, 0xF, true));
      gc += __int_as_float(__builtin_amdgcn_update_dpp(0, __float_as_int(gc), 0x114, 0xF, 0xF, true));
      gc += __int_as_float(__builtin_amdgcn_update_dpp(0, __float_as_int(gc), 0x118, 0xF, 0xF, true));
      { const float t0 = __int_as_float(__builtin_amdgcn_readlane(__float_as_int(gc), 15)), t1 = __int_as_float(__builtin_amdgcn_readlane(__float_as_int(gc), 31)), t2 = __int_as_float(__builtin_amdgcn_readlane(__float_as_int(gc), 47));
        gc += q4 == 0 ? 0.f : (q4 == 1 ? t0 : (q4 == 2 ? t0 + t1 : (t0 + t1) + t2)); }
      if (w2 == 0) { gcL[lane] = gc; btL[lane] = beta; } }
    const float gl = __int_as_float(__builtin_amdgcn_readlane(__float_as_int(gc), 63));
    if (w2 == 0 && lane == 0) egl[bh * 32 + c] = expf(gl);
    bf16x8 qf[2][2], kf[2][2];
    {   float qv[2][2][8];
        gdn_conv<0>(h, conv_w, b, hh, c, w2, i16, q4, qv);
#pragma unroll
        for (int m = 0; m < 2; ++m) {
            const int tl = 32 * w2 + 16 * m + i16;
            float sq = 0.f;
#pragma unroll
            for (int ks = 0; ks < 2; ++ks)
#pragma unroll
                for (int jj = 0; jj < 8; ++jj) sq += qv[m][ks][jj] * qv[m][ks][jj];
            sq += __shfl_xor(sq, 16); sq += __shfl_xor(sq, 32);
            const float rq = rsqrtf(sq + RMS_EPS) * 0.125f; const float eg = expf(__shfl(gc, tl));
#pragma unroll
            for (int ks = 0; ks < 2; ++ks) {
                float qn[8], qg[8];
#pragma unroll
                for (int jj = 0; jj < 8; ++jj) { qn[jj] = qv[m][ks][jj] * rq; qg[jj] = qn[jj] * eg; }
                qf[m][ks] = pack8(qn);
                const int f = (2 * w2 + m) * 2 + ks;
                const int offA = f * 1024 + (i16 + 16 * ((2 * q4) & 3)) * 16 + (q4 >> 1) * 8, offB = f * 1024 + (i16 + 16 * ((2 * q4 + 1) & 3)) * 16 + (q4 >> 1) * 8;
                u32x2 wa; wa.x = pg8::cvt_pk_bf16(qg[0], qg[1]); wa.y = pg8::cvt_pk_bf16(qg[2], qg[3]); *(u32x2*)(prec + PR_QG + offA) = wa;
                u32x2 wb; wb.x = pg8::cvt_pk_bf16(qg[4], qg[5]); wb.y = pg8::cvt_pk_bf16(qg[6], qg[7]); *(u32x2*)(prec + PR_QG + offB) = wb;
            }
        }
    }
    asm volatile("" ::: "memory");
    {   float kv[2][2][8];
        gdn_conv<1>(h, conv_w, b, hh, c, w2, i16, q4, kv);
#pragma unroll
        for (int m = 0; m < 2; ++m) {
            const int tl = 32 * w2 + 16 * m + i16;
            float sk = 0.f;
#pragma unroll
            for (int ks = 0; ks < 2; ++ks)
#pragma unroll
                for (int jj = 0; jj < 8; ++jj) sk += kv[m][ks][jj] * kv[m][ks][jj];
            sk += __shfl_xor(sk, 16); sk += __shfl_xor(sk, 32);
            const float rk = rsqrtf(sk + RMS_EPS); const float ekd = expf(gl - __shfl(gc, tl));
#pragma unroll
            for (int ks = 0; ks < 2; ++ks) {
                float kn[8];
#pragma unroll
                for (int jj = 0; jj < 8; ++jj) kn[jj] = kv[m][ks][jj] * rk;
                kf[m][ks] = pack8(kn);
                *(LAS bf16x8*)(Lc + GC_K + tl * 144 + (32 * ks + 8 * q4) * 2) = kf[m][ks];
#pragma unroll
                for (int jj = 0; jj < 8; ++jj) *(bf16_t*)(srec + SR_KDT + afrag_byte(32 * ks + 8 * q4 + jj, tl)) = (bf16_t)f2bf(kn[jj] * ekd);
            }
        }
    }
    asm volatile("" ::: "memory");
    {   float vv[2][2][8];
        gdn_conv<2>(h, conv_w, b, hh, c, w2, i16, q4, vv);
#pragma unroll
        for (int m = 0; m < 2; ++m) { const int tl = 32 * w2 + 16 * m + i16;
#pragma unroll
            for (int ks = 0; ks < 2; ++ks) *(LAS bf16x8*)(Lc + GC_V + tl * 144 + (32 * ks + 8 * q4) * 2) = pack8(vv[m][ks]); }
    }
    __syncthreads();
#pragma unroll
    for (int mm = 0; mm < 2; ++mm) {
        const int mt = 2 * w2 + mm;
#pragma unroll
        for (int nt = 0; nt < 4; ++nt) {
            if (nt <= mt) {
                const bf16x8 bk0 = *(const LAS bf16x8*)(Lc + GC_K + (16 * nt + i16) * 144 + (8 * q4) * 2), bk1 = *(const LAS bf16x8*)(Lc + GC_K + (16 * nt + i16) * 144 + (32 + 8 * q4) * 2);
                f32x4 kk = __builtin_amdgcn_mfma_f32_16x16x32_bf16(kf[mm][0], bk0, (f32x4){0.f, 0.f, 0.f, 0.f}, 0, 0, 0); kk = __builtin_amdgcn_mfma_f32_16x16x32_bf16(kf[mm][1], bk1, kk, 0, 0, 0);
                f32x4 qk = __builtin_amdgcn_mfma_f32_16x16x32_bf16(qf[mm][0], bk0, (f32x4){0.f, 0.f, 0.f, 0.f}, 0, 0, 0); qk = __builtin_amdgcn_mfma_f32_16x16x32_bf16(qf[mm][1], bk1, qk, 0, 0, 0);
                const int s = 16 * nt + i16; const float gs = gcL[s];
#pragma unroll
                for (int rr = 0; rr < 4; ++rr) { const int r = 16 * mt + 4 * q4 + rr; const float dec = __expf(fminf(gcL[r] - gs, 0.f));
                    if (s < r) { const int n1 = r - 1, a1 = n1 >> 2, b1 = n1 & 3; Ltri[4 * ((a1 + 1) * (2 * a1 + b1)) + s] = btL[r] * kk[rr] * dec; }
                    *(bf16_t*)(prec + PR_ATTN + attn6_byte(r, s)) = (bf16_t)f2bf(s <= r ? qk[rr] * dec : 0.f); }
            } else if (nt == mt + 1 && (mt & 1) == 0) {
#pragma unroll
                for (int rr = 0; rr < 4; ++rr) *(bf16_t*)(prec + PR_ATTN + attn6_byte(16 * mt + 4 * q4 + rr, 16 * nt + i16)) = (bf16_t)0;
            }
        }
    }
    __syncthreads();
    {
        const LAS bf16_t* src = (const LAS bf16_t*)(Lc + (w2 ? GC_K : GC_V));
        float x[64];
#pragma unroll
        for (int i = 0; i < 64; ++i) {
            const float sc = btL[i] * __expf(w2 ? gcL[i] : 0.f);
            float acc = sc * bf2f(src[i * 72 + lane]);
#pragma unroll
            for (int j4 = 0; j4 < i; j4 += 4) { const f32x4 Lr = *(const LAS f32x4*)(Ltri + tri_off(i) + j4);
#pragma unroll
                for (int jj = 0; jj < 4; ++jj) if (j4 + jj < i) acc -= Lr[jj] * x[j4 + jj]; }
            asm volatile("" : "+v"(acc) :: "memory");
            x[i] = acc;
        }
        if (w2 == 0) {
            const int w = lane >> 4, n = lane & 15;
#pragma unroll
            for (int a = 0; a < 16; ++a) { u32x2 uw; uw.x = pg8::cvt_pk_bf16(x[4 * a], x[4 * a + 1]); uw.y = pg8::cvt_pk_bf16(x[4 * a + 2], x[4 * a + 3]); *(u32x2*)(srec + SR_U + ((w * 4 + (a >> 2)) * 64 + n + 16 * (a & 3)) * 8) = uw; }
        } else {
#pragma unroll
            for (int cc = 0; cc < 64; ++cc) *(bf16_t*)(srec + SR_WNEG + afrag_byte(cc, lane)) = (bf16_t)f2bf(-x[cc]);
        }
    }
    __syncthreads();
}

__device__ __forceinline__ void gdn_seq_unit(const Params& P, int bh, LAS unsigned char* lds) {
    const int tid = opaque((int)threadIdx.x), lane = tid & 63, wave = __builtin_amdgcn_readfirstlane(tid >> 6);
    const unsigned char* rec0 = P.ws + WS_R1 + R1_GSEQ + (size_t)bh * 32 * SREC; const float* egl = (const float*)(P.ws + WS_R1 + R1_EGL) + bh * 32;
    unsigned char* vs0 = P.ws + WS_R1 + R1_GVS + (size_t)bh * 32 * VREC + (size_t)(wave & 3) * 4096;
    const __amdgpu_buffer_rsrc_t vrs = __builtin_amdgcn_make_buffer_rsrc((void*)vs0, 0, 32 * VREC, 0x00020000);
#define GSQ_ISSUE(cc) do { _Pragma("unroll") for (int k_ = 0; k_ < 3; ++k_) { const int piece = wave * 3 + k_; \
        __builtin_amdgcn_global_load_lds((const unsigned*)(rec0 + (size_t)(cc) * SREC + piece * 1024 + lane * 16), (LAS unsigned*)(lds + ((cc) & 3) * SREC + piece * 1024), 16, 0, 0); } } while (0)
#define GSQ_AF(base, t, s) (*(const LAS bf16x8*)(buf + (base) + (((t) * 2 + (s)) * 64 + lane) * 16))
    const float eglv = egl[lane & 31];
    asm volatile("s_waitcnt vmcnt(0)" ::: "memory");
    GSQ_ISSUE(0); GSQ_ISSUE(1); GSQ_ISSUE(2);
    f32x4 St[4]; bf16x8 Sb[2];
#pragma unroll
    for (int t = 0; t < 4; ++t) St[t] = (f32x4){0.f, 0.f, 0.f, 0.f};
    Sb[0] = (bf16x8){0, 0, 0, 0, 0, 0, 0, 0}; Sb[1] = Sb[0];
    for (int c = 0; c < 32; ++c) {
        if (wave < 4) { if (c == 0) asm volatile("s_waitcnt vmcnt(6)" ::: "memory"); else if (c == 1) asm volatile("s_waitcnt vmcnt(10)" ::: "memory"); else if (c < 30) asm volatile("s_waitcnt vmcnt(14)" ::: "memory");
                        else if (c == 30) asm volatile("s_waitcnt vmcnt(11)" ::: "memory"); else asm volatile("s_waitcnt vmcnt(8)" ::: "memory"); }
        else { if (c < 30) asm volatile("s_waitcnt vmcnt(6)" ::: "memory"); else if (c == 30) asm volatile("s_waitcnt vmcnt(3)" ::: "memory"); else asm volatile("s_waitcnt vmcnt(0)" ::: "memory"); }
        __builtin_amdgcn_s_barrier(); asm volatile("" ::: "memory");
        const LAS unsigned char* buf = lds + (c & 3) * SREC;
        if (wave < 4) {
            const float eg = __int_as_float(__builtin_amdgcn_readlane(__float_as_int(eglv), c));
            f32x4 vn[4]; bf16x8 fw[4][2], fk[4][2];
#pragma unroll
            for (int t = 0; t < 4; ++t) { const u32x2 uw = *(const LAS u32x2*)(buf + SR_U + ((wave * 4 + t) * 64 + lane) * 8);
                vn[t] = (f32x4){__uint_as_float(uw.x << 16), __uint_as_float(uw.x & 0xffff0000u), __uint_as_float(uw.y << 16), __uint_as_float(uw.y & 0xffff0000u)};
#pragma unroll
                for (int s2 = 0; s2 < 2; ++s2) { fw[t][s2] = GSQ_AF(SR_WNEG, t, s2); fk[t][s2] = GSQ_AF(SR_KDT, t, s2); } }
            __builtin_amdgcn_raw_buffer_store_b128(__builtin_bit_cast(u32x4, Sb[0]), vrs, lane * 16, c * VREC, 0);
            __builtin_amdgcn_raw_buffer_store_b128(__builtin_bit_cast(u32x4, Sb[1]), vrs, lane * 16, c * VREC + 1024, 0);
#pragma unroll
            for (int t = 0; t < 4; ++t)
#pragma unroll
                for (int s2 = 0; s2 < 2; ++s2) vn[t] = __builtin_amdgcn_mfma_f32_16x16x32_bf16(fw[t][s2], Sb[s2], vn[t], 0, 0, 0);
            bf16x8 Vb[2]; Vb[0] = pack44(vn[0], vn[1]); Vb[1] = pack44(vn[2], vn[3]);
            __builtin_amdgcn_raw_buffer_store_b128(__builtin_bit_cast(u32x4, Vb[0]), vrs, lane * 16, c * VREC + 2048, 0);
            __builtin_amdgcn_raw_buffer_store_b128(__builtin_bit_cast(u32x4, Vb[1]), vrs, lane * 16, c * VREC + 3072, 0);
#pragma unroll
            for (int t = 0; t < 4; ++t) { St[t] = St[t] * eg;
#pragma unroll
                for (int s2 = 0; s2 < 2; ++s2) St[t] = __builtin_amdgcn_mfma_f32_16x16x32_bf16(fk[t][s2], Vb[s2], St[t], 0, 0, 0); }
            Sb[0] = pack44(St[0], St[1]); Sb[1] = pack44(St[2], St[3]);
        }
        asm volatile("s_waitcnt lgkmcnt(0)" ::: "memory");
        if (c + 3 < 32) GSQ_ISSUE(c + 3);
    }
    asm volatile("s_waitcnt vmcnt(0)" ::: "memory");
    __syncthreads();
#undef GSQ_ISSUE
#undef GSQ_AF
}
__device__ __forceinline__ void gdn_out_unit(const Params& P, int l, int unit, int par, LAS unsigned char* lds) {
    const int tid = opaque((int)threadIdx.x), lane = tid & 63, wave = __builtin_amdgcn_readfirstlane(tid >> 6), q = lane >> 4, n = lane & 15, w = wave & 3;
    const int cid = unit * 2 + (wave >> 2); const int bh = cid >> 5, c = cid & 31; const int b = bh / NH, hh = bh % NH; const int e = 16 * w + n;
    const bf16x8* pr = (const bf16x8*)(P.ws + WS_R1 + R1_GPAR + (size_t)cid * PREC); const bf16x8* vs = (const bf16x8*)(P.ws + WS_R1 + R1_GVS + (size_t)cid * VREC + (size_t)w * 4096);
    const bf16_t* h = (const bf16_t*)(P.ws + WS_R1 + R1_H); bf16_t* mix = (bf16_t*)(P.ws + WS_R1 + R1_MIX);
    LAS float* xs = (LAS float*)(lds + par * 2048);
    const bf16x8 Sb0 = vs[lane], Sb1 = vs[64 + lane], Vb0 = vs[128 + lane], Vb1 = vs[192 + lane];
    bf16x8 fq[4][2], fa[6];
#pragma unroll
    for (int t = 0; t < 4; ++t) { fq[t][0] = pr[(t * 2) * 64 + lane]; fq[t][1] = pr[(t * 2 + 1) * 64 + lane]; }
#pragma unroll
    for (int f = 0; f < 6; ++f) fa[f] = pr[512 + f * 64 + lane];
    unsigned short zr[16];
#pragma unroll
    for (int t = 0; t < 4; ++t)
#pragma unroll
        for (int r = 0; r < 4; ++r) zr[t * 4 + r] = h[((size_t)b * SEQ + c * 64 + 16 * t + 4 * q + r) * INP + C_GZ + hh * 64 + e];
    const float nw = pin(P, 16)[l * HD + e];
    f32x4 o[4];
#pragma unroll
    for (int t = 0; t < 4; ++t) { o[t] = __builtin_amdgcn_mfma_f32_16x16x32_bf16(fq[t][0], Sb0, (f32x4){0.f, 0.f, 0.f, 0.f}, 0, 0, 0); o[t] = __builtin_amdgcn_mfma_f32_16x16x32_bf16(fq[t][1], Sb1, o[t], 0, 0, 0); }
    o[0] = __builtin_amdgcn_mfma_f32_16x16x32_bf16(fa[0], Vb0, o[0], 0, 0, 0); o[1] = __builtin_amdgcn_mfma_f32_16x16x32_bf16(fa[1], Vb0, o[1], 0, 0, 0);
    o[2] = __builtin_amdgcn_mfma_f32_16x16x32_bf16(fa[2], Vb0, o[2], 0, 0, 0); o[2] = __builtin_amdgcn_mfma_f32_16x16x32_bf16(fa[3], Vb1, o[2], 0, 0, 0);
    o[3] = __builtin_amdgcn_mfma_f32_16x16x32_bf16(fa[4], Vb0, o[3], 0, 0, 0); o[3] = __builtin_amdgcn_mfma_f32_16x16x32_bf16(fa[5], Vb1, o[3], 0, 0, 0);
#pragma unroll
    for (int t = 0; t < 4; ++t)
#pragma unroll
        for (int r = 0; r < 4; ++r) { const float v = row16_sum(o[t][r] * o[t][r]); if (n == 0) xs[wave * 64 + 16 * t + 4 * q + r] = v; }
    __syncthreads();
#pragma unroll
    for (int t = 0; t < 4; ++t)
#pragma unroll
        for (int r = 0; r < 4; ++r) { const int pos = 16 * t + 4 * q + r; const LAS float* xp = xs + (wave & 4) * 64 + pos;
            const float tot = (xp[0] + xp[64]) + (xp[128] + xp[192]); const float rstd = rsqrtf(tot * (1.f / 64.f) + RMS_EPS);
            mix[((size_t)b * SEQ + c * 64 + pos) * DM + 640 + hh * 64 + e] = (bf16_t)f2bf(o[t][r] * rstd * nw * siluf_(bf2f(zr[t * 4 + r]))); }
}

constexpr int MB_KV = 9216;
constexpr int MB_K0 = 0, MB_V0 = 2 * MB_KV, MB_MSK = 4 * MB_KV, MB_WG = MB_MSK + 1024, MB_KM = MB_WG + 64, MB_BYTES = MB_KM + 2048;
constexpr float MB_C = 0.125f * 1.4426950408889634f;
constexpr float MB_NEG = -1e30f;
__device__ __forceinline__ void moba_unit(const Params& P, int bh, int qb, LAS unsigned char* lds) {
    const int tid = opaque((int)threadIdx.x), lane = tid & 63, wave = __builtin_amdgcn_readfirstlane(tid >> 6), q4 = lane >> 4, n_i = lane & 15;
    const int b = bh / NH, hh = bh % NH;
    const bf16_t* h = (const bf16_t*)(P.ws + WS_R1 + R1_H); const float* kmean = (const float*)(P.ws + WS_R1 + R1_KMEAN); bf16_t* mix = (bf16_t*)(P.ws + WS_R1 + R1_MIX);
    const size_t row0 = (size_t)b * SEQ;
    const int q0 = qb * 256 + 32 * wave;
    LAS unsigned* mskL = (LAS unsigned*)(lds + MB_MSK); LAS unsigned* wgL = (LAS unsigned*)(lds + MB_WG);
    { LAS float* kmL = (LAS float*)(lds + MB_KM); const int j = tid >> 6, d = tid & 63; const float* km = kmean + (size_t)(b * 8 + j) * 4 * 384 + hh * HD + d;
      kmL[tid] = (km[0] + km[384]) + (km[768] + km[1152]); }
    __syncthreads();
    {   const int qi = lane & 31, half = lane >> 5;
        const bf16_t* qp = h + (row0 + q0 + qi) * INP + C_MQ + hh * HD; const LAS float* kmL = (const LAS float*)(lds + MB_KM) + 4 * half * 64;
        float gt[4] = {0.f, 0.f, 0.f, 0.f};
        u32x4 qw[8];
#pragma unroll
        for (int c8 = 0; c8 < 8; ++c8) qw[c8] = *(const u32x4*)(qp + c8 * 8);
#pragma unroll
        for (int c8 = 0; c8 < 8; ++c8) { float qv[8];
#pragma unroll
            for (int jj = 0; jj < 4; ++jj) { qv[2 * jj] = __uint_as_float(qw[c8][jj] << 16); qv[2 * jj + 1] = __uint_as_float(qw[c8][jj] & 0xffff0000u); }
#pragma unroll
            for (int jb = 0; jb < 4; ++jb) { const f32x4 k0 = *(const LAS f32x4*)(kmL + jb * 64 + c8 * 8), k1 = *(const LAS f32x4*)(kmL + jb * 64 + c8 * 8 + 4);
                gt[jb] += (qv[0] * k0[0] + qv[1] * k0[1]) + (qv[2] * k0[2] + qv[3] * k0[3]) + (qv[4] * k1[0] + qv[5] * k1[1]) + (qv[6] * k1[2] + qv[7] * k1[3]); }
            asm volatile("" : "+v"(gt[0]), "+v"(gt[1]), "+v"(gt[2]), "+v"(gt[3]) :: "memory"); }
#pragma unroll
        for (int jb = 0; jb < 4; ++jb) gt[jb] = (4 * half + jb < qb) ? gt[jb] * 0.125f : -INFINITY;
        float gate[8];
#pragma unroll
        for (int jb = 0; jb < 4; ++jb) { const float o = __shfl_xor(gt[jb], 32); gate[jb] = half ? o : gt[jb]; gate[4 + jb] = half ? gt[jb] : o; }
        unsigned sel = 0;
#pragma unroll
        for (int j = 0; j < 8; ++j) { int rank = 0;
#pragma unroll
            for (int i = 0; i < 8; ++i) rank += (gate[i] > gate[j] || (gate[i] == gate[j] && i < j)) ? 1 : 0;
            if (j < qb && rank < 3) sel |= 1u << j; }
        if (lane < 32) mskL[wave * 32 + lane] = sel;
        unsigned wsel = sel;
#pragma unroll
        for (int o = 1; o < 32; o <<= 1) wsel |= __shfl_xor(wsel, o);
        if (lane == 0) wgL[wave] = wsel;
    }
    bf16x8 Qf[2][2];
#pragma unroll
    for (int qt = 0; qt < 2; ++qt)
#pragma unroll
        for (int ks = 0; ks < 2; ++ks) { const u32x4 w = *(const u32x4*)(h + (row0 + q0 + 16 * qt + n_i) * INP + C_MQ + hh * HD + 32 * ks + 8 * q4); float qf8[8];
#pragma unroll
            for (int jj = 0; jj < 4; ++jj) { qf8[2 * jj] = __uint_as_float(w[jj] << 16) * MB_C; qf8[2 * jj + 1] = __uint_as_float(w[jj] & 0xffff0000u) * MB_C; }
            Qf[qt][ks] = pack8(qf8); }
    __syncthreads();
    unsigned wgmask = 0;
#pragma unroll
    for (int w = 0; w < 8; ++w) wgmask |= wgL[w];
    wgmask = (unsigned)__builtin_amdgcn_readfirstlane((int)wgmask);
    const unsigned msk0 = mskL[wave * 32 + n_i], msk1 = mskL[wave * 32 + 16 + n_i];
    const unsigned wvmask = (unsigned)__builtin_amdgcn_readfirstlane((int)wgL[wave]);
    const int nblk = 1 + __builtin_popcount(wgmask);
    const int ntile = 4 * nblk;
    const int skey = tid >> 3, sch = tid & 7;
    auto tile_block = [&](int t) -> int { const int bi = t >> 2; if (bi == 0) return qb; unsigned m = wgmask; int j = 0;
        for (int k = 1; k < bi; ++k) m &= m - 1u; j = __builtin_ctz(m); return j; };
    u32x4 kreg, vreg;
    { const int jb = qb; const size_t kr = (row0 + jb * 256 + skey) * INP + hh * HD + sch * 8; kreg = *(const u32x4*)(h + kr + C_MK); vreg = *(const u32x4*)(h + kr + C_MV); }
    *(LAS u32x4*)(lds + MB_K0 + skey * 144 + sch * 16) = kreg; *(LAS u32x4*)(lds + MB_V0 + skey * 144 + sch * 16) = vreg;
    u32x4 kreg2 = kreg, vreg2 = vreg;
    if (1 < ntile) { const int jn = tile_block(1); const size_t kr = (row0 + jn * 256 + 64 + skey) * INP + hh * HD + sch * 8; kreg = *(const u32x4*)(h + kr + C_MK); vreg = *(const u32x4*)(h + kr + C_MV); }
    __syncthreads();
    f32x4 ot[4][2];
#pragma unroll
    for (int dt = 0; dt < 4; ++dt) { ot[dt][0] = (f32x4){0.f, 0.f, 0.f, 0.f}; ot[dt][1] = ot[dt][0]; }
    float mref[2] = {0.f, 0.f}, lrow[2] = {0.f, 0.f};
    constexpr float MB_THR = 8.f;
    for (int t = 0; t < ntile; ++t) {
        const int cur = t & 1; const int jb = tile_block(t); const int tt = t & 3;
        { const int t2 = t + 2 < ntile ? t + 2 : t; const int jn = tile_block(t2); const size_t kr = (row0 + jn * 256 + (t2 & 3) * 64 + skey) * INP + hh * HD + sch * 8; kreg2 = *(const u32x4*)(h + kr + C_MK); vreg2 = *(const u32x4*)(h + kr + C_MV); }
        const bool own = (t < 4);
        const bool active = own ? (64 * tt <= 32 * wave + 31) : (((wvmask >> jb) & 1u) != 0u);
        if (active) {
            const LAS unsigned char* kL = lds + MB_K0 + cur * MB_KV; const LAS unsigned char* vL = lds + MB_V0 + cur * MB_KV;
            f32x4 st[4][2];
            float ini[2]; ini[0] = (own || ((msk0 >> jb) & 1u)) ? -mref[0] : MB_NEG; ini[1] = (own || ((msk1 >> jb) & 1u)) ? -mref[1] : MB_NEG;
#pragma unroll
            for (int kt = 0; kt < 4; ++kt) { const bf16x8 k0 = *(const LAS bf16x8*)(kL + (16 * kt + n_i) * 144 + (8 * q4) * 2), k1 = *(const LAS bf16x8*)(kL + (16 * kt + n_i) * 144 + (32 + 8 * q4) * 2);
#pragma unroll
                for (int qt = 0; qt < 2; ++qt) { f32x4 a = __builtin_amdgcn_mfma_f32_16x16x32_bf16(k0, Qf[qt][0], (f32x4){ini[qt], ini[qt], ini[qt], ini[qt]}, 0, 0, 0); st[kt][qt] = __builtin_amdgcn_mfma_f32_16x16x32_bf16(k1, Qf[qt][1], a, 0, 0, 0); } }
            if (own && 64 * tt + 63 > 32 * wave) {
#pragma unroll
                for (int kt = 0; kt < 4; ++kt)
#pragma unroll
                    for (int qt = 0; qt < 2; ++qt)
#pragma unroll
                        for (int r = 0; r < 4; ++r) { const int key = 64 * tt + 16 * kt + 4 * q4 + r, qq = 32 * wave + 16 * qt + n_i; if (key > qq) st[kt][qt][r] = MB_NEG; }
            }
            float lm[2];
#pragma unroll
            for (int qt = 0; qt < 2; ++qt) { float a = fmaxf(fmaxf(st[0][qt][0], st[0][qt][1]), fmaxf(st[0][qt][2], st[0][qt][3]));
#pragma unroll
                for (int kt = 1; kt < 4; ++kt) a = fmaxf(a, fmaxf(fmaxf(st[kt][qt][0], st[kt][qt][1]), fmaxf(st[kt][qt][2], st[kt][qt][3])));
                lm[qt] = a; }
            if (t == 0 || __any(fmaxf(lm[0], lm[1]) > MB_THR)) {
#pragma unroll
                for (int qt = 0; qt < 2; ++qt) { float mx = lm[qt]; mx = fmaxf(mx, __shfl_xor(mx, 16)); mx = fmaxf(mx, __shfl_xor(mx, 32));
                    const float dl = (t == 0) ? mx : fmaxf(mx, 0.f);
                    const float f = (t == 0) ? 1.f : __builtin_amdgcn_exp2f(-dl); mref[qt] += dl; lrow[qt] *= f;
#pragma unroll
                    for (int dt = 0; dt < 4; ++dt) ot[dt][qt] = ot[dt][qt] * f;
#pragma unroll
                    for (int kt = 0; kt < 4; ++kt)
#pragma unroll
                        for (int r = 0; r < 4; ++r) st[kt][qt][r] -= dl; }
            }
            bf16x8 Pb[2][2];
#pragma unroll
            for (int qt = 0; qt < 2; ++qt) { float ps = 0.f;
#pragma unroll
                for (int kt = 0; kt < 4; ++kt)
#pragma unroll
                    for (int r = 0; r < 4; ++r) { const float p = __builtin_amdgcn_exp2f(st[kt][qt][r]); st[kt][qt][r] = p; ps += p; }
                lrow[qt] += ps;
                Pb[qt][0] = pack44(st[0][qt], st[1][qt]); Pb[qt][1] = pack44(st[2][qt], st[3][qt]); }
            const int qq = (lane & 15) >> 2, pp = lane & 3;
#pragma unroll
            for (int dt = 0; dt < 4; ++dt)
#pragma unroll
                for (int s2 = 0; s2 < 2; ++s2) {
                    typedef short v4s __attribute__((ext_vector_type(4)));
                    const v4s lo = __builtin_bit_cast(v4s, __builtin_amdgcn_ds_read_tr16_b64_v4i16((LAS v4s*)(vL + (32 * s2 + 4 * q4 + qq) * 144 + (16 * dt + 4 * pp) * 2)));
                    const v4s hi = __builtin_bit_cast(v4s, __builtin_amdgcn_ds_read_tr16_b64_v4i16((LAS v4s*)(vL + (32 * s2 + 16 + 4 * q4 + qq) * 144 + (16 * dt + 4 * pp) * 2)));
                    const bf16x8 vf = (bf16x8){lo[0], lo[1], lo[2], lo[3], hi[0], hi[1], hi[2], hi[3]};
                    ot[dt][0] = __builtin_amdgcn_mfma_f32_16x16x32_bf16(vf, Pb[0][s2], ot[dt][0], 0, 0, 0);
                    ot[dt][1] = __builtin_amdgcn_mfma_f32_16x16x32_bf16(vf, Pb[1][s2], ot[dt][1], 0, 0, 0);
                }
        }
        if (t + 1 < ntile) { *(LAS u32x4*)(lds + MB_K0 + (cur ^ 1) * MB_KV + skey * 144 + sch * 16) = kreg; *(LAS u32x4*)(lds + MB_V0 + (cur ^ 1) * MB_KV + skey * 144 + sch * 16) = vreg; }
        kreg = kreg2; vreg = vreg2;
        __syncthreads();
    }
#pragma unroll
    for (int qt = 0; qt < 2; ++qt) { float lt = lrow[qt]; lt += __shfl_xor(lt, 16); lt += __shfl_xor(lt, 32); const float inv = 1.f / lt;
#pragma unroll
        for (int dt = 0; dt < 4; ++dt) { u32x2 w; w.x = pg8::cvt_pk_bf16(ot[dt][qt][0] * inv, ot[dt][qt][1] * inv); w.y = pg8::cvt_pk_bf16(ot[dt][qt][2] * inv, ot[dt][qt][3] * inv);
            *(u32x2*)(mix + (row0 + q0 + 16 * qt + n_i) * DM + 256 + hh * HD + 16 * dt + 4 * q4) = w; } }
    __syncthreads();
}

constexpr size_t WS_GLUW = 863 * MiB + 65536;
__device__ __forceinline__ void gluprep(const Params& P, int l, int tid0, int nthr) {
    bf16_t* GW = (bf16_t*)(P.ws + WS_GLUW + (size_t)l * 131072); const float* W = pin(P, 11) + (size_t)l * 65536;
    for (int e = tid0; e < 65536; e += nthr) { const int k = e >> 8, col = e & 255; GW[(((k >> 5) * 16 + (col >> 4)) * 64 + (col & 15) + 16 * ((k & 31) >> 3)) * 8 + (k & 7)] = (bf16_t)f2bf(W[e]); }
}
__device__ __forceinline__ void glu_unit(const Params& P, int l, int unit) {
    const int tid = opaque((int)threadIdx.x), lane = tid & 63, wave = __builtin_amdgcn_readfirstlane(tid >> 6), q4 = lane >> 4, n_i = lane & 15;
    const bf16_t* ys = (const bf16_t*)(P.ws + WS_R1 + R1_YS5); bf16_t* mix = (bf16_t*)(P.ws + WS_R1 + R1_MIX);
    const bf16x8* GW = (const bf16x8*)(P.ws + WS_GLUW + (size_t)l * 131072); const float* bias = pin(P, 12) + l * 256;
    const int tok0 = unit * 256 + 32 * wave;
    bf16x8 af[2][8];
#pragma unroll
    for (int mt = 0; mt < 2; ++mt)
#pragma unroll
        for (int ks = 0; ks < 8; ++ks) af[mt][ks] = *(const bf16x8*)(ys + (size_t)(tok0 + 16 * mt + n_i) * 256 + 32 * ks + 8 * q4);
#pragma unroll 2
    for (int nt = 0; nt < 16; ++nt) {
        f32x4 a0 = (f32x4){0.f, 0.f, 0.f, 0.f}, a1 = a0;
#pragma unroll
        for (int ks = 0; ks < 8; ++ks) { const bf16x8 bfr = GW[(ks * 16 + nt) * 64 + lane]; a0 = __builtin_amdgcn_mfma_f32_16x16x32_bf16(af[0][ks], bfr, a0, 0, 0, 0); a1 = __builtin_amdgcn_mfma_f32_16x16x32_bf16(af[1][ks], bfr, a1, 0, 0, 0); }
        const int col = 16 * nt + n_i; const float bv = bias[col];
#pragma unroll
        for (int r = 0; r < 4; ++r) { const size_t t0 = (size_t)(tok0 + 4 * q4 + r), t1 = t0 + 16;
            mix[t0 * DM + col] = (bf16_t)f2bf(bf2f(ys[t0 * 256 + col]) * sigmoidf_(a0[r] + bv)); mix[t1 * DM + col] = (bf16_t)f2bf(bf2f(ys[t1 * 256 + col]) * sigmoidf_(a1[r] + bv)); }
    }
}

__device__ __forceinline__ void ln1_load(const Params& P, int l, int row, int lane, f32x4 (&xa)[4], f32x4 (&ya)[4]) {
    const float* xin = l == 0 ? pin(P, 0) : (const float*)P.out; const float* y = (const float*)(P.ws + WS_Y);
    const f32x4* xr = (const f32x4*)(xin + (size_t)row * DM) + lane; const f32x4* yr = (const f32x4*)(y + (size_t)row * DM) + lane;
#pragma unroll
    for (int j = 0; j < 4; ++j) { xa[j] = xr[64 * j]; ya[j] = yr[64 * j]; }
}
template <bool MOE> __device__ __forceinline__ void ln1_proc(const Params& P, int l, int row, int lane, const f32x4 (&xa)[4], const f32x4 (&ya)[4], int& re1, int& re2, float& rw1) {
    unsigned char* ws = P.ws; constexpr bool moe = MOE;
    const float* g = pin(P, 17) + l * DM; const float* bvec = pin(P, 18) + l * DM;
    float* x1 = (float*)(ws + WS_X1); bf16_t* x1b = (bf16_t*)(ws + WS_X1B);
    const float* router = pin(P, 24) + (size_t)(l >> 1) * DM * NE;
    f32x4 v[4]; float s = 0.f;
#pragma unroll
    for (int j = 0; j < 4; ++j) { v[j] = xa[j] * ALPHA + ya[j]; s += (v[j][0] + v[j][1]) + (v[j][2] + v[j][3]); }
    const float mean = wave_sum(s) * (1.f / DM); float s2 = 0.f;
#pragma unroll
    for (int j = 0; j < 4; ++j) { v[j] = v[j] - mean; s2 += (v[j][0] * v[j][0] + v[j][1] * v[j][1]) + (v[j][2] * v[j][2] + v[j][3] * v[j][3]); }
    const float rstd = rsqrtf(wave_sum(s2) * (1.f / DM) + LN_EPS);
    float lg[8];
#pragma unroll
    for (int e = 0; e < 8; ++e) lg[e] = 0.f;
#pragma unroll
    for (int j = 0; j < 4; ++j) { const f32x4 gg = ((const f32x4*)g)[lane + 64 * j], bb = ((const f32x4*)bvec)[lane + 64 * j];
        v[j] = v[j] * rstd * gg + bb;
        ((f32x4*)(x1 + (size_t)row * DM))[lane + 64 * j] = v[j];
        u32x2 o; o.x = pk2(v[j][0], v[j][1]); o.y = pk2(v[j][2], v[j][3]); ((u32x2*)(x1b + (size_t)row * DM))[lane + 64 * j] = o;
        if (moe) {
#pragma unroll
            for (int c = 0; c < 4; ++c) { const f32x4* rp = (const f32x4*)(router + (size_t)(4 * (lane + 64 * j) + c) * 8); const f32x4 r0 = rp[0], r1 = rp[1];
                lg[0] += v[j][c] * r0[0]; lg[1] += v[j][c] * r0[1]; lg[2] += v[j][c] * r0[2]; lg[3] += v[j][c] * r0[3];
                lg[4] += v[j][c] * r1[0]; lg[5] += v[j][c] * r1[1]; lg[6] += v[j][c] * r1[2]; lg[7] += v[j][c] * r1[3]; }
            asm volatile("" ::: "memory"); }
    }
    if (moe) {
#pragma unroll
        for (int e = 0; e < 8; ++e) lg[e] = wave_sum(lg[e]);
        int e1 = 0; float v1 = lg[0];
#pragma unroll
        for (int e = 1; e < 8; ++e) if (lg[e] > v1) { v1 = lg[e]; e1 = e; }
        int e2 = -1; float v2 = -INFINITY;
#pragma unroll
        for (int e = 0; e < 8; ++e) if (e != e1 && lg[e] > v2) { v2 = lg[e]; e2 = e; }
        re1 = e1; re2 = e2; rw1 = 1.f / (1.f + __expf(v2 - v1));
    }
}
__device__ __forceinline__ void permute_row(const Params& P, int l, int c, int lane) {
    unsigned char* ws = P.ws; unsigned* ctl = (unsigned*)(ws + WS_CTL); const unsigned* cntw = ctl + CW_CNT + 512 * (l >> 1);
    const bf16_t* x1b = (const bf16_t*)(ws + WS_X1B); bf16_t* xperm = (bf16_t*)(ws + WS_Y); const int* rowtok_v = (const int*)(ws + WS_MISC + MISC_ROWTOKV); int* tile_e = (int*)(ws + WS_MISC + MISC_TILEE);
    int cnt[8], tb[9]; tb[0] = 0;
#pragma unroll
    for (int e = 0; e < 8; ++e) { cnt[e] = (int)cntw[64 * e]; tb[e + 1] = tb[e] + ((cnt[e] + 255) >> 8); }
    const int NT = tb[8];
    if (c == 0 && lane == 0) ctl[CW_NT] = (unsigned)NT;
    if (c >= NT * 256) return;
    const int tile = c >> 8; int e = 0, tbe = 0, cne = cnt[0];
#pragma unroll
    for (int i = 1; i < 8; ++i) if (tile >= tb[i]) { e = i; tbe = tb[i]; cne = cnt[i]; }
    if ((c & 255) == 0 && lane == 0) tile_e[tile] = e;
    const int pos = c - tbe * 256;
    u32x4 v0 = (u32x4){0u, 0u, 0u, 0u}, v1 = v0;
    if (pos < cne) { const int tok = rowtok_v[e * MTOK + pos]; const u32x4* s = (const u32x4*)(x1b + (size_t)tok * DM); v0 = s[lane]; v1 = s[lane + 64]; }
    u32x4* d = (u32x4*)(xperm + (size_t)c * DM); d[lane] = v0; d[lane + 64] = v1;
}
__device__ __forceinline__ void ln2_load(const Params& P, int l, int row, int lane, f32x4 (&Ix)[4], u32x2 (&Ia)[4], u32x2 (&Ic)[4], float& Iw1, float& Iw2) {
    unsigned char* ws = P.ws; const int moe = l & 1; const unsigned* cntw = (const unsigned*)(ws + WS_CTL) + CW_CNT + 512 * (l >> 1);
    const float* x1 = (const float*)(ws + WS_X1); const bf16_t* yp = (const bf16_t*)(ws + WS_Y);
    const int* tok_e = (const int*)(ws + WS_MISC + MISC_TOKE); const int* tok_p = (const int*)(ws + WS_MISC + MISC_TOKP); const float* tok_w = (const float*)(ws + WS_MISC + MISC_TOKW);
    int r1 = row, r2 = row; Iw1 = 1.f; Iw2 = 0.f;
    if (moe) { int tb[9]; tb[0] = 0;
#pragma unroll
        for (int e = 0; e < 8; ++e) tb[e + 1] = tb[e] + (((int)cntw[64 * e] + 255) >> 8);
        const int e1 = tok_e[row * 2], e2 = tok_e[row * 2 + 1]; int b1 = 0, b2 = 0;
#pragma unroll
        for (int e = 0; e < 8; ++e) { if (e == e1) b1 = tb[e]; if (e == e2) b2 = tb[e]; }
        r1 = b1 * 256 + tok_p[row * 2]; r2 = b2 * 256 + tok_p[row * 2 + 1]; Iw1 = tok_w[row * 2]; Iw2 = tok_w[row * 2 + 1]; }
    const f32x4* xr = (const f32x4*)(x1 + (size_t)row * DM) + lane; const u32x2* y1 = (const u32x2*)(yp + (size_t)r1 * DM) + lane; const u32x2* y2 = (const u32x2*)(yp + (size_t)r2 * DM) + lane;
#pragma unroll
    for (int j = 0; j < 4; ++j) { Ix[j] = xr[64 * j]; Ia[j] = y1[64 * j]; Ic[j] = y2[64 * j]; }
}
__device__ __forceinline__ void ln2_proc(const Params& P, int l, int row, int lane, const f32x4 (&Ix)[4], const u32x2 (&Ia)[4], const u32x2 (&Ic)[4], float w1, float w2) {
    const float* g = pin(P, 19) + l * DM; const float* bvec = pin(P, 20) + l * DM; float* xout = P.out; bf16_t* xb = (bf16_t*)(P.ws + WS_XB);
    f32x4 v[4]; float s = 0.f;
#pragma unroll
    for (int j = 0; j < 4; ++j) { const u32x2 a = Ia[j], c = Ic[j];
        f32x4 f; f[0] = w1 * __uint_as_float(a.x << 16) + w2 * __uint_as_float(c.x << 16); f[1] = w1 * __uint_as_float(a.x & 0xffff0000u) + w2 * __uint_as_float(c.x & 0xffff0000u);
        f[2] = w1 * __uint_as_float(a.y << 16) + w2 * __uint_as_float(c.y << 16); f[3] = w1 * __uint_as_float(a.y & 0xffff0000u) + w2 * __uint_as_float(c.y & 0xffff0000u);
        v[j] = Ix[j] * ALPHA + f; s += (v[j][0] + v[j][1]) + (v[j][2] + v[j][3]); }
    const float mean = wave_sum(s) * (1.f / DM); float s2 = 0.f;
#pragma unroll
    for (int j = 0; j < 4; ++j) { v[j] = v[j] - mean; s2 += (v[j][0] * v[j][0] + v[j][1] * v[j][1]) + (v[j][2] * v[j][2] + v[j][3] * v[j][3]); }
    const float rstd = rsqrtf(wave_sum(s2) * (1.f / DM) + LN_EPS);
#pragma unroll
    for (int j = 0; j < 4; ++j) { const f32x4 gg = ((const f32x4*)g)[lane + 64 * j], bb = ((const f32x4*)bvec)[lane + 64 * j];
        v[j] = v[j] * rstd * gg + bb;
        ((f32x4*)(xout + (size_t)row * DM))[lane + 64 * j] = v[j];
        u32x2 o; o.x = pk2(v[j][0], v[j][1]); o.y = pk2(v[j][2], v[j][3]); ((u32x2*)(xb + (size_t)row * DM))[lane + 64 * j] = o; }
}

template <class Epi> __device__ __forceinline__ void run_gemm(LAS unsigned char* lds, const bf16_t* A, const bf16_t* Bt, int nM, int nN, int K, size_t bstride, const int* tile_e, const unsigned* nt_word, const Epi& E) {
    LAS int* te = (LAS int*)(lds + LDS_TE);
    if (nt_word) nM = (int)__builtin_amdgcn_readfirstlane(__hip_atomic_load(nt_word, __ATOMIC_RELAXED, __HIP_MEMORY_SCOPE_AGENT));
    if (tile_e) { const int t_ = opaque((int)threadIdx.x); if (t_ < nM) te[t_] = __hip_atomic_load(tile_e + t_, __ATOMIC_RELAXED, __HIP_MEMORY_SCOPE_AGENT); }
    __syncthreads();
    pg8::Gemm g{A, Bt, nM, nN, K, bstride, tile_e ? (const LAS int*)te : (const LAS int*)nullptr};
    pg8::StaticOrder S; S.init(nM, nN, (int)gridDim.x, (int)blockIdx.x, g.tile_e);
    pg8::gemm_phase<Epi, true>(lds, g, S, E);
}

__global__ void __launch_bounds__(512, 2) mega_fwd(KArgs A) {
    extern __shared__ __attribute__((aligned(16))) unsigned char smem[];
    LAS unsigned char* lds = (LAS unsigned char*)smem;
    volatile LAS unsigned* MISC = (volatile LAS unsigned*)(lds + LDS_MISC);
    const int tid = threadIdx.x, lane = tid & 63, wave = __builtin_amdgcn_readfirstlane(tid >> 6);
    const int G = gridDim.x, blk = blockIdx.x;
    unsigned char* ws = A.ws; unsigned* ctl = (unsigned*)(ws + WS_CTL);
    if (tid < 32) MISC[tid] = 0u;
    { LAS unsigned long long* pt = (LAS unsigned long long*)(lds + LDS_PTAB);
      if (tid == 0) {
#pragma unroll
          for (int i = 0; i < 28; ++i) pt[i] = (unsigned long long)A.in[i]; } }
    Params P; P.tab = (const LAS unsigned*)(lds + LDS_PTAB); P.out = A.out; P.ws = ws;
    __syncthreads();
    XcdBarrier bar = xcd_barrier_post(ctl + CW_BAR, MISC + 8);
    const int gw = blk * NWAVES + wave, NGW = G * NWAVES;

    phase_prep(P, lds);
#if PROBE == 2
    xcd_barrier(bar); phase_prep(P, lds);
#endif
    for (int r10_ = 0; r10_ < (PROBE == 10 ? 2 : 1); ++r10_) {
    for (int it = blk; it < DEPTH * S5G * 4; it += G) s5prep_item(P, it, lds);
    for (int l2 = 0; l2 < DEPTH; ++l2) gluprep(P, l2, blk * 512 + tid, G * 512);
    }
    xcd_barrier(bar);

    bf16_t* xb = (bf16_t*)(ws + WS_XB); bf16_t* x1b = (bf16_t*)(ws + WS_X1B); bf16_t* ybf = (bf16_t*)(ws + WS_Y); float* yf = (float*)(ws + WS_Y);
    bf16_t* hbuf = (bf16_t*)(ws + WS_R1 + R1_H); float* aux = (float*)(ws + WS_R1 + R1_AUX); bf16_t* mix = (bf16_t*)(ws + WS_R1 + R1_MIX); bf16_t* Hbuf = (bf16_t*)(ws + WS_R1);
    const int* tile_e = (const int*)(ws + WS_MISC + MISC_TILEE);

    for (int l = 0; l < DEPTH; ++l) {
        const int moe = l & 1; const int slot0 = moe ? 2 + (l >> 1) * 8 : (l >> 1);
        { pg8::EpiBf16 E{hbuf, aux, INP, 11};
          for (int rp_ = 0; rp_ < (PROBE == 4 ? 2 : 1); ++rp_) { if (rp_) xcd_barrier(bar); run_gemm(lds, xb, (const bf16_t*)(ws + WS_WIN) + (size_t)l * INP * DM, MTOK / 256, INP / 256, DM, 0, nullptr, nullptr, E); } }
        xcd_barrier(bar);
#if PROBE == 1
        for (int rep_ = 0; rep_ < 2; ++rep_) {
#else
        { const int rep_ = 0;
#endif
        for (int r5_ = 0; r5_ < (PROBE == 5 ? 2 : 1); ++r5_) {
        for (int k_ = 0; k_ < 2; ++k_) {
            if (blk < 128 && k_ == 0) s5_unit(P, l, blk, lds);
            else gdn_local_unit(P, l, blk < 128 ? blk : 128 + (blk - 128) * 2 + k_, lds); }
        for (int it = gw; it < BATCH * 8 * 6 * 4; it += NGW) kmean_item(P, it, opaque(lane));
        xcd_barrier(bar);
        }
        for (int r6_ = 0; r6_ < (PROBE == 6 ? 2 : 1); ++r6_) {
        if (blk < BATCH * NH) for (int r7_ = 0; r7_ < (PROBE == 7 ? 2 : 1); ++r7_) gdn_seq_unit(P, blk, lds);
        for (;;) {
            if (tid == 0) MISC[16] = atomicAdd(ctl + CW_Q + l + 4 * rep_ + 8 * r6_, 1u);
            __syncthreads();
            const int u = (int)MISC[16];
            __syncthreads();
            if (u >= 384 + 64) break;
            if (u >= 64) moba_unit(P, (u - 64) % 48, 7 - (u - 64) / 48, lds); else glu_unit(P, l, u);
        }
        xcd_barrier(bar);
        }
        for (int u = blk, it_ = 0; u < BATCH * NH * 16; u += G, ++it_) gdn_out_unit(P, l, u, it_ & 1, lds);
        xcd_barrier(bar);
        }
        { pg8::EpiF32 E{yf, DM, 0};
          for (int rp_ = 0; rp_ < (PROBE == 4 ? 2 : 1); ++rp_) { if (rp_) xcd_barrier(bar); run_gemm(lds, mix, (const bf16_t*)(ws + WS_WOUT) + (size_t)l * DM * DM, MTOK / 256, DM / 256, DM, 0, nullptr, nullptr, E); } }
        xcd_barrier(bar);
        if (!moe) { for (int rp_ = 0; rp_ < (PROBE == 3 ? 2 : 1); ++rp_) { const int ln_ = opaque(lane); f32x4 xa[4], ya[4], xn[4], yn[4]; ln1_load(P, l, gw, ln_, xa, ya);
            for (int r = gw; r < MTOK; r += NGW) { ln1_load(P, l, r + NGW < MTOK ? r + NGW : r, ln_, xn, yn);
                int e1_, e2_; float w1_; ln1_proc<false>(P, l, r, ln_, xa, ya, e1_, e2_, w1_);
#pragma unroll
                for (int j = 0; j < 4; ++j) { xa[j] = xn[j]; ya[j] = yn[j]; } } } }
        else {
            LAS int* lc = (LAS int*)lds; LAS int* rinfo = lc + 32;
            int* tok_e = (int*)(ws + WS_MISC + MISC_TOKE); int* tok_p = (int*)(ws + WS_MISC + MISC_TOKP); float* tok_w = (float*)(ws + WS_MISC + MISC_TOKW); int* rowtok_v = (int*)(ws + WS_MISC + MISC_ROWTOKV);
            unsigned* cntw = ctl + CW_CNT + 512 * (l >> 1);
            { const int t8 = opaque(tid); if (t8 < 8) lc[t8] = 0; }
            __syncthreads();
            const int ln_ = opaque(lane); f32x4 xa[4], ya[4], xn[4], yn[4]; ln1_load(P, l, blk * 64 + wave * 8, ln_, xa, ya);
            for (int i = 0; i < 8; ++i) { const int rl = wave * 8 + i, row = blk * 64 + rl; int e1_, e2_; float w1_; ln1_load(P, l, i < 7 ? row + 1 : row, ln_, xn, yn);
                ln1_proc<true>(P, l, row, ln_, xa, ya, e1_, e2_, w1_);
#pragma unroll
                for (int j = 0; j < 4; ++j) { xa[j] = xn[j]; ya[j] = yn[j]; }
                if (lane == 0) { const int r1 = __hip_atomic_fetch_add(lc + e1_, 1, __ATOMIC_RELAXED, __HIP_MEMORY_SCOPE_WORKGROUP), r2 = __hip_atomic_fetch_add(lc + e2_, 1, __ATOMIC_RELAXED, __HIP_MEMORY_SCOPE_WORKGROUP);
                    rinfo[rl * 4] = e1_; rinfo[rl * 4 + 1] = r1; rinfo[rl * 4 + 2] = e2_; rinfo[rl * 4 + 3] = r2;
                    tok_e[row * 2] = e1_; tok_e[row * 2 + 1] = e2_; tok_w[row * 2] = w1_; tok_w[row * 2 + 1] = 1.f - w1_; } }
            __syncthreads();
            { const int t8 = opaque(tid); if (t8 < 8) lc[16 + t8] = (int)atomicAdd(cntw + 64 * t8, (unsigned)lc[t8]); }
            __syncthreads();
            const int tq = opaque(tid);
            if (tq < 128) { const int rl = tq >> 1, sl = tq & 1, row = blk * 64 + rl; const int e = rinfo[rl * 4 + 2 * sl], p = lc[16 + e] + rinfo[rl * 4 + 2 * sl + 1];
                tok_p[row * 2 + sl] = p; rowtok_v[e * MTOK + p] = row; }
            __syncthreads();
        }
        xcd_barrier(bar);
        if (moe) { for (int r12_ = 0; r12_ < (PROBE == 12 ? 2 : 1); ++r12_) for (int c = gw; c < MAXT * 256; c += NGW) permute_row(P, l, c, opaque(lane)); xcd_barrier(bar); }
        { pg8::EpiSwiglu E{Hbuf, DFF, 0};
          for (int rp_ = 0; rp_ < (PROBE == 4 ? 2 : 1); ++rp_) { if (rp_) xcd_barrier(bar);
          run_gemm(lds, moe ? (const bf16_t*)ybf : (const bf16_t*)x1b, (const bf16_t*)(ws + WS_WGU) + (size_t)slot0 * 2 * DFF * DM, MTOK / 256, 2 * DFF / 256, DM, (size_t)2 * DFF * DM,
                   moe ? tile_e : nullptr, moe ? ctl + CW_NT : nullptr, E); } }
        xcd_barrier(bar);
        { pg8::EpiBf16 E{ybf, nullptr, DM, -1};
          for (int rp_ = 0; rp_ < (PROBE == 4 ? 2 : 1); ++rp_) { if (rp_) xcd_barrier(bar); run_gemm(lds, Hbuf, (const bf16_t*)(ws + WS_WD) + (size_t)slot0 * DM * DFF, MTOK / 256, DM / 256, DFF, (size_t)DM * DFF, moe ? tile_e : nullptr, moe ? ctl + CW_NT : nullptr, E); } }
        xcd_barrier(bar);
        for (int rp_ = 0; rp_ < (PROBE == 3 ? 2 : 1); ++rp_) { const int ln_ = opaque(lane); f32x4 ax[4], bx[4]; u32x2 aa[4], ac[4], ba[4], bc[4]; float aw1, aw2, bw1, bw2; ln2_load(P, l, gw, ln_, ax, aa, ac, aw1, aw2);
            for (int r = gw; r < MTOK; r += 2 * NGW) { ln2_load(P, l, r + NGW, ln_, bx, ba, bc, bw1, bw2); ln2_proc(P, l, r, ln_, ax, aa, ac, aw1, aw2);
                if (r + 2 * NGW < MTOK) ln2_load(P, l, r + 2 * NGW, ln_, ax, aa, ac, aw1, aw2); ln2_proc(P, l, r + NGW, ln_, bx, ba, bc, bw1, bw2); } }
        if (l + 1 < DEPTH) xcd_barrier(bar);
    }
}

extern "C" void kernel_launch(void* const* d_in, const int* in_sizes, int n_in, void* d_out, int out_size, void* d_ws, size_t ws_size, hipStream_t stream) {
    static int grid = 0;
    if (grid == 0) {
        if (n_in != 28 || out_size != MTOK * DM || ws_size < WS_END) { fprintf(stderr, "kernel_launch: unexpected arguments (n_in %d out %d ws %zu)\n", n_in, out_size, ws_size); grid = -1; return; }
        int dev = 0, cus = 0;
        if (hipGetDevice(&dev) != hipSuccess || hipDeviceGetAttribute(&cus, hipDeviceAttributeMultiprocessorCount, dev) != hipSuccess) { grid = -1; return; }
        if (hipFuncSetAttribute((const void*)mega_fwd, hipFuncAttributeMaxDynamicSharedMemorySize, LDS_BYTES) != hipSuccess) { fprintf(stderr, "kernel_launch: hipFuncSetAttribute failed\n"); grid = -1; return; }
        int per_cu = 0;
        if (hipOccupancyMaxActiveBlocksPerMultiprocessor(&per_cu, (const void*)mega_fwd, NWAVES * 64, LDS_BYTES) != hipSuccess || per_cu < 1) { fprintf(stderr, "kernel_launch: occupancy query says %d\n", per_cu); }
        (void)hipGetLastError();
        grid = cus;
        if (grid < 256) { fprintf(stderr, "kernel_launch: needs 256 CUs\n"); grid = -1; return; }
        grid = 256;
    }
    if (grid < 0) return;
    (void)hipMemsetAsync((char*)d_ws + WS_CTL, 0, 1 * MiB, stream);
    KArgs p{};
    for (int i = 0; i < 28; ++i) p.in[i] = (const float*)d_in[i];
    p.out = (float*)d_out; p.ws = (unsigned char*)d_ws;
    hipLaunchKernelGGL(mega_fwd, dim3(grid), dim3(NWAVES * 64), LDS_BYTES, stream, p);
}
```
